# Optimizing an MI355X kernel written in HIP

```python
import math
import jax
import jax.numpy as jnp
from jax import lax
import numpy as np


D_MODEL = 2048
BATCH = 1
SEQ = 16384
DEPTH = 1

CHUNK = 64
PLE_DIM = 256
EPS = 1e-6

RET_HEADS = 8
RET_HEAD_DIM = 128
RET_WIDTH = RET_HEADS * RET_HEAD_DIM
ROPE_THETA = 10000.0

SSM_WIDTH = 1024
SSM_GROUP_SIZE = 16
SSM_GROUPS = SSM_WIDTH // SSM_GROUP_SIZE
SSM_STATE = 64
DT_MIN = 1e-3
DT_MAX = 1e-1

IN_COLS = 4 * RET_WIDTH + SSM_WIDTH

N_EXPERT_GROUPS = 4
EXPERTS_PER_GROUP = 8
N_EXPERTS = N_EXPERT_GROUPS * EXPERTS_PER_GROUP
TOP_K_INNER = 2
D_EXPERT = 512
MOE_BLOCK = 128

kernel_name = 'hybrid_retention_s5_hmoe_block'


def _rmsnorm(x, w):
    xf = x.astype(jnp.float32)
    y = xf * lax.rsqrt(jnp.mean(xf * xf, axis=-1, keepdims=True) + EPS)
    return (y * w.astype(jnp.float32)).astype(x.dtype)


def _rope(t):
    seq = t.shape[1]
    half = t.shape[-1] // 2
    inv_freq = ROPE_THETA ** (-jnp.arange(half, dtype=jnp.float32) / half)
    ang = jnp.arange(seq, dtype=jnp.float32)[:, None] * inv_freq[None, :]
    cos = jnp.cos(ang)[None, :, None, :]
    sin = jnp.sin(ang)[None, :, None, :]
    t1, t2 = t[..., :half], t[..., half:]
    return jnp.concatenate([t1 * cos - t2 * sin, t1 * sin + t2 * cos], axis=-1)


def _retention(q, k, v, g, gn_w):
    bsz, seq, nh, dh = q.shape
    nc = seq // CHUNK
    q = _rope(q)
    k = _rope(k) * (dh ** -0.5)
    log_gamma = jnp.log1p(-jnp.exp2(-5.0 - jnp.arange(nh, dtype=jnp.float32)))
    pos = jnp.arange(CHUNK, dtype=jnp.float32)
    intra_decay = jnp.exp(log_gamma[:, None, None] * jnp.abs(pos[:, None] - pos[None, :]))
    key_decay = jnp.exp(log_gamma[:, None] * (CHUNK - 1.0 - pos)[None, :])
    query_decay = jnp.exp(log_gamma[:, None] * (pos + 1.0)[None, :])
    chunk_decay = jnp.exp(log_gamma * CHUNK)
    qc = q.reshape(bsz, nc, CHUNK, nh, dh)
    kc = k.reshape(bsz, nc, CHUNK, nh, dh)
    vc = v.reshape(bsz, nc, CHUNK, nh, dh)
    scores = jnp.einsum('bnqhd,bnkhd->bnhqk', qc, kc) * intra_decay
    y_intra = jnp.einsum('bnhqk,bnkhe->bnqhe', scores, vc)
    kv = jnp.einsum('bnkhd,bnkhe,hk->nbhde', kc, vc, key_decay)

    def step(state, kv_n):
        return state * chunk_decay[None, :, None, None] + kv_n, state

    _, state_prev = lax.scan(step, jnp.zeros((bsz, nh, dh, dh), jnp.float32), kv)
    y_cross = jnp.einsum('bnqhd,nbhde,hq->bnqhe', qc, state_prev, query_decay)
    y = (y_intra + y_cross).reshape(bsz, seq, nh, dh)
    mu = jnp.mean(y, axis=-1, keepdims=True)
    var = jnp.mean(jnp.square(y - mu), axis=-1, keepdims=True)
    y = ((y - mu) * lax.rsqrt(var + EPS)).reshape(bsz, seq, nh * dh) * gn_w
    return jax.nn.silu(g) * y


def _s5(u, lam_re, lam_im, log_dt, b_re, b_im, c_re, c_im, d, w_glu):
    bsz, seq, _ = u.shape
    f32 = jnp.float32
    ug = u.reshape(bsz, seq, SSM_GROUPS, SSM_GROUP_SIZE)
    lam = lax.complex(jnp.minimum(lam_re.astype(f32), -1e-4), lam_im.astype(f32))
    dt = jnp.exp(log_dt.astype(f32))[:, None]
    log_lam_bar = lam * dt
    lam_bar = jnp.exp(log_lam_bar)
    b_mat = lax.complex(b_re.astype(f32), b_im.astype(f32))
    b_bar = ((lam_bar - 1.0) / lam)[..., None] * b_mat
    bu = jnp.einsum('gpc,bsgc->bsgp', b_bar, ug.astype(jnp.complex64))
    steps = jnp.ones((1, seq, 1, 1), f32)

    def combine(left, right):
        n_l, s_l = left
        n_r, s_r = right
        return n_l + n_r, jnp.exp(n_r.astype(jnp.complex64) * log_lam_bar) * s_l + s_r

    _, states = lax.associative_scan(combine, (steps, bu), axis=1)
    c_mat = lax.complex(c_re.astype(f32), c_im.astype(f32))
    y = jnp.real(jnp.einsum('gcp,bsgp->bsgc', c_mat, states)).reshape(bsz, seq, SSM_WIDTH)
    y = y + d.astype(f32) * u
    y = jax.nn.gelu(y)
    return y * jax.nn.sigmoid(y @ w_glu.astype(f32))


def _hybrid_mixer(h, w_in, ret_gn_w, lam_re, lam_im, log_dt, b_re, b_im, c_re, c_im,
                  ssm_d, w_glu, w_branch_a, w_branch_b, w_merge, w_out):
    bsz, seq, _ = h.shape
    f32 = jnp.float32
    proj = h @ w_in
    q, k, v, g, u = jnp.split(proj, [RET_WIDTH, 2 * RET_WIDTH, 3 * RET_WIDTH, 4 * RET_WIDTH], axis=-1)

    def heads(t):
        return t.astype(f32).reshape(bsz, seq, RET_HEADS, RET_HEAD_DIM)

    y_ret = _retention(heads(q), heads(k), heads(v), g.astype(f32), ret_gn_w.astype(f32)).astype(h.dtype)
    y_ssm = _s5(u.astype(f32), lam_re, lam_im, log_dt, b_re, b_im, c_re, c_im, ssm_d, w_glu).astype(h.dtype)
    gates = jax.nn.sigmoid(h @ w_merge).reshape(bsz, seq, 2, D_MODEL)
    merged = gates[:, :, 0] * (y_ret @ w_branch_a) + gates[:, :, 1] * (y_ssm @ w_branch_b)
    return merged @ w_out


def _hier_moe(h, w_rg, b_rg, w_re, b_re, w_gate, w_up, w_down):
    bsz, seq, dm = h.shape
    n_tok = bsz * seq
    ht = h.reshape(n_tok, dm)
    g_prob = jax.nn.softmax((ht @ w_rg).astype(jnp.float32) + b_rg.astype(jnp.float32), axis=-1)
    g_w, g_idx = lax.top_k(g_prob, 1)
    e_logits = ((ht @ w_re).astype(jnp.float32) + b_re.astype(jnp.float32)).reshape(
        n_tok, N_EXPERT_GROUPS, EXPERTS_PER_GROUP)
    e_sel = e_logits[jnp.arange(n_tok), g_idx[:, 0]]
    top_logit, top_j = lax.top_k(e_sel, TOP_K_INNER)
    e_w = jax.nn.softmax(top_logit, axis=-1) * g_w
    expert = g_idx * EXPERTS_PER_GROUP + top_j
    n_assign = n_tok * TOP_K_INNER
    flat_e = expert.reshape(-1).astype(jnp.int32)
    flat_tok = jnp.repeat(jnp.arange(n_tok, dtype=jnp.int32), TOP_K_INNER)
    flat_w = e_w.reshape(-1)
    order = jnp.argsort(flat_e)
    se, stok, sw = flat_e[order], flat_tok[order], flat_w[order]
    counts = jnp.bincount(flat_e, length=N_EXPERTS).astype(jnp.int32)
    start = jnp.cumsum(counts) - counts
    padded = (counts + MOE_BLOCK - 1) // MOE_BLOCK * MOE_BLOCK
    pad_end = jnp.cumsum(padded)
    pad_start = pad_end - padded
    dest = pad_start[se] + (jnp.arange(n_assign, dtype=jnp.int32) - start[se])
    n_rows = n_assign + N_EXPERTS * MOE_BLOCK
    n_blocks = n_rows // MOE_BLOCK
    row_tok = jnp.zeros((n_rows,), jnp.int32).at[dest].set(stok)
    row_w = jnp.zeros((n_rows,), jnp.float32).at[dest].set(sw)
    block_start = jnp.arange(n_blocks, dtype=jnp.int32) * MOE_BLOCK
    block_expert = jnp.minimum(jnp.searchsorted(pad_end, block_start, side='right'), N_EXPERTS - 1)

    def expert_block(args):
        e, toks = args
        xb = ht[toks]
        a = jax.nn.silu(xb @ w_gate[e]) * (xb @ w_up[e])
        return a @ w_down[e]

    y_rows = lax.map(expert_block, (block_expert, row_tok.reshape(n_blocks, MOE_BLOCK)))
    y_rows = y_rows.reshape(n_rows, dm) * row_w[:, None].astype(h.dtype)
    out = jax.ops.segment_sum(y_rows, row_tok, num_segments=n_tok)
    return out.reshape(bsz, seq, dm)


def setup_inputs(seed: int = 0) -> dict:
    key = jax.random.key(seed)
    ks = jax.random.split(key, 32)
    f32 = jnp.float32

    def nrm(k, shape, scale):
        return jax.random.normal(k, shape, f32) * scale

    def gain(k, shape):
        return 1.0 + 0.02 * jax.random.normal(k, shape, f32)

    L, D = DEPTH, D_MODEL
    R, W, G, P, Cg = RET_WIDTH, SSM_WIDTH, SSM_GROUPS, SSM_STATE, SSM_GROUP_SIZE
    E, F = N_EXPERTS, D_EXPERT
    return {
        'x': nrm(ks[0], (BATCH, SEQ, D), 1.0),
        'p': nrm(ks[1], (L, BATCH, SEQ, PLE_DIM), 1.0),
        'norm_mix': gain(ks[2], (L, D)),
        'w_in': nrm(ks[3], (L, D, IN_COLS), D ** -0.5),
        'ret_gn_w': gain(ks[4], (L, R)),
        'ssm_lam_re': -0.5 + nrm(ks[5], (L, G, P), 0.01),
        'ssm_lam_im': math.pi * jnp.arange(P, dtype=f32) + nrm(ks[6], (L, G, P), 0.01),
        'ssm_log_dt': jax.random.uniform(ks[7], (L, G), f32, math.log(DT_MIN), math.log(DT_MAX)),
        'ssm_b_re': nrm(ks[8], (L, G, P, Cg), (2 * Cg) ** -0.5),
        'ssm_b_im': nrm(ks[9], (L, G, P, Cg), (2 * Cg) ** -0.5),
        'ssm_c_re': nrm(ks[10], (L, G, Cg, P), P ** -0.5),
        'ssm_c_im': nrm(ks[11], (L, G, Cg, P), P ** -0.5),
        'ssm_d': nrm(ks[12], (L, W), 1.0),
        'w_glu': nrm(ks[13], (L, W, W), W ** -0.5),
        'w_branch_a': nrm(ks[14], (L, R, D), R ** -0.5),
        'w_branch_b': nrm(ks[15], (L, W, D), W ** -0.5),
        'w_merge': nrm(ks[16], (L, D, 2 * D), D ** -0.5),
        'w_out': nrm(ks[17], (L, D, D), D ** -0.5),
        'norm_ffn': gain(ks[18], (L, D)),
        'w_router_group': nrm(ks[19], (L, D, N_EXPERT_GROUPS), D ** -0.5),
        'b_router_group': nrm(ks[20], (L, N_EXPERT_GROUPS), 0.01),
        'w_router_expert': nrm(ks[21], (L, D, E), D ** -0.5),
        'b_router_expert': nrm(ks[22], (L, E), 0.01),
        'w_exp_gate': nrm(ks[23], (L, E, D, F), D ** -0.5),
        'w_exp_up': nrm(ks[24], (L, E, D, F), D ** -0.5),
        'w_exp_down': nrm(ks[25], (L, E, F, D), F ** -0.5),
        'norm_ple': gain(ks[26], (L, D)),
        'w_ple_gate': nrm(ks[27], (L, D, D), D ** -0.5),
        'w_ple': nrm(ks[28], (L, PLE_DIM, D), PLE_DIM ** -0.5),
        'norm_f': gain(ks[29], (D,)),
    }


def reference(x, p, norm_mix, w_in, ret_gn_w, ssm_lam_re, ssm_lam_im, ssm_log_dt,
              ssm_b_re, ssm_b_im, ssm_c_re, ssm_c_im, ssm_d, w_glu, w_branch_a, w_branch_b,
              w_merge, w_out, norm_ffn, w_router_group, b_router_group, w_router_expert,
              b_router_expert, w_exp_gate, w_exp_up, w_exp_down, norm_ple, w_ple_gate,
              w_ple, norm_f):
    for i in range(DEPTH):
        h = _rmsnorm(x, norm_mix[i])
        x = x + _hybrid_mixer(h, w_in[i], ret_gn_w[i], ssm_lam_re[i], ssm_lam_im[i], ssm_log_dt[i],
                              ssm_b_re[i], ssm_b_im[i], ssm_c_re[i], ssm_c_im[i], ssm_d[i], w_glu[i],
                              w_branch_a[i], w_branch_b[i], w_merge[i], w_out[i])
        h = _rmsnorm(x, norm_ffn[i])
        x = x + _hier_moe(h, w_router_group[i], b_router_group[i], w_router_expert[i],
                          b_router_expert[i], w_exp_gate[i], w_exp_up[i], w_exp_down[i])
        h = _rmsnorm(x, norm_ple[i])
        x = x + jax.nn.sigmoid(h @ w_ple_gate[i]) * (p[i] @ w_ple[i])
    return _rmsnorm(x, norm_f)
```

```cpp
#include <hip/hip_runtime.h>
#include <math.h>
#include <stdio.h>

namespace {
constexpr int T = 16384, D = 2048, CH = 64, NCH = T / CH, PLE = 256;
constexpr int NH = 8, DH = 128, RW = 1024, SW = 1024, SG = 64, SP = 64, SC = 16;
constexpr int INC = 5120, NE = 32, NGR = 4, EPG = 8, FE = 512;
constexpr float EPS = 1e-6f;

__device__ __forceinline__ float sigm(float x) { return 1.f / (1.f + __expf(-x)); }
__device__ __forceinline__ float silu(float x) { return x * sigm(x); }
__device__ __forceinline__ float gelu_tanh(float x) { const float u = 0.7978845608028654f * (x + 0.044715f * x * x * x); return 0.5f * x * (1.f + tanhf(u)); }
__device__ __forceinline__ float wave_sum(float v) {
#pragma unroll
    for (int o = 1; o < 64; o <<= 1) v += __shfl_xor(v, o);
    return v;
}

__global__ __launch_bounds__(256) void k_rmsnorm(const float* x, const float* w, float* out) {
    __shared__ float red[4];
    const size_t row = blockIdx.x; const int tid = threadIdx.x;
    const float4* xr = (const float4*)(x + row * D); const float4* wr = (const float4*)w;
    float4 a = xr[tid], b = xr[tid + 256];
    float s = a.x * a.x + a.y * a.y + a.z * a.z + a.w * a.w + b.x * b.x + b.y * b.y + b.z * b.z + b.w * b.w;
    s = wave_sum(s); if ((tid & 63) == 0) red[tid >> 6] = s; __syncthreads();
    const float r = rsqrtf((red[0] + red[1] + red[2] + red[3]) * (1.f / D) + EPS);
    float4 wa = wr[tid], wb = wr[tid + 256];
    float4* o = (float4*)(out + row * D);
    o[tid] = make_float4(a.x * r * wa.x, a.y * r * wa.y, a.z * r * wa.z, a.w * r * wa.w);
    o[tid + 256] = make_float4(b.x * r * wb.x, b.y * r * wb.y, b.z * r * wb.z, b.w * r * wb.w);
}

struct GArgs { const float* A; const float* W; const float* W2; const int* ridx; const int* cnt; long wstride; long ridx_stride; int lda, ldw, M, N, K, pad; };
template <class Epi, bool DUAL> __global__ __launch_bounds__(256) void sgemm_k(GArgs g, Epi epi) {
    __shared__ float As[16][68];
    __shared__ float Ws[16][68];
    __shared__ float Ws2[DUAL ? 16 : 1][68];
    const int tid = threadIdx.x, tx = tid & 15, ty = tid >> 4;
    const int z = blockIdx.z;
    int Mz = g.M; if (g.cnt) Mz = g.cnt[z];
    const int m0 = blockIdx.y * 64, n0 = blockIdx.x * 64;
    if (m0 >= Mz) return;
    const float* W = g.W + (size_t)z * g.wstride; const float* W2 = DUAL ? g.W2 + (size_t)z * g.wstride : nullptr;
    const int* ridx = g.ridx ? g.ridx + (size_t)z * g.ridx_stride : nullptr;
    const int arow = tid >> 2, akq = tid & 3;
    int gm = m0 + arow; if (gm >= Mz) gm = Mz - 1;
    const size_t srow = ridx ? (size_t)ridx[gm] : (size_t)gm;
    const float* ap = g.A + srow * g.lda + akq * 4;
    const int wk = tid >> 4, wn = (tid & 15) * 4;
    float acc[4][4], acc2[4][4];
#pragma unroll
    for (int i = 0; i < 4; ++i)
#pragma unroll
        for (int j = 0; j < 4; ++j) { acc[i][j] = 0.f; acc2[i][j] = 0.f; }
    for (int k0 = 0; k0 < g.K; k0 += 16) {
        const float4 a = *(const float4*)(ap + k0);
        As[akq * 4 + 0][arow] = a.x; As[akq * 4 + 1][arow] = a.y; As[akq * 4 + 2][arow] = a.z; As[akq * 4 + 3][arow] = a.w;
        *(float4*)&Ws[wk][wn] = *(const float4*)(W + (size_t)(k0 + wk) * g.ldw + n0 + wn);
        if (DUAL) *(float4*)&Ws2[wk][wn] = *(const float4*)(W2 + (size_t)(k0 + wk) * g.ldw + n0 + wn);
        __syncthreads();
#pragma unroll
        for (int kk = 0; kk < 16; ++kk) {
            const float4 av = *(const float4*)&As[kk][ty * 4]; const float4 bv = *(const float4*)&Ws[kk][tx * 4];
            const float aa[4] = {av.x, av.y, av.z, av.w}; const float bb[4] = {bv.x, bv.y, bv.z, bv.w};
#pragma unroll
            for (int i = 0; i < 4; ++i)
#pragma unroll
                for (int j = 0; j < 4; ++j) acc[i][j] += aa[i] * bb[j];
            if (DUAL) { const float4 cv = *(const float4*)&Ws2[kk][tx * 4]; const float cc[4] = {cv.x, cv.y, cv.z, cv.w};
#pragma unroll
                for (int i = 0; i < 4; ++i)
#pragma unroll
                    for (int j = 0; j < 4; ++j) acc2[i][j] += aa[i] * cc[j]; }
        }
        __syncthreads();
    }
#pragma unroll
    for (int i = 0; i < 4; ++i) { const int m = m0 + ty * 4 + i; if (m < Mz) epi(z, m, n0 + tx * 4, acc[i], acc2[i]); }
}
struct EpiStore { float* C; long ldc; __device__ void operator()(int, int m, int n, const float (&v)[4], const float (&)[4]) const { *(float4*)(C + (size_t)m * ldc + n) = make_float4(v[0], v[1], v[2], v[3]); } };
struct EpiSigm { float* C; long ldc; __device__ void operator()(int, int m, int n, const float (&v)[4], const float (&)[4]) const { *(float4*)(C + (size_t)m * ldc + n) = make_float4(sigm(v[0]), sigm(v[1]), sigm(v[2]), sigm(v[3])); } };
struct EpiGlu { const float* Y; float* C; long ldc; __device__ void operator()(int, int m, int n, const float (&v)[4], const float (&)[4]) const {
    const float4 y = *(const float4*)(Y + (size_t)m * ldc + n); *(float4*)(C + (size_t)m * ldc + n) = make_float4(y.x * sigm(v[0]), y.y * sigm(v[1]), y.z * sigm(v[2]), y.w * sigm(v[3])); } };
struct EpiMerge { const float* G; float* C; int ldg, ldc, accum, pad; __device__ void operator()(int, int m, int n, const float (&v)[4], const float (&)[4]) const {
    const float4 gt = *(const float4*)(G + (size_t)m * ldg + n); float4 o = make_float4(gt.x * v[0], gt.y * v[1], gt.z * v[2], gt.w * v[3]);
    float4* c = (float4*)(C + (size_t)m * ldc + n); if (accum) { const float4 p = *c; o.x += p.x; o.y += p.y; o.z += p.z; o.w += p.w; } *c = o; } };
struct EpiResid { const float* X; float* C; long ldc; __device__ void operator()(int, int m, int n, const float (&v)[4], const float (&)[4]) const {
    const float4 x = *(const float4*)(X + (size_t)m * ldc + n); *(float4*)(C + (size_t)m * ldc + n) = make_float4(x.x + v[0], x.y + v[1], x.z + v[2], x.w + v[3]); } };
struct EpiPle { const float* PP; float* C; long ldc; __device__ void operator()(int, int m, int n, const float (&v)[4], const float (&)[4]) const {
    const float4 pp = *(const float4*)(PP + (size_t)m * ldc + n); float4* c = (float4*)(C + (size_t)m * ldc + n); float4 x = *c;
    x.x += sigm(v[0]) * pp.x; x.y += sigm(v[1]) * pp.y; x.z += sigm(v[2]) * pp.z; x.w += sigm(v[3]) * pp.w; *c = x; } };
struct EpiGateUp { float* ACT; const int* off; __device__ void operator()(int z, int m, int n, const float (&g)[4], const float (&u)[4]) const {
    *(float4*)(ACT + (size_t)(off[z] + m) * FE + n) = make_float4(silu(g[0]) * u[0], silu(g[1]) * u[1], silu(g[2]) * u[2], silu(g[3]) * u[3]); } };
struct EpiDown { float* MOE; const int* list; const float* wgt; __device__ void operator()(int z, int m, int n, const float (&v)[4], const float (&)[4]) const {
    const int code = list[(size_t)z * T + m]; const int tok = code >> 1, slot = code & 1; const float w = wgt[code];
    *(float4*)(MOE + ((size_t)slot * T + tok) * D + n) = make_float4(w * v[0], w * v[1], w * v[2], w * v[3]); } };

__global__ void k_rope(float* __restrict__ proj) {
    const int idx = blockIdx.x * blockDim.x + threadIdx.x;
    if (idx >= T * 2 * NH * 64) return;
    const int j = idx & 63, h = (idx >> 6) & 7, qk = (idx >> 9) & 1, t = idx >> 10;
    const double inv = pow(10000.0, -(double)j / 64.0);
    double s, c; sincos((double)t * inv, &s, &c);
    float* p = proj + (size_t)t * INC + qk * RW + h * DH + j;
    const float t1 = p[0], t2 = p[64]; const float sc = qk ? 0.08838834764831845f : 1.f;
    p[0] = (t1 * (float)c - t2 * (float)s) * sc; p[64] = (t1 * (float)s + t2 * (float)c) * sc;
}
__device__ __forceinline__ float gamma_of(int h) { return 1.f - exp2f(-5.f - (float)h); }
__global__ __launch_bounds__(256) void k_ret_kv(const float* __restrict__ proj, float* __restrict__ kv) {
    __shared__ float Ks[32][128]; __shared__ float Vs[32][128];
    const int n = blockIdx.x >> 3, h = blockIdx.x & 7, tid = threadIdx.x;
    const float lg = logf(gamma_of(h));
    float acc[64];
#pragma unroll
    for (int i = 0; i < 64; ++i) acc[i] = 0.f;
    const int e = tid & 127, d0 = tid >> 7;
    for (int kh = 0; kh < 2; ++kh) {
        for (int i = tid; i < 32 * 128; i += 256) { const int k = i >> 7, c = i & 127; const size_t row = (size_t)(n * CH + kh * 32 + k) * INC;
            Ks[k][c] = proj[row + RW + h * DH + c] * __expf(lg * (float)(63 - (kh * 32 + k))); Vs[k][c] = proj[row + 2 * RW + h * DH + c]; }
        __syncthreads();
        for (int k = 0; k < 32; ++k) { const float v = Vs[k][e];
#pragma unroll
            for (int i = 0; i < 64; ++i) acc[i] += Ks[k][d0 + 2 * i] * v; }
        __syncthreads();
    }
    float* o = kv + ((size_t)(n * NH + h) * DH) * DH;
#pragma unroll
    for (int i = 0; i < 64; ++i) o[(size_t)(d0 + 2 * i) * DH + e] = acc[i];
}
__global__ void k_ret_scan(float* __restrict__ kv) {
    const int idx = blockIdx.x * blockDim.x + threadIdx.x; if (idx >= NH * DH * DH) return;
    const int h = idx / (DH * DH); const float cd = __expf(logf(gamma_of(h)) * 64.f);
    float st = 0.f;
    for (int n = 0; n < NCH; ++n) { float* p = kv + (size_t)n * NH * DH * DH + idx; const float t = *p; *p = st; st = st * cd + t; }
}
__global__ __launch_bounds__(256) void k_ret_out(const float* __restrict__ proj, const float* __restrict__ st, float* __restrict__ yraw) {
    extern __shared__ float sm[];
    float* Qs = sm; float* Ks = sm + 64 * 129; float* Ss = sm + 2 * 64 * 129;
    const int n = blockIdx.x >> 3, h = blockIdx.x & 7, tid = threadIdx.x;
    const float lg = logf(gamma_of(h));
    for (int i = tid; i < 64 * 128; i += 256) { const int k = i >> 7, c = i & 127; const size_t row = (size_t)(n * CH + k) * INC;
        Qs[k * 129 + c] = proj[row + h * DH + c]; Ks[k * 129 + c] = proj[row + RW + h * DH + c]; }
    __syncthreads();
    for (int i = tid; i < 64 * 64; i += 256) { const int q = i >> 6, k = i & 63; float s = 0.f;
        for (int d = 0; d < 128; ++d) s += Qs[q * 129 + d] * Ks[k * 129 + d];
        Ss[q * 65 + k] = s * __expf(lg * fabsf((float)(q - k))); }
    __syncthreads();
    const int e = tid & 127, q0 = tid >> 7;
    float acc[32], accx[32];
#pragma unroll
    for (int i = 0; i < 32; ++i) { acc[i] = 0.f; accx[i] = 0.f; }
    for (int k = 0; k < 64; ++k) { const float v = proj[(size_t)(n * CH + k) * INC + 2 * RW + h * DH + e];
#pragma unroll
        for (int i = 0; i < 32; ++i) acc[i] += Ss[(q0 + 2 * i) * 65 + k] * v; }
    const float* S = st + ((size_t)(n * NH + h) * DH) * DH;
    for (int d = 0; d < 128; ++d) { const float s = S[(size_t)d * DH + e];
#pragma unroll
        for (int i = 0; i < 32; ++i) accx[i] += Qs[(q0 + 2 * i) * 129 + d] * s; }
#pragma unroll
    for (int i = 0; i < 32; ++i) { const int q = q0 + 2 * i; yraw[(size_t)(n * CH + q) * RW + h * DH + e] = acc[i] + __expf(lg * (float)(q + 1)) * accx[i]; }
}
__global__ __launch_bounds__(256) void k_ret_norm(float* __restrict__ y, const float* __restrict__ proj, const float* __restrict__ gnw) {
    const int wv = blockIdx.x * 4 + (threadIdx.x >> 6), lane = threadIdx.x & 63; const int t = wv >> 3, h = wv & 7;
    float* yp = y + (size_t)t * RW + h * DH; const float a = yp[lane], b = yp[lane + 64];
    const float mu = wave_sum(a + b) * (1.f / 128.f); const float da = a - mu, db = b - mu;
    const float var = wave_sum(da * da + db * db) * (1.f / 128.f); const float r = rsqrtf(var + EPS);
    const float* gp = proj + (size_t)t * INC + 3 * RW + h * DH;
    yp[lane] = silu(gp[lane]) * da * r * gnw[h * DH + lane]; yp[lane + 64] = silu(gp[lane + 64]) * db * r * gnw[h * DH + lane + 64];
}
__global__ __launch_bounds__(64) void k_s5(const float* __restrict__ proj, const float* lam_re, const float* lam_im, const float* log_dt, const float* b_re, const float* b_im,
                                          const float* c_re, const float* c_im, const float* dvec, float* __restrict__ ypre) {
    __shared__ float Xr[64][65], Xi[64][65]; __shared__ float Us[64][16];
    const int g = blockIdx.x, p = threadIdx.x;
    const double lr = fmin((double)lam_re[g * SP + p], -1e-4), li = (double)lam_im[g * SP + p], dt = exp((double)log_dt[g]);
    const double er = exp(lr * dt); double sn, cs; sincos(li * dt, &sn, &cs);
    const double lbr = er * cs, lbi = er * sn;
    const double nr = lbr - 1.0, ni = lbi, den = lr * lr + li * li;
    const double fr = (nr * lr + ni * li) / den, fi = (ni * lr - nr * li) / den;
    float Br[16], Bi[16];
#pragma unroll
    for (int c = 0; c < 16; ++c) { const double br = b_re[(g * SP + p) * SC + c], bi = b_im[(g * SP + p) * SC + c]; Br[c] = (float)(fr * br - fi * bi); Bi[c] = (float)(fr * bi + fi * br); }
    const float flr = (float)lbr, fli = (float)lbi;
    float sr = 0.f, si = 0.f;
    for (int t0 = 0; t0 < T; t0 += 64) {
        for (int i = p; i < 64 * 16; i += 64) Us[i >> 4][i & 15] = proj[(size_t)(t0 + (i >> 4)) * INC + 4 * RW + g * SC + (i & 15)];
        __syncthreads();
        for (int t = 0; t < 64; ++t) { float br = 0.f, bi = 0.f;
#pragma unroll
            for (int c = 0; c < 16; ++c) { const float u = Us[t][c]; br += Br[c] * u; bi += Bi[c] * u; }
            const float nr2 = flr * sr - fli * si + br, ni2 = flr * si + fli * sr + bi; sr = nr2; si = ni2; Xr[t][p] = sr; Xi[t][p] = si; }
        __syncthreads();
        for (int i = p; i < 64 * 16; i += 64) { const int t = i >> 4, c = i & 15; float y = 0.f;
            for (int q = 0; q < 64; ++q) y += c_re[(g * SC + c) * SP + q] * Xr[t][q] - c_im[(g * SC + c) * SP + q] * Xi[t][q];
            y += dvec[g * SC + c] * Us[t][c]; ypre[(size_t)(t0 + t) * SW + g * SC + c] = gelu_tanh(y); }
        __syncthreads();
    }
}
__global__ __launch_bounds__(256) void k_router(const float* __restrict__ h, const float* __restrict__ wrg, const float* __restrict__ brg, const float* __restrict__ wre, const float* __restrict__ bre,
                                               int* __restrict__ cnt, int* __restrict__ list, float* __restrict__ wgt) {
    const int t = blockIdx.x * 4 + (threadIdx.x >> 6), lane = threadIdx.x & 63;
    float lg[36];
#pragma unroll
    for (int j = 0; j < 36; ++j) lg[j] = 0.f;
    for (int k = lane; k < D; k += 64) { const float x = h[(size_t)t * D + k];
#pragma unroll
        for (int j = 0; j < 4; ++j) lg[j] += x * wrg[k * NGR + j];
#pragma unroll
        for (int j = 0; j < 32; ++j) lg[4 + j] += x * wre[k * NE + j]; }
#pragma unroll
    for (int j = 0; j < 36; ++j) lg[j] = wave_sum(lg[j]);
    if (lane == 0) {
        float gl[4]; float mx = -1e30f; int gi = 0;
#pragma unroll
        for (int j = 0; j < 4; ++j) { gl[j] = lg[j] + brg[j]; if (gl[j] > mx) { mx = gl[j]; gi = j; } }
        float se = 0.f;
#pragma unroll
        for (int j = 0; j < 4; ++j) se += __expf(gl[j] - mx);
        const float gw = 1.f / se;
        float b1 = -1e30f, b2 = -1e30f; int j1 = 0, j2 = 0;
#pragma unroll
        for (int g4 = 0; g4 < 4; ++g4) if (g4 == gi) {
#pragma unroll
            for (int j = 0; j < 8; ++j) { const float v = lg[4 + g4 * 8 + j] + bre[g4 * 8 + j]; if (v > b1) { b2 = b1; j2 = j1; b1 = v; j1 = j; } else if (v > b2) { b2 = v; j2 = j; } } }
        const float e2 = __expf(b2 - b1); const float w1 = gw / (1.f + e2), w2 = gw * e2 / (1.f + e2);
        const int ea = gi * 8 + j1, eb = gi * 8 + j2;
        const int pa = atomicAdd(&cnt[ea], 1); list[(size_t)ea * T + pa] = t * 2; wgt[t * 2] = w1;
        const int pb = atomicAdd(&cnt[eb], 1); list[(size_t)eb * T + pb] = t * 2 + 1; wgt[t * 2 + 1] = w2;
    }
}
__global__ void k_offsets(const int* cnt, int* off, int* tokidx, const int* list) { if (threadIdx.x == 0) { int s = 0; for (int e = 0; e < NE; ++e) { off[e] = s; s += cnt[e]; } } }
__global__ void k_tokidx(const int* __restrict__ cnt, const int* __restrict__ list, int* __restrict__ tokidx) {
    const int e = blockIdx.y; for (int r = blockIdx.x * blockDim.x + threadIdx.x; r < cnt[e]; r += gridDim.x * blockDim.x) tokidx[(size_t)e * T + r] = list[(size_t)e * T + r] >> 1;
}
__global__ __launch_bounds__(256) void k_moe_combine(float* __restrict__ x, const float* __restrict__ moe, const float* __restrict__ w, float* __restrict__ out) {
    __shared__ float red[4];
    const size_t row = blockIdx.x; const int tid = threadIdx.x;
    float4* xr = (float4*)(x + row * D); const float4* m0 = (const float4*)(moe + row * D); const float4* m1 = (const float4*)(moe + ((size_t)T + row) * D); const float4* wr = (const float4*)w;
    float4 a = xr[tid], b = xr[tid + 256]; const float4 c0 = m0[tid], c1 = m0[tid + 256], d0 = m1[tid], d1 = m1[tid + 256];
    a.x += c0.x + d0.x; a.y += c0.y + d0.y; a.z += c0.z + d0.z; a.w += c0.w + d0.w; b.x += c1.x + d1.x; b.y += c1.y + d1.y; b.z += c1.z + d1.z; b.w += c1.w + d1.w;
    xr[tid] = a; xr[tid + 256] = b;
    float s = a.x * a.x + a.y * a.y + a.z * a.z + a.w * a.w + b.x * b.x + b.y * b.y + b.z * b.z + b.w * b.w;
    s = wave_sum(s); if ((tid & 63) == 0) red[tid >> 6] = s; __syncthreads();
    const float r = rsqrtf((red[0] + red[1] + red[2] + red[3]) * (1.f / D) + EPS);
    float4 wa = wr[tid], wb = wr[tid + 256]; float4* o = (float4*)(out + row * D);
    o[tid] = make_float4(a.x * r * wa.x, a.y * r * wa.y, a.z * r * wa.z, a.w * r * wa.w);
    o[tid + 256] = make_float4(b.x * r * wb.x, b.y * r * wb.y, b.z * r * wb.z, b.w * r * wb.w);
}
__global__ void k_fillidx(const int* cnt, const int* off, int* idx) { const int e = blockIdx.y; for (int r = blockIdx.x * blockDim.x + threadIdx.x; r < cnt[e]; r += gridDim.x * blockDim.x) idx[(size_t)e * T + r] = off[e] + r; }
template <class Epi, bool DUAL> void gemm(hipStream_t s, GArgs g, Epi e, int zdim = 1, int mmax = -1) {
    const int mm = mmax < 0 ? g.M : mmax; dim3 grid(g.N / 64, (mm + 63) / 64, zdim);
    hipLaunchKernelGGL((sgemm_k<Epi, DUAL>), grid, dim3(256), 0, s, g, e);
}
}

extern "C" void kernel_launch(void* const* d_in, const int* in_sizes, int n_in, void* d_out, int out_size, void* d_ws, size_t ws_size, hipStream_t stream) {
    const float* x = (const float*)d_in[0]; const float* p = (const float*)d_in[1]; const float* norm_mix = (const float*)d_in[2]; const float* w_in = (const float*)d_in[3];
    const float* gnw = (const float*)d_in[4]; const float* lam_re = (const float*)d_in[5]; const float* lam_im = (const float*)d_in[6]; const float* log_dt = (const float*)d_in[7];
    const float* b_re = (const float*)d_in[8]; const float* b_im = (const float*)d_in[9]; const float* c_re = (const float*)d_in[10]; const float* c_im = (const float*)d_in[11];
    const float* ssm_d = (const float*)d_in[12]; const float* w_glu = (const float*)d_in[13]; const float* w_a = (const float*)d_in[14]; const float* w_b = (const float*)d_in[15];
    const float* w_merge = (const float*)d_in[16]; const float* w_out = (const float*)d_in[17]; const float* norm_ffn = (const float*)d_in[18];
    const float* w_rg = (const float*)d_in[19]; const float* b_rg = (const float*)d_in[20]; const float* w_re = (const float*)d_in[21]; const float* b_re2 = (const float*)d_in[22];
    const float* w_eg = (const float*)d_in[23]; const float* w_eu = (const float*)d_in[24]; const float* w_ed = (const float*)d_in[25];
    const float* norm_ple = (const float*)d_in[26]; const float* w_pg = (const float*)d_in[27]; const float* w_ple = (const float*)d_in[28]; const float* norm_f = (const float*)d_in[29];
    float* out = (float*)d_out;
    float* ws = (float*)d_ws;
    const size_t need = ((size_t)T * D + (size_t)T * INC + 2 * (size_t)T * RW) * 4 + (1u << 23);
    if (ws_size < need) { fprintf(stderr, "kernel_launch: ws too small %zu < %zu\n", ws_size, need); return; }
    float* H = ws;
    float* PROJ = H + (size_t)T * D;
    float* YRET = PROJ + (size_t)T * INC;
    float* YSSM = YRET + (size_t)T * RW;
    int* ctl = (int*)(YSSM + (size_t)T * SW);
    int* cnt = ctl; int* off = ctl + 64; float* wgt = (float*)(ctl + 128); int* list = ctl + 128 + 2 * T; int* tokidx = list + (size_t)NE * T;
    float* KV = out;
    float* YPRE = out;
    float* GATES = PROJ; float* MERGED = H; float* ACT = YRET; float* MOE = PROJ; float* PP = PROJ;

    hipMemsetAsync(cnt, 0, 128 * sizeof(int), stream);
    hipLaunchKernelGGL(k_rmsnorm, dim3(T), dim3(256), 0, stream, x, norm_mix, H);
    gemm<EpiStore, false>(stream, GArgs{H, w_in, nullptr, nullptr, nullptr, 0, 0, D, INC, T, INC, D, 0}, EpiStore{PROJ, INC});
    hipLaunchKernelGGL(k_rope, dim3(T * 2 * NH * 64 / 256), dim3(256), 0, stream, PROJ);
    hipLaunchKernelGGL(k_ret_kv, dim3(NCH * NH), dim3(256), 0, stream, (const float*)PROJ, KV);
    hipLaunchKernelGGL(k_ret_scan, dim3(NH * DH * DH / 256), dim3(256), 0, stream, KV);
    {
        static bool attr = false; const int lds = (2 * 64 * 129 + 64 * 65) * 4;
        if (!attr) { hipFuncSetAttribute((const void*)k_ret_out, hipFuncAttributeMaxDynamicSharedMemorySize, lds); attr = true; }
        hipLaunchKernelGGL(k_ret_out, dim3(NCH * NH), dim3(256), lds, stream, (const float*)PROJ, (const float*)KV, YRET);
    }
    hipLaunchKernelGGL(k_ret_norm, dim3(T * NH / 4), dim3(256), 0, stream, YRET, (const float*)PROJ, gnw);
    hipLaunchKernelGGL(k_s5, dim3(SG), dim3(64), 0, stream, (const float*)PROJ, lam_re, lam_im, log_dt, b_re, b_im, c_re, c_im, ssm_d, YPRE);
    gemm<EpiGlu, false>(stream, GArgs{YPRE, w_glu, nullptr, nullptr, nullptr, 0, 0, SW, SW, T, SW, SW, 0}, EpiGlu{YPRE, YSSM, SW});
    gemm<EpiSigm, false>(stream, GArgs{H, w_merge, nullptr, nullptr, nullptr, 0, 0, D, 2 * D, T, 2 * D, D, 0}, EpiSigm{GATES, 2 * D});
    gemm<EpiMerge, false>(stream, GArgs{YRET, w_a, nullptr, nullptr, nullptr, 0, 0, RW, D, T, D, RW, 0}, EpiMerge{GATES, MERGED, 2 * D, D, 0, 0});
    gemm<EpiMerge, false>(stream, GArgs{YSSM, w_b, nullptr, nullptr, nullptr, 0, 0, SW, D, T, D, SW, 0}, EpiMerge{GATES + D, MERGED, 2 * D, D, 1, 0});
    gemm<EpiResid, false>(stream, GArgs{MERGED, w_out, nullptr, nullptr, nullptr, 0, 0, D, D, T, D, D, 0}, EpiResid{x, out, D});
    hipLaunchKernelGGL(k_rmsnorm, dim3(T), dim3(256), 0, stream, (const float*)out, norm_ffn, H);
    hipLaunchKernelGGL(k_router, dim3(T / 4), dim3(256), 0, stream, (const float*)H, w_rg, b_rg, w_re, b_re2, cnt, list, wgt);
    hipLaunchKernelGGL(k_offsets, dim3(1), dim3(64), 0, stream, (const int*)cnt, off, tokidx, (const int*)list);
    hipLaunchKernelGGL(k_tokidx, dim3(16, NE), dim3(256), 0, stream, (const int*)cnt, (const int*)list, tokidx);
    gemm<EpiGateUp, true>(stream, GArgs{H, w_eg, w_eu, tokidx, cnt, (long)D * FE, (long)T, D, FE, T, FE, D, 0}, EpiGateUp{ACT, off}, NE, T);
    hipLaunchKernelGGL(k_fillidx, dim3(16, NE), dim3(256), 0, stream, (const int*)cnt, (const int*)off, tokidx);
    gemm<EpiDown, false>(stream, GArgs{ACT, w_ed, nullptr, tokidx, cnt, (long)FE * D, (long)T, FE, D, T, D, FE, 0}, EpiDown{MOE, list, wgt}, NE, T);
    hipLaunchKernelGGL(k_moe_combine, dim3(T), dim3(256), 0, stream, out, (const float*)MOE, norm_ple, H);
    gemm<EpiStore, false>(stream, GArgs{p, w_ple, nullptr, nullptr, nullptr, 0, 0, PLE, D, T, D, PLE, 0}, EpiStore{PP, D});
    gemm<EpiPle, false>(stream, GArgs{H, w_pg, nullptr, nullptr, nullptr, 0, 0, D, D, T, D, D, 0}, EpiPle{PP, out, D});
    hipLaunchKernelGGL(k_rmsnorm, dim3(T), dim3(256), 0, stream, (const float*)out, norm_f, out);
}
```

```cpp
#include <hip/hip_runtime.h>
#include <math.h>
#include <stdio.h>
#include <stdint.h>
namespace pg8 {
#define PG8_LAS __attribute__((address_space(3)))
typedef unsigned short bf16_t;
typedef short bf16x8 __attribute__((ext_vector_type(8)));
typedef float f32x4 __attribute__((ext_vector_type(4)));
typedef float f32x2 __attribute__((ext_vector_type(2)));
typedef unsigned u32x4 __attribute__((ext_vector_type(4)));
typedef unsigned u32x2 __attribute__((ext_vector_type(2)));
constexpr int BM = 256, BK = 64, HALF = 128, HTB = HALF * BK * 2  , STAGE_BYTES = 8 * HTB, NXCD = 8, WGM = 8;

__host__ __device__ __forceinline__ int lds_byte(int r, int c) { const int st = (r >> 4) * 2 + (c >> 5), rr = r & 15, cc = c & 31, ob = rr * 64 + cc * 2; return st * 1024 + (ob ^ (((ob >> 9) & 1) << 5)); }
__host__ __device__ __forceinline__ void stage_rc(int b, int& R, int& C) { const int st = b / 1024, sb = b % 1024, swz = sb ^ (((sb >> 9) & 1) << 5); R = (st >> 1) * 16 + swz / 64; C = (st & 1) * 32 + (swz % 64) / 2; }
__host__ __device__ __forceinline__ int perm32(int rho) { const int n = rho >> 4, i = rho & 15; return 8 * (i >> 2) + 4 * n + (i & 3); }

struct Unit { int pm, pn, z; };
__device__ __forceinline__ const char* uptr(const char* p) {
    const unsigned long long v = (unsigned long long)p; const unsigned lo = __builtin_amdgcn_readfirstlane((unsigned)v), hi = __builtin_amdgcn_readfirstlane((unsigned)(v >> 32));
    return (const char*)(((unsigned long long)hi << 32) | lo); }

__device__ __forceinline__ void tile_of(int L, int nM, int nN, int& pm, int& pn) {
    const int nwg = nM * nN; int wgid = L; { const int q = nwg / NXCD, r = nwg % NXCD, xcd = wgid % NXCD, off = wgid / NXCD; wgid = (xcd < r ? xcd * (q + 1) : r * (q + 1) + (xcd - r) * q) + off; }
    const int nig = WGM * nN, gid = wgid / nig, fm = gid * WGM, gsz = (nM - fm) < WGM ? (nM - fm) : WGM;
    pm = fm + ((wgid % nig) % gsz); pn = (wgid % nig) / gsz;
}
struct SchedPlain {
    static constexpr bool GATHER = false;
    const char* A; const char* B; unsigned lda2, ldb2; int nM, nN, G, c;
    __device__ __forceinline__ void init(const void* A_, int lda, const void* B_, int ldb, int M, int N, int G_, int c_) { A = (const char*)A_; B = (const char*)B_; lda2 = lda * 2; ldb2 = ldb * 2; nM = M / BM; nN = N / BM; G = G_; c = c_; }
    __device__ __forceinline__ bool next(int i, Unit& u) const { const int L = i * G + c; if (L >= nM * nN) return false; tile_of(L, nM, nN, u.pm, u.pn); u.z = 0; return true; }
    __device__ __forceinline__ const char* a_ptr(const Unit& u) const { return A + (size_t)u.pm * BM * lda2; }
    __device__ __forceinline__ const char* b_ptr(const Unit& u) const { return B + (size_t)u.pn * BM * ldb2; }
    __device__ __forceinline__ void a_off(const Unit&, const int (&R)[2], const int (&C)[2], unsigned (&v)[2][2]) const {
#pragma unroll
        for (int h = 0; h < 2; ++h)
#pragma unroll
            for (int i = 0; i < 2; ++i) v[h][i] = (unsigned)(h * HALF + R[i]) * lda2 + (unsigned)C[i] * 2u; }
};
struct SchedBatch {
    static constexpr bool GATHER = false;
    const char* A; const char* B; unsigned lda2, ldb2; size_t sA, sB; int nMz, nz, G, c;
    __device__ __forceinline__ bool next(int i, Unit& u) const { const int L = i * G + c; if (L >= nMz * nz) return false; u.z = L >> 2; u.pm = L & 3; u.pn = 0; return true; }
    __device__ __forceinline__ const char* a_ptr(const Unit& u) const { return A + (size_t)u.z * sA + (size_t)u.pm * BM * lda2; }
    __device__ __forceinline__ const char* b_ptr(const Unit& u) const { return B + (size_t)u.z * sB; }
    __device__ __forceinline__ void a_off(const Unit&, const int (&R)[2], const int (&C)[2], unsigned (&v)[2][2]) const {
#pragma unroll
        for (int h = 0; h < 2; ++h)
#pragma unroll
            for (int i = 0; i < 2; ++i) v[h][i] = (unsigned)(h * HALF + R[i]) * lda2 + (unsigned)C[i] * 2u; }
};
struct SchedTwoPass {
    static constexpr bool GATHER = false;
    const char* A0; const char* A1; const char* B0; const char* B1; unsigned lda2, ldb2; int nM, nN, G, c;
    __device__ __forceinline__ bool next(int i, Unit& u) const { const int L = (i >> 1) * G + c; if (L >= nM * nN) return false; tile_of(L, nM, nN, u.pm, u.pn); u.z = i & 1; return true; }
    __device__ __forceinline__ const char* a_ptr(const Unit& u) const { return (u.z ? A1 : A0) + (size_t)u.pm * BM * lda2; }
    __device__ __forceinline__ const char* b_ptr(const Unit& u) const { return (u.z ? B1 : B0) + (size_t)u.pn * BM * ldb2; }
    __device__ __forceinline__ void a_off(const Unit&, const int (&R)[2], const int (&C)[2], unsigned (&v)[2][2]) const {
#pragma unroll
        for (int h = 0; h < 2; ++h)
#pragma unroll
            for (int i = 0; i < 2; ++i) v[h][i] = (unsigned)(h * HALF + R[i]) * lda2 + (unsigned)C[i] * 2u; }
};

typedef float f32x2_t __attribute__((ext_vector_type(2))); typedef __bf16 bf16x2_t __attribute__((ext_vector_type(2)));
__device__ __forceinline__ unsigned cvt_pk_bf16(float lo, float hi) { f32x2_t v = {lo, hi}; bf16x2_t b = __builtin_convertvector(v, bf16x2_t); return __builtin_bit_cast(unsigned, b); }
__device__ __forceinline__ float bf_lo(unsigned w) { return __uint_as_float(w << 16); }
__device__ __forceinline__ float bf_hi(unsigned w) { return __uint_as_float(w & 0xffff0000u); }
__device__ __forceinline__ float fsigm(float x) { return __builtin_amdgcn_rcpf(1.f + __builtin_amdgcn_exp2f(-1.4426950408889634f * x)); }
__device__ __forceinline__ u32x4 pack8(const f32x4& a, const f32x4& b) { u32x4 w; w.x = cvt_pk_bf16(a[0], a[1]); w.y = cvt_pk_bf16(a[2], a[3]); w.z = cvt_pk_bf16(b[0], b[1]); w.w = cvt_pk_bf16(b[2], b[3]); return w; }
__device__ __forceinline__ void unpack8(const u32x4& w, f32x4& a, f32x4& b) { a = (f32x4){bf_lo(w.x), bf_hi(w.x), bf_lo(w.y), bf_hi(w.y)}; b = (f32x4){bf_lo(w.z), bf_hi(w.z), bf_lo(w.w), bf_hi(w.w)}; }

template <class Epi, class Sched, bool ALIGN_EPI = true>
__device__ __forceinline__ void gemm_phase(PG8_LAS unsigned char* lds, const int K, const Sched& S, const Epi& E) {
    const int tid = threadIdx.x, wid = __builtin_amdgcn_readfirstlane(tid >> 6), lane = tid & 63, wr = wid >> 2, wc = wid & 3, fr = lane & 15, fq = lane >> 4;
    const int nt = K / BK;
    int Rr[2], Cc[2]; unsigned voffB[2], voffA[2];
#pragma unroll
    for (int i = 0; i < 2; ++i) { stage_rc(tid * 16 + i * 8192, Rr[i], Cc[i]); const int Rb = Epi::PERM ? ((Rr[i] & ~31) + perm32(Rr[i] & 31)) : Rr[i];
        voffB[i] = (unsigned)Rb * S.ldb2 + (unsigned)Cc[i] * 2u; voffA[i] = (unsigned)Rr[i] * S.lda2 + (unsigned)Cc[i] * 2u; }
    const size_t ah = (size_t)HALF * S.lda2;
    const size_t kstep = (size_t)(BK * 2);
    const size_t bh = (size_t)HALF * S.ldb2;
    const unsigned ldsw = (unsigned)wid * 1024u;
    const int aoff = lds_byte(wr * 64 + fr, fq * 8), boff = lds_byte(wc * 32 + fr, fq * 8);
#define PG8_SA(b, h) (((b) * 2 + (h)) * HTB)
#define PG8_SB(b, h) ((4 + (b) * 2 + (h)) * HTB)
#define PG8_STAGE(bufoff, gbase, voff) do { _Pragma("unroll") for (int _i = 0; _i < 2; ++_i) \
        __builtin_amdgcn_global_load_lds((const unsigned*)((const char*)(gbase) + (voff)[_i]), (PG8_LAS unsigned*)(lds + (bufoff) + ldsw + _i * 8192), 16, 0, 0); } while (0)
#define PG8_STAGE_A(bufoff, h, gbase, VG) do { if constexpr (Sched::GATHER) { PG8_STAGE(bufoff, gbase, VG[h]); } else { PG8_STAGE(bufoff, (gbase) + (h) * ah, voffA); } } while (0)
#define PG8_LDA(dst, b, h) do { _Pragma("unroll") for (int m = 0; m < 4; ++m) _Pragma("unroll") for (int k = 0; k < 2; ++k) dst[m][k] = *(const PG8_LAS bf16x8*)(lds + PG8_SA(b, h) + aoff + m * 2048 + k * 1024); } while (0)
#define PG8_LDB(dst, b, h) do { _Pragma("unroll") for (int n = 0; n < 2; ++n) _Pragma("unroll") for (int k = 0; k < 2; ++k) dst[n][k] = *(const PG8_LAS bf16x8*)(lds + PG8_SB(b, h) + boff + n * 2048 + k * 1024); } while (0)
#define PG8_MMA(ai, bj, At, Bt) do { __builtin_amdgcn_s_setprio(1); _Pragma("unroll") for (int m = 0; m < 4; ++m) _Pragma("unroll") for (int n = 0; n < 2; ++n) _Pragma("unroll") for (int k = 0; k < 2; ++k) \
        acc[ai][bj][m][n] = __builtin_amdgcn_mfma_f32_16x16x32_bf16(Bt[n][k], At[m][k], acc[ai][bj][m][n], 0, 0, 0); __builtin_amdgcn_s_setprio(0); } while (0)
#define PG8_WAIT_V(n) asm volatile("s_waitcnt vmcnt(" #n ")" ::: "memory")
#define PG8_WAIT_L(n) asm volatile("s_waitcnt lgkmcnt(" #n ")" ::: "memory")
#define PG8_BAR __builtin_amdgcn_s_barrier()
#define PG8_SCHED __builtin_amdgcn_sched_barrier(0)
    Unit cur, nxt; int ui = 0;
    if (!S.next(0, cur)) return;
    f32x4 acc[2][2][4][2];
#pragma unroll
    for (int a = 0; a < 2; ++a)
#pragma unroll
        for (int b = 0; b < 2; ++b)
#pragma unroll
            for (int m = 0; m < 4; ++m)
#pragma unroll
                for (int n = 0; n < 2; ++n) acc[a][b][m][n] = (f32x4){0.f, 0.f, 0.f, 0.f};
    bf16x8 At[4][2], B0[2][2], B1[2][2];
    unsigned vAc[2][2], vAn[2][2];
    if constexpr (Sched::GATHER) S.a_off(cur, Rr, Cc, vAc);
    const char* cA = uptr(S.a_ptr(cur)); const char* cB = uptr(S.b_ptr(cur));
    PG8_STAGE(PG8_SB(0, 0), cB, voffB); PG8_STAGE(PG8_SB(0, 1), cB + bh, voffB); PG8_STAGE_A(PG8_SA(0, 0), 0, cA, vAc); PG8_STAGE_A(PG8_SA(0, 1), 1, cA, vAc);
    if (wr == 1) PG8_BAR;
    PG8_WAIT_V(2); PG8_BAR;
    PG8_STAGE(PG8_SB(1, 0), cB + kstep, voffB); PG8_STAGE_A(PG8_SA(1, 0), 0, cA + kstep, vAc); PG8_STAGE(PG8_SB(1, 1), cB + bh + kstep, voffB);
    PG8_WAIT_V(6); PG8_BAR;
    for (;;) {
        const bool has_next = S.next(ui + 1, nxt);
        const char* nA = cA; const char* nB = cB;
        if constexpr (Sched::GATHER) {
#pragma unroll
            for (int h = 0; h < 2; ++h)
#pragma unroll
                for (int i = 0; i < 2; ++i) vAn[h][i] = vAc[h][i]; }
        if (has_next) { nA = uptr(S.a_ptr(nxt)); nB = uptr(S.b_ptr(nxt)); if constexpr (Sched::GATHER) S.a_off(nxt, Rr, Cc, vAn); }
        for (int t = 0; t < nt; t += 2) {
            const bool last = (t == nt - 2);
            const char* a1 = cA + (size_t)(t + 1) * kstep;
            const char* a2 = last ? nA : cA + (size_t)(t + 2) * kstep; const char* b2 = last ? nB : cB + (size_t)(t + 2) * kstep;
            const char* a3 = a2 + kstep; const char* b3 = b2 + kstep;
            unsigned v2[2][2];
            if constexpr (Sched::GATHER) {
#pragma unroll
                for (int h = 0; h < 2; ++h)
#pragma unroll
                    for (int i = 0; i < 2; ++i) v2[h][i] = last ? vAn[h][i] : vAc[h][i]; }
            PG8_LDB(B0, 0, 0); PG8_LDB(B1, 0, 1); PG8_SCHED; PG8_LDA(At, 0, 0); PG8_STAGE_A(PG8_SA(1, 1), 1, a1, vAc);
            PG8_WAIT_V(8); PG8_WAIT_L(0); PG8_BAR; PG8_MMA(0, 0, At, B0); PG8_MMA(0, 1, At, B1); PG8_BAR; PG8_SCHED;
            PG8_LDA(At, 0, 1); PG8_STAGE(PG8_SB(0, 0), b2, voffB); PG8_STAGE(PG8_SB(0, 1), b2 + bh, voffB); PG8_STAGE_A(PG8_SA(0, 0), 0, a2, v2);
            PG8_WAIT_V(8); PG8_WAIT_L(0); PG8_BAR; PG8_MMA(1, 0, At, B0); PG8_MMA(1, 1, At, B1); PG8_BAR; PG8_SCHED;
            PG8_LDB(B0, 1, 0); PG8_LDB(B1, 1, 1); PG8_SCHED; PG8_LDA(At, 1, 0); PG8_STAGE_A(PG8_SA(0, 1), 1, a2, v2);
            PG8_WAIT_V(8); PG8_WAIT_L(0); PG8_BAR; PG8_MMA(0, 0, At, B0); PG8_MMA(0, 1, At, B1); PG8_BAR; PG8_SCHED;
            PG8_LDA(At, 1, 1); PG8_STAGE(PG8_SB(1, 0), b3, voffB); PG8_STAGE(PG8_SB(1, 1), b3 + bh, voffB); PG8_STAGE_A(PG8_SA(1, 0), 0, a3, v2);
            PG8_WAIT_V(8); PG8_WAIT_L(0); PG8_BAR; PG8_MMA(1, 0, At, B0); PG8_MMA(1, 1, At, B1); PG8_BAR; PG8_SCHED;
        }
        if constexpr (ALIGN_EPI) { if (wr == 0) PG8_BAR; }
        E(acc, cur, wr, wc, fr, fq);
        if (!has_next) break;
#pragma unroll
        for (int a = 0; a < 2; ++a)
#pragma unroll
            for (int b = 0; b < 2; ++b)
#pragma unroll
                for (int m = 0; m < 4; ++m)
#pragma unroll
                    for (int n = 0; n < 2; ++n) acc[a][b][m][n] = (f32x4){0.f, 0.f, 0.f, 0.f};
        cur = nxt; cA = nA; cB = nB; ++ui;
        if constexpr (Sched::GATHER) {
#pragma unroll
            for (int h = 0; h < 2; ++h)
#pragma unroll
                for (int i = 0; i < 2; ++i) vAc[h][i] = vAn[h][i]; }
        if constexpr (ALIGN_EPI) { if (wr == 1) PG8_BAR; }
    }
    PG8_WAIT_V(0);
    if constexpr (!ALIGN_EPI) { if (wr == 0) PG8_BAR; }
    PG8_BAR;
#undef PG8_SA
#undef PG8_SB
#undef PG8_STAGE
#undef PG8_STAGE_A
#undef PG8_LDA
#undef PG8_LDB
#undef PG8_MMA
#undef PG8_WAIT_V
#undef PG8_WAIT_L
#undef PG8_BAR
#undef PG8_SCHED
}
}

#define XB_TMO      128
#define XB_XCNT(j)  (256  + 64 * (j))
#define XB_XSUB(j)  (1280 + 64 * (j))
#define XB_XGEN(j)  (2304 + 64 * (j))
#define XB_TOP      3328
#define XB_TOPGEN   3392
#define XCD_BAR_WORDS 3456
#define XB_SPIN_CAP (1u << 18)
#define LAS __attribute__((address_space(3)))

__device__ __forceinline__ unsigned xb_ld(unsigned* p)              { return __hip_atomic_load(p, __ATOMIC_RELAXED, __HIP_MEMORY_SCOPE_AGENT); }
__device__ __forceinline__ unsigned xb_add(unsigned* p, unsigned v) { return __hip_atomic_fetch_add(p, v, __ATOMIC_RELAXED, __HIP_MEMORY_SCOPE_AGENT); }
__device__ __forceinline__ unsigned xb_xcc_id() { return (unsigned)__builtin_amdgcn_s_getreg((3 << 11) | 20) & 0xFu; }
#define XB_SPIN(cond, bar) do { unsigned _sp = 0; while (cond) { __builtin_amdgcn_s_sleep(1); \
    if ((++_sp & 255u) == 0u) { if (xb_ld(&(bar)[XB_TMO])) break; if (_sp > XB_SPIN_CAP) { atomicAdd(&(bar)[XB_TMO], 1u); break; } } } } while (0)

struct XcdBarrier {
    unsigned* bar; unsigned x;
    volatile LAS unsigned* st;
};

__device__ __forceinline__ XcdBarrier xcd_barrier_post(unsigned* bar, volatile LAS unsigned* st) {
    XcdBarrier b; b.bar = bar; b.x = xb_xcc_id(); b.st = st;
    if (threadIdx.x == 0) (void)xb_add(&bar[XB_XCNT(b.x)], 1u);
    return b;
}
__device__ __forceinline__ void xcd_barrier_complete(unsigned* bar, unsigned x, unsigned& nloc, unsigned& nx) {
    const unsigned G = gridDim.x * gridDim.y * gridDim.z;
    unsigned sum, cnt, mine, sp = 0u;
    for (;;) {
        sum = 0u; cnt = 0u; mine = 0u;
#pragma unroll
        for (unsigned j = 0; j < 16; ++j) { const unsigned c = xb_ld(&bar[XB_XCNT(j)]); sum += c; cnt += (c > 0u) ? 1u : 0u; mine = (j == x) ? c : mine; }
        if (sum == G) break;
        __builtin_amdgcn_s_sleep(1);
        if ((++sp & 255u) == 0u) { if (xb_ld(&bar[XB_TMO])) break; if (sp > XB_SPIN_CAP) { atomicAdd(&bar[XB_TMO], 1u); break; } }
    }
    nloc = mine > 0u ? mine : 1u; nx = cnt > 0u ? cnt : 1u;
}

__device__ __forceinline__ void xcd_barrier(const XcdBarrier& b) {
    asm volatile("s_waitcnt vmcnt(0)" ::: "memory");
    __syncthreads();
    if (threadIdx.x == 0) {
        unsigned* bar = b.bar;
        __builtin_amdgcn_s_waitcnt(0);
        unsigned nloc = b.st[0], nx = b.st[1];
        if (nloc == 0u) { xcd_barrier_complete(bar, b.x, nloc, nx); b.st[0] = nloc; b.st[1] = nx; }
        const unsigned old = xb_add(&bar[XB_XSUB(b.x)], 1u);
        const unsigned gen = old / nloc;
        if (old + 1u == (gen + 1u) * nloc) {
            __builtin_amdgcn_fence(__ATOMIC_RELEASE, "agent");
            asm volatile("s_waitcnt vmcnt(0)" ::: "memory");
            const unsigned og = xb_add(&bar[XB_TOP], 1u);
            const unsigned tg = og / nx;
            if (og + 1u == (tg + 1u) * nx) xb_add(&bar[XB_TOPGEN], 1u);
            else XB_SPIN(xb_ld(&bar[XB_TOPGEN]) == tg, bar);
            __builtin_amdgcn_fence(__ATOMIC_ACQUIRE, "agent");
            xb_add(&bar[XB_XGEN(b.x)], 1u);
            asm volatile("s_waitcnt vmcnt(0)" ::: "memory");
        } else {
            XB_SPIN(xb_ld(&bar[XB_XGEN(b.x)]) == gen, bar);
            __builtin_amdgcn_fence(__ATOMIC_ACQUIRE, "agent");
            asm volatile("s_waitcnt vmcnt(0)" ::: "memory");
        }
    }
    __syncthreads();
}


constexpr int NWAVES = 8;
constexpr int T = 16384, D = 2048, RW = 1024, NH = 8, DH = 128, SG = 64, SP = 64, SC = 16, NE = 32, FE = 512, PLE = 256, INC = 5120;
constexpr int N1 = 9216;
constexpr int S5L = 16, S5NC = T / S5L, S5K = 384;
constexpr int RSC = 32, RCH = 8;
constexpr float EPS = 1e-6f;

constexpr size_t MiB = 1u << 20;
constexpr size_t WS_CTL = 0, CTL_ZERO_BYTES = 1 * MiB;
constexpr size_t WS_LIST = 1 * MiB, WS_WGT = 3 * MiB, WS_RINV = 3 * MiB + 256 * 1024, WS_LAM = 3 * MiB + 512 * 1024;
constexpr size_t WS_COS = 4 * MiB, WS_SIN = 8 * MiB, WS_PB = 12 * MiB;
constexpr size_t WS_WT1 = 20 * MiB, WS_WGLU = 56 * MiB, WS_WA = 58 * MiB, WS_WB = 62 * MiB, WS_WOUT = 66 * MiB, WS_WPG = 74 * MiB, WS_WP = 82 * MiB, WS_BTC = 83 * MiB, WS_BLT = 95 * MiB;
constexpr size_t WS_HB = 100 * MiB, WS_YRET = 100 * MiB, WS_YPRE = 132 * MiB;
constexpr size_t WS_Q = 164 * MiB, WS_K = 196 * MiB, WS_V = 228 * MiB, WS_G = 260 * MiB, WS_UA = 292 * MiB, WS_EST = 340 * MiB, WS_KVS = 372 * MiB;
constexpr size_t WS_MERGED = 164 * MiB, WS_YSSM = 228 * MiB;
constexpr size_t WS_END = 600 * MiB;
constexpr int CW_TMO = 0, CW_CODE = 1, CW_BAR = 4096, CW_Q0 = 8192  , CW_CNT = 8256  ;

constexpr int RING_OFF = 0, RING_BYTES = 131072;
constexpr int LDSCTL_OFF = RING_BYTES, MISC_OFF = LDSCTL_OFF + 320;
constexpr int LDS_BYTES = 147456;

#define GAS __attribute__((address_space(1)))
typedef unsigned short bf16;
typedef unsigned v4u __attribute__((ext_vector_type(4)));
typedef unsigned v2u __attribute__((ext_vector_type(2)));
typedef float f32x4 __attribute__((ext_vector_type(4)));
typedef short bf16x8 __attribute__((ext_vector_type(8)));
typedef short s16x4 __attribute__((ext_vector_type(4)));
typedef short v4i16_t __attribute__((ext_vector_type(4)));
typedef GAS unsigned gu32;
#define RLX_AGENT __ATOMIC_RELAXED, __HIP_MEMORY_SCOPE_AGENT
#define LDS_WAIT() asm volatile("s_waitcnt lgkmcnt(0)" ::: "memory")
#define VM_WAIT() asm volatile("s_waitcnt vmcnt(0)" ::: "memory")
using pg8::cvt_pk_bf16; using pg8::bf_lo; using pg8::bf_hi; using pg8::fsigm;

struct Frame {
    LAS unsigned char* lds;
    volatile LAS unsigned* MISC;
    unsigned* ctl;
    int tid, lane, wave, G;
};
__device__ __forceinline__ float wave_sum(float v) {
#pragma unroll
    for (int o = 1; o < 64; o <<= 1) v += __shfl_xor(v, o);
    return v;
}
__device__ __forceinline__ int wg_next_item(Frame& F, unsigned* ctr) {
    __syncthreads();
    if (F.tid == 0) F.MISC[16] = __hip_atomic_fetch_add(ctr, 1u, RLX_AGENT);
    __syncthreads();
    return (int)F.MISC[16];
}

template <int MODE>
__device__ __forceinline__ void transpose_item(const float* W, int K, int N, bf16* WT, int ldt, int row_off, LAS float* scr, int item, int lane) {
    const int nblk = N / 32, kb = item / nblk, nb = item % nblk, k0 = 64 * kb, n0 = 32 * nb;
#pragma unroll 8
    for (int i = 0; i < 32; ++i) { const int kk = 2 * i + (lane >> 5); scr[kk * 33 + (lane & 31)] = W[(size_t)(k0 + kk) * N + n0 + (lane & 31)]; }
    LDS_WAIT(); asm volatile("" ::: "memory");
    const int c = lane & 7;
#pragma unroll
    for (int j = 0; j < 4; ++j) { const int n = (lane >> 3) + 8 * j; const LAS float* s = scr + (8 * c) * 33 + n;
        v4u o; o.x = cvt_pk_bf16(s[0 * 33], s[1 * 33]); o.y = cvt_pk_bf16(s[2 * 33], s[3 * 33]); o.z = cvt_pk_bf16(s[4 * 33], s[5 * 33]); o.w = cvt_pk_bf16(s[6 * 33], s[7 * 33]);
        const int nn = n0 + n; const int row = MODE == 0 ? row_off + nn : (MODE == 1 ? 8 * (nn >> 2) + (nn & 3) : 8 * (nn >> 2) + 4 + (nn & 3));
        *(GAS v4u*)(WT + (size_t)row * ldt + k0 + 8 * c) = o; }
    LDS_WAIT(); asm volatile("" ::: "memory");
}
__device__ __forceinline__ void rms_row_to_bf16(int lane, const float* xrow, const float* w, bf16* orow) {
    const GAS f32x4* xr = (const GAS f32x4*)xrow + lane; const GAS f32x4* wr = (const GAS f32x4*)w + lane;
    f32x4 v[8]; float s = 0.f;
#pragma unroll
    for (int j = 0; j < 8; ++j) { v[j] = xr[64 * j]; s += (v[j].x * v[j].x + v[j].y * v[j].y) + (v[j].z * v[j].z + v[j].w * v[j].w); }
    const float r = rsqrtf(wave_sum(s) * (1.f / D) + EPS);
    GAS v2u* o8 = (GAS v2u*)orow + lane;
#pragma unroll
    for (int j = 0; j < 8; ++j) { const f32x4 ww = wr[64 * j]; v2u o; o.x = cvt_pk_bf16(v[j].x * r * ww.x, v[j].y * r * ww.y); o.y = cvt_pk_bf16(v[j].z * r * ww.z, v[j].w * r * ww.w); o8[64 * j] = o; }
}
__device__ __forceinline__ void s5_tables(Frame& F, int g, const float* lam_re, const float* lam_im, const float* log_dt, const float* b_re, const float* b_im, const float* c_re, const float* c_im, const float* dvec,
                                          bf16* BTC, bf16* BLT, float* LAMT) {
    LAS double* PW = (LAS double*)(F.lds);
    LAS double* BB = (LAS double*)(F.lds + 17408);
    LAS double* CC = (LAS double*)(F.lds + 33792);
    LAS float* KM = (LAS float*)(F.lds + 50176);
    const int tid = F.tid;
    if (tid < 64) {
        const int p = tid; const double lr = fmin((double)lam_re[g * SP + p], -1e-4), li = (double)lam_im[g * SP + p], dt = exp((double)log_dt[g]);
        for (int j = 0; j <= 16; ++j) { const double mag = exp((double)j * lr * dt); double sn, cs; sincos((double)j * li * dt, &sn, &cs); PW[(j * 64 + p) * 2] = mag * cs; PW[(j * 64 + p) * 2 + 1] = mag * sn; }
        { const double mag = exp(512.0 * lr * dt); double sn, cs; sincos(512.0 * li * dt, &sn, &cs);
          LAMT[(g * 64 + p) * 4 + 2] = (float)(mag * cs); LAMT[(g * 64 + p) * 4 + 3] = (float)(mag * sn); }
        const double lbr = PW[(1 * 64 + p) * 2], lbi = PW[(1 * 64 + p) * 2 + 1];
        LAMT[(g * 64 + p) * 4 + 0] = (float)PW[(16 * 64 + p) * 2]; LAMT[(g * 64 + p) * 4 + 1] = (float)PW[(16 * 64 + p) * 2 + 1];
        const double nr = lbr - 1.0, ni = lbi, den = lr * lr + li * li; const double fr = (nr * lr + ni * li) / den, fi = (ni * lr - nr * li) / den;
        for (int c = 0; c < 16; ++c) { const double br = b_re[(g * SP + p) * SC + c], bi = b_im[(g * SP + p) * SC + c]; BB[(p * 16 + c) * 2] = fr * br - fi * bi; BB[(p * 16 + c) * 2 + 1] = fr * bi + fi * br; }
    }
    for (int idx = tid; idx < 1024; idx += 512) { const int c = idx >> 6, p = idx & 63; CC[idx * 2] = (double)c_re[(g * SC + c) * SP + p]; CC[idx * 2 + 1] = (double)c_im[(g * SC + c) * SP + p]; }
    __syncthreads();
    for (int idx = tid; idx < 4096; idx += 512) { const int j = idx >> 8, c = (idx >> 4) & 15, c2 = idx & 15; double s = 0.0;
        for (int p = 0; p < 64; ++p) { const double cr = CC[(c * 64 + p) * 2], ci = CC[(c * 64 + p) * 2 + 1], pr = PW[(j * 64 + p) * 2], pi = PW[(j * 64 + p) * 2 + 1];
            const double ar = cr * pr - ci * pi, ai = cr * pi + ci * pr; s += ar * BB[(p * 16 + c2) * 2] - ai * BB[(p * 16 + c2) * 2 + 1]; }
        if (j == 0 && c == c2) s += (double)dvec[g * SC + c];
        KM[idx] = (float)s; }
    __syncthreads();
    for (int idx = tid; idx < 256 * 48; idx += 512) { const int n = idx / 48, kc = idx % 48, s = n >> 4, c = n & 15; float v[8];
        if (kc < 32) { const int t = kc >> 1, c0 = (kc & 1) * 8;
#pragma unroll
            for (int j = 0; j < 8; ++j) v[j] = (t <= s) ? KM[((s - t) * 16 + c) * 16 + c0 + j] : 0.f;
        } else { const int q = kc - 32, part = q >> 3, p0 = (q & 7) * 8;
#pragma unroll
            for (int j = 0; j < 8; ++j) { const int p = p0 + j; const double cr = CC[(c * 64 + p) * 2], ci = CC[(c * 64 + p) * 2 + 1], pr = PW[((s + 1) * 64 + p) * 2], pi = PW[((s + 1) * 64 + p) * 2 + 1];
                v[j] = part ? (float)(-(cr * pi + ci * pr)) : (float)(cr * pr - ci * pi); } }
        v4u o; o.x = cvt_pk_bf16(v[0], v[1]); o.y = cvt_pk_bf16(v[2], v[3]); o.z = cvt_pk_bf16(v[4], v[5]); o.w = cvt_pk_bf16(v[6], v[7]);
        *(GAS v4u*)(BTC + ((size_t)(g * 256 + n) * S5K + kc * 8)) = o; }
    for (int idx = tid; idx < 128 * 32; idx += 512) { const int n = idx >> 5, kc = idx & 31, p = n & 63, part = n >> 6, t = kc >> 1, c0 = (kc & 1) * 8; float v[8];
        const double pr = PW[((15 - t) * 64 + p) * 2], pi = PW[((15 - t) * 64 + p) * 2 + 1];
#pragma unroll
        for (int j = 0; j < 8; ++j) { const double br = BB[(p * 16 + c0 + j) * 2], bi = BB[(p * 16 + c0 + j) * 2 + 1]; v[j] = part ? (float)(pr * bi + pi * br) : (float)(pr * br - pi * bi); }
        v4u o; o.x = cvt_pk_bf16(v[0], v[1]); o.y = cvt_pk_bf16(v[2], v[3]); o.z = cvt_pk_bf16(v[4], v[5]); o.w = cvt_pk_bf16(v[6], v[7]);
        *(GAS v4u*)(BLT + ((size_t)(g * 128 + n) * 256 + kc * 8)) = o; }
    __syncthreads();
}

using pg8::Unit; using pg8::pack8; using pg8::unpack8;
struct EpiProj {
    static constexpr bool PERM = true;
    bf16* QKVG; bf16* UA; bf16* GATES;
    __device__ __forceinline__ void operator()(const f32x4 (&acc)[2][2][4][2], const Unit& u, int wr, int wc, int fr, int fq) const {
        const int row0 = u.pm * 256 + wr * 64 + fr, ct = wc * 32 + 8 * fq;
        if (u.pn < 16) { bf16* dst = QKVG + (size_t)(u.pn >> 2) * T * RW + (u.pn & 3) * 256 + ct;
#pragma unroll
            for (int ai = 0; ai < 2; ++ai)
#pragma unroll
                for (int m = 0; m < 4; ++m) { const size_t row = row0 + ai * 128 + m * 16;
#pragma unroll
                    for (int bj = 0; bj < 2; ++bj) *(v4u*)(dst + row * RW + bj * 128) = pack8(acc[ai][bj][m][0], acc[ai][bj][m][1]); }
        } else if (u.pn < 20) {
#pragma unroll
            for (int ai = 0; ai < 2; ++ai)
#pragma unroll
                for (int m = 0; m < 4; ++m) { const int row = row0 + ai * 128 + m * 16, ci = row >> 4, s = row & 15;
#pragma unroll
                    for (int bj = 0; bj < 2; ++bj) { const int cu = (u.pn - 16) * 256 + bj * 128 + ct, g = cu >> 4, c0 = cu & 15;
                        *(v4u*)(UA + ((size_t)(g * S5NC + ci) * S5K + 16 * s + c0)) = pack8(acc[ai][bj][m][0], acc[ai][bj][m][1]); } }
        } else { bf16* dst = GATES + (u.pn - 20) * 256 + ct;
#pragma unroll
            for (int ai = 0; ai < 2; ++ai)
#pragma unroll
                for (int m = 0; m < 4; ++m) { const size_t row = row0 + ai * 128 + m * 16;
#pragma unroll
                    for (int bj = 0; bj < 2; ++bj) { f32x4 a = acc[ai][bj][m][0], b = acc[ai][bj][m][1];
#pragma unroll
                        for (int j = 0; j < 4; ++j) { a[j] = fsigm(a[j]); b[j] = fsigm(b[j]); }
                        *(v4u*)(dst + row * 4096 + bj * 128) = pack8(a, b); } }
        }
    }
};
struct EpiS5A {
    static constexpr bool PERM = false;
    float* EST;
    __device__ __forceinline__ void operator()(const f32x4 (&acc)[2][2][4][2], const Unit& u, int wr, int wc, int fr, int fq) const {
        const int row0 = u.pm * 256 + wr * 64 + fr, col0 = wc * 32 + 4 * fq;
#pragma unroll
        for (int ai = 0; ai < 2; ++ai)
#pragma unroll
            for (int m = 0; m < 4; ++m) { float* rowp = EST + ((size_t)u.z * S5NC + row0 + ai * 128 + m * 16) * 128 + col0;
#pragma unroll
                for (int n = 0; n < 2; ++n) *(f32x4*)(rowp + n * 16) = acc[ai][0][m][n]; }
    }
};
struct EpiS5C {
    static constexpr bool PERM = true;
    bf16* YPRE;
    __device__ __forceinline__ void operator()(const f32x4 (&acc)[2][2][4][2], const Unit& u, int wr, int wc, int fr, int fq) const {
        const int row0 = u.pm * 256 + wr * 64 + fr, ct = wc * 32 + 8 * fq;
        bf16* yb = YPRE + ((size_t)row0 * 16 * RW + u.z * 16);
#pragma unroll
        for (int ai = 0; ai < 2; ++ai)
#pragma unroll
            for (int m = 0; m < 4; ++m) {
#pragma unroll
                for (int bj = 0; bj < 2; ++bj) { const int col = bj * 128 + ct, s = col >> 4, c0 = col & 15;
                    f32x4 a = acc[ai][bj][m][0], b = acc[ai][bj][m][1];
#pragma unroll
                    for (int j = 0; j < 4; ++j) { const float xa = a[j], xb = b[j];
                        a[j] = xa * fsigm(1.5957691216057308f * (xa + 0.044715f * xa * xa * xa)); b[j] = xb * fsigm(1.5957691216057308f * (xb + 0.044715f * xb * xb * xb)); }
                    *(v4u*)(yb + (size_t)(ai * 128 + m * 16) * 16 * RW + (size_t)s * RW + c0) = pack8(a, b); } }
    }
};
struct EpiGlu {
    static constexpr bool PERM = true;
    const bf16* YPRE; bf16* YSSM;
    __device__ __forceinline__ void operator()(const f32x4 (&acc)[2][2][4][2], const Unit& u, int wr, int wc, int fr, int fq) const {
        const int row0 = u.pm * 256 + wr * 64 + fr, col0 = u.pn * 256 + wc * 32 + 8 * fq;
#pragma unroll
        for (int ai = 0; ai < 2; ++ai)
#pragma unroll
            for (int m = 0; m < 4; ++m) { const size_t off = (size_t)(row0 + ai * 128 + m * 16) * RW + col0;
#pragma unroll
                for (int bj = 0; bj < 2; ++bj) { const v4u yw = *(const v4u*)(YPRE + off + bj * 128); f32x4 y0, y1; unpack8(yw, y0, y1);
                    f32x4 a = acc[ai][bj][m][0], b = acc[ai][bj][m][1];
#pragma unroll
                    for (int j = 0; j < 4; ++j) { a[j] = y0[j] * fsigm(a[j]); b[j] = y1[j] * fsigm(b[j]); }
                    *(v4u*)(YSSM + off + bj * 128) = pack8(a, b); }
                if (m & 1) asm volatile("" ::: "memory"); }
    }
};
struct EpiMerge {
    static constexpr bool PERM = true;
    const bf16* GATES; bf16* MERGED;
    __device__ __forceinline__ void operator()(const f32x4 (&acc)[2][2][4][2], const Unit& u, int wr, int wc, int fr, int fq) const {
        const int row0 = u.pm * 256 + wr * 64 + fr, col0 = u.pn * 256 + wc * 32 + 8 * fq;
#pragma unroll
        for (int ai = 0; ai < 2; ++ai)
#pragma unroll
            for (int m = 0; m < 4; ++m) { const size_t row = row0 + ai * 128 + m * 16;
#pragma unroll
                for (int bj = 0; bj < 2; ++bj) { const v4u gw = *(const v4u*)(GATES + row * 4096 + u.z * 2048 + col0 + bj * 128); f32x4 g0, g1; unpack8(gw, g0, g1);
                    f32x4 a = acc[ai][bj][m][0] * g0, b = acc[ai][bj][m][1] * g1;
                    bf16* mp = MERGED + row * D + col0 + bj * 128;
                    if (u.z) { const v4u pw = *(const v4u*)mp; f32x4 p0, p1; unpack8(pw, p0, p1); a += p0; b += p1; }
                    *(v4u*)mp = pack8(a, b); }
                if (m & 1) asm volatile("" ::: "memory"); }
    }
};
struct EpiOut {
    static constexpr bool PERM = false;
    const float* X; float* O;
    __device__ __forceinline__ void operator()(const f32x4 (&acc)[2][2][4][2], const Unit& u, int wr, int wc, int fr, int fq) const {
        const int row0 = u.pm * 256 + wr * 64 + fr, col0 = u.pn * 256 + wc * 32 + 4 * fq;
#pragma unroll
        for (int ai = 0; ai < 2; ++ai)
#pragma unroll
            for (int m = 0; m < 4; ++m) { const size_t off = (size_t)(row0 + ai * 128 + m * 16) * D + col0;
#pragma unroll
                for (int bj = 0; bj < 2; ++bj)
#pragma unroll
                    for (int n = 0; n < 2; ++n) { const f32x4 xv = *(const f32x4*)(X + off + bj * 128 + n * 16); *(f32x4*)(O + off + bj * 128 + n * 16) = xv + acc[ai][bj][m][n]; }
                asm volatile("" ::: "memory"); }
    }
};

__device__ __forceinline__ unsigned off_b(unsigned row, unsigned ch) { return 256u * row + 16u * (ch ^ (((row & 3) << 2) | ((row >> 2) & 3))); }
__device__ __forceinline__ unsigned rrow16(unsigned lane, unsigned rb, unsigned s) { return off_b((lane & 15) + 16 * rb, 4 * s + (lane >> 4)); }
__device__ __forceinline__ unsigned rtr16(unsigned lane, unsigned c, unsigned ks, unsigned t) { const unsigned g = lane >> 4, q = (lane & 15) >> 2, p = lane & 3; return off_b(32 * ks + 8 * g + 4 * t + q, 2 * c + (p >> 1)) + 8 * (p & 1); }
__device__ __forceinline__ s16x4 vtr(LAS unsigned char* p) { return __builtin_bit_cast(s16x4, __builtin_amdgcn_ds_read_tr16_b64_v4i16((LAS v4i16_t*)p)); }
__device__ __forceinline__ bf16x8 trfrag(LAS unsigned char* img, unsigned lane, unsigned c, unsigned ks) {
    const s16x4 a = vtr(img + rtr16(lane, c, ks, 0)), b = vtr(img + rtr16(lane, c, ks, 1));
    return (bf16x8){a[0], a[1], a[2], a[3], b[0], b[1], b[2], b[3]};
}
__device__ __forceinline__ bf16x8 rowfrag(LAS unsigned char* img, unsigned lane, unsigned rb, unsigned s) { return *(const LAS bf16x8*)(img + rrow16(lane, rb, s)); }
constexpr int RL_Q = 0, RL_K = 16384, RL_KD = 32768, RL_V = 49152, RL_ST = 65536, RL_P = 98304, RL_STAT = 98304 + 9216;
constexpr int PS_STRIDE = 144;

struct RetCtx { const bf16* Q; const bf16* K; const bf16* V; const bf16* Gt; const float* COS; const float* SIN; const float* gnw; float* KVS; bf16* YRET; };

template <bool WITH_Q>
__device__ __forceinline__ void ret_stage(Frame& F, const RetCtx& R, int tok0, int h, float l2g, float wexp0) {
    const int tid = F.tid, row = tid >> 3, ch = tid & 7; const size_t tok = (size_t)tok0 + row;
    const f32x4 c0 = *(const f32x4*)(R.COS + tok * 64 + ch * 8), c1 = *(const f32x4*)(R.COS + tok * 64 + ch * 8 + 4);
    const f32x4 s0 = *(const f32x4*)(R.SIN + tok * 64 + ch * 8), s1 = *(const f32x4*)(R.SIN + tok * 64 + ch * 8 + 4);
    const size_t gofs = tok * RW + h * DH + ch * 8;
    const v4u k1w = *(const v4u*)(R.K + gofs), k2w = *(const v4u*)(R.K + gofs + 64);
    const v4u v1w = *(const v4u*)(R.V + gofs), v2w = *(const v4u*)(R.V + gofs + 64);
    f32x4 a0, a1, b0, b1;
    if (WITH_Q) { const v4u q1w = *(const v4u*)(R.Q + gofs), q2w = *(const v4u*)(R.Q + gofs + 64);
        unpack8(q1w, a0, a1); unpack8(q2w, b0, b1);
        *(LAS v4u*)(F.lds + RL_Q + off_b(row, ch)) = pack8(a0 * c0 - b0 * s0, a1 * c1 - b1 * s1);
        *(LAS v4u*)(F.lds + RL_Q + off_b(row, ch + 8)) = pack8(a0 * s0 + b0 * c0, a1 * s1 + b1 * c1); }
    unpack8(k1w, a0, a1); unpack8(k2w, b0, b1);
    const float sc = 0.08838834764831845f;
    f32x4 o0 = (a0 * c0 - b0 * s0) * sc, o1 = (a1 * c1 - b1 * s1) * sc, p0 = (a0 * s0 + b0 * c0) * sc, p1 = (a1 * s1 + b1 * c1) * sc;
    if (WITH_Q) { *(LAS v4u*)(F.lds + RL_K + off_b(row, ch)) = pack8(o0, o1); *(LAS v4u*)(F.lds + RL_K + off_b(row, ch + 8)) = pack8(p0, p1); }
    const float kw = __builtin_amdgcn_exp2f(l2g * (wexp0 - (float)row));
    *(LAS v4u*)(F.lds + RL_KD + off_b(row, ch)) = pack8(o0 * kw, o1 * kw); *(LAS v4u*)(F.lds + RL_KD + off_b(row, ch + 8)) = pack8(p0 * kw, p1 * kw);
    *(LAS v4u*)(F.lds + RL_V + off_b(row, ch)) = v1w; *(LAS v4u*)(F.lds + RL_V + off_b(row, ch + 8)) = v2w;
}
__device__ __forceinline__ void ret_kv_update(Frame& F, f32x4 (&st)[8]) {
    const unsigned lane = F.lane, w = F.wave;
#pragma unroll
    for (int ks = 0; ks < 2; ++ks) { const bf16x8 a = trfrag(F.lds + RL_KD, lane, w, ks);
#pragma unroll
        for (int et = 0; et < 8; ++et) { const bf16x8 b = trfrag(F.lds + RL_V, lane, et, ks); st[et] = __builtin_amdgcn_mfma_f32_16x16x32_bf16(a, b, st[et], 0, 0, 0); } }
}
__device__ __forceinline__ void ret_pass_a(Frame& F, const RetCtx& R, int job) {
    const int s = job >> 3, h = job & 7; const float l2g = log2f(1.f - exp2f(-5.f - (float)h));
    f32x4 st[8];
#pragma unroll
    for (int et = 0; et < 8; ++et) st[et] = (f32x4){0.f, 0.f, 0.f, 0.f};
    for (int c = 0; c < RCH; ++c) {
        __syncthreads();
        ret_stage<false>(F, R, (s * RCH + c) * 64, h, l2g, (float)(511 - 64 * c));
        __syncthreads();
        ret_kv_update(F, st);
    }
    const int fr = F.lane & 15, g = F.lane >> 4; float* o = R.KVS + ((size_t)(s * NH + h) * DH) * DH;
#pragma unroll
    for (int et = 0; et < 8; ++et)
#pragma unroll
        for (int r = 0; r < 4; ++r) o[(size_t)(16 * F.wave + 4 * g + r) * DH + 16 * et + fr] = st[et][r];
}
__device__ __forceinline__ void ret_pass_c(Frame& F, const RetCtx& R, int job) {
    const int s = job >> 3, h = job & 7; const float gam = 1.f - exp2f(-5.f - (float)h), l2g = log2f(gam), cd = __builtin_amdgcn_exp2f(l2g * 64.f);
    const unsigned lane = F.lane, w = F.wave; const int fr = lane & 15, g = lane >> 4;
    f32x4 st[8];
    { const float* o = R.KVS + ((size_t)(s * NH + h) * DH) * DH;
#pragma unroll
      for (int et = 0; et < 8; ++et)
#pragma unroll
          for (int r = 0; r < 4; ++r) st[et][r] = o[(size_t)(16 * w + 4 * g + r) * DH + 16 * et + fr]; }
    const int qt = w >> 1, eh = w & 1;
    const int kt = w >> 1, qt2 = 2 * (w & 1);
    for (int c = 0; c < RCH; ++c) {
        const int tok0 = (s * RCH + c) * 64;
        __syncthreads();
#pragma unroll
        for (int et = 0; et < 8; ++et) { v2u pk; pk.x = cvt_pk_bf16(st[et][0], st[et][1]); pk.y = cvt_pk_bf16(st[et][2], st[et][3]);
            *(LAS v2u*)(F.lds + RL_ST + off_b(16 * et + fr, 2 * w + (g >> 1)) + 8 * (g & 1)) = pk; }
        ret_stage<true>(F, R, tok0, h, l2g, 63.f);
        __syncthreads();
#pragma unroll
        for (int j = 0; j < 2; ++j) { f32x4 sc = (f32x4){0.f, 0.f, 0.f, 0.f};
#pragma unroll
            for (int ks = 0; ks < 4; ++ks) sc = __builtin_amdgcn_mfma_f32_16x16x32_bf16(rowfrag(F.lds + RL_K, lane, kt, ks), rowfrag(F.lds + RL_Q, lane, qt2 + j, ks), sc, 0, 0, 0);
            const int q = 16 * (qt2 + j) + fr;
#pragma unroll
            for (int r = 0; r < 4; ++r) { const int key = 16 * kt + 4 * g + r; sc[r] *= __builtin_amdgcn_exp2f(l2g * fabsf((float)(q - key))); }
            v2u pk; pk.x = cvt_pk_bf16(sc[0], sc[1]); pk.y = cvt_pk_bf16(sc[2], sc[3]);
            *(LAS v2u*)(F.lds + RL_P + q * PS_STRIDE + (16 * kt + 4 * g) * 2) = pk; }
        f32x4 y[4];
#pragma unroll
        for (int j = 0; j < 4; ++j) y[j] = (f32x4){0.f, 0.f, 0.f, 0.f};
#pragma unroll
        for (int ks = 0; ks < 4; ++ks) { const bf16x8 a = rowfrag(F.lds + RL_Q, lane, qt, ks);
#pragma unroll
            for (int j = 0; j < 4; ++j) y[j] = __builtin_amdgcn_mfma_f32_16x16x32_bf16(a, rowfrag(F.lds + RL_ST, lane, 4 * eh + j, ks), y[j], 0, 0, 0); }
#pragma unroll
        for (int r = 0; r < 4; ++r) { const float qd = __builtin_amdgcn_exp2f(l2g * (float)(16 * qt + 4 * g + r + 1));
#pragma unroll
            for (int j = 0; j < 4; ++j) y[j][r] *= qd; }
        __syncthreads();
#pragma unroll
        for (int ks = 0; ks < 2; ++ks) { const bf16x8 a = *(const LAS bf16x8*)(F.lds + RL_P + (16 * qt + fr) * PS_STRIDE + (32 * ks + 8 * g) * 2);
#pragma unroll
            for (int j = 0; j < 4; ++j) y[j] = __builtin_amdgcn_mfma_f32_16x16x32_bf16(a, trfrag(F.lds + RL_V, lane, 4 * eh + j, ks), y[j], 0, 0, 0); }
        LAS float* STAT = (LAS float*)(F.lds + RL_STAT);
#pragma unroll
        for (int r = 0; r < 4; ++r) { float s1 = 0.f, s2 = 0.f;
#pragma unroll
            for (int j = 0; j < 4; ++j) { s1 += y[j][r]; s2 += y[j][r] * y[j][r]; }
#pragma unroll
            for (int o = 1; o < 16; o <<= 1) { s1 += __shfl_xor(s1, o); s2 += __shfl_xor(s2, o); }
            if (fr == 0) { STAT[((16 * qt + 4 * g + r) * 2 + eh) * 2] = s1; STAT[((16 * qt + 4 * g + r) * 2 + eh) * 2 + 1] = s2; } }
#pragma unroll
        for (int et = 0; et < 8; ++et) st[et] *= cd;
        ret_kv_update(F, st);
        __syncthreads();
#pragma unroll
        for (int r = 0; r < 4; ++r) { const int q = 16 * qt + 4 * g + r; const float s1 = STAT[(q * 2) * 2] + STAT[(q * 2 + 1) * 2], s2 = STAT[(q * 2) * 2 + 1] + STAT[(q * 2 + 1) * 2 + 1];
            const float mu = s1 * (1.f / 128.f), var = s2 * (1.f / 128.f) - mu * mu, rs = rsqrtf(var + EPS); const size_t tok = (size_t)tok0 + q;
#pragma unroll
            for (int j = 0; j < 4; ++j) { const int e = h * DH + 16 * (4 * eh + j) + fr; const float gv = __uint_as_float((unsigned)R.Gt[tok * RW + e] << 16);
                const float o = (y[j][r] - mu) * rs * R.gnw[e] * gv * fsigm(gv);
                R.YRET[tok * RW + e] = (bf16)(cvt_pk_bf16(o, o) & 0xffffu); } }
    }
}

__device__ __forceinline__ void s5_scan(Frame& F, int job, const float* EST, const float* LAMT, bf16* UA) {
    const int g = job >> 2, pq = job & 3, pl = F.tid & 15, seg = F.tid >> 4, p = pq * 16 + pl;
    const float l16r = LAMT[(g * 64 + p) * 4 + 0], l16i = LAMT[(g * 64 + p) * 4 + 1], lsr = LAMT[(g * 64 + p) * 4 + 2], lsi = LAMT[(g * 64 + p) * 4 + 3];
    float er[32], ei[32];
    const float* e0 = EST + ((size_t)g * S5NC + seg * 32) * 128 + p;
#pragma unroll
    for (int i = 0; i < 32; ++i) { er[i] = e0[(size_t)i * 128]; ei[i] = e0[(size_t)i * 128 + 64]; }
    float sr = 0.f, si = 0.f;
#pragma unroll
    for (int i = 0; i < 32; ++i) { const float nr = l16r * sr - l16i * si + er[i], ni = l16r * si + l16i * sr + ei[i]; sr = nr; si = ni; }
    LAS float* SE = (LAS float*)F.lds;
    __syncthreads();
    SE[(seg * 16 + pl) * 2] = sr; SE[(seg * 16 + pl) * 2 + 1] = si;
    __syncthreads();
    sr = 0.f; si = 0.f;
    for (int s2 = 0; s2 < seg; ++s2) { const float ar = SE[(s2 * 16 + pl) * 2], ai = SE[(s2 * 16 + pl) * 2 + 1]; const float nr = lsr * sr - lsi * si + ar, ni = lsr * si + lsi * sr + ai; sr = nr; si = ni; }
    bf16* o = UA + ((size_t)g * S5NC + seg * 32) * S5K + 256 + p;
#pragma unroll
    for (int i = 0; i < 32; ++i) { o[(size_t)i * S5K] = (bf16)(cvt_pk_bf16(sr, sr) & 0xffffu); o[(size_t)i * S5K + 64] = (bf16)(cvt_pk_bf16(si, si) & 0xffffu);
        const float nr = l16r * sr - l16i * si + er[i], ni = l16r * si + l16i * sr + ei[i]; sr = nr; si = ni; }
    __syncthreads();
}
__device__ __forceinline__ void ret_scan(Frame& F, int job, float* KVS) {
    const int idx = job * 512 + F.tid;
    const int h = idx >> 14; const float cd8 = __builtin_amdgcn_exp2f(log2f(1.f - exp2f(-5.f - (float)h)) * 512.f);
    float v[RSC];
#pragma unroll
    for (int s = 0; s < RSC; ++s) v[s] = KVS[(size_t)s * NH * DH * DH + idx];
    float st = 0.f;
#pragma unroll
    for (int s = 0; s < RSC; ++s) { const float t = v[s]; KVS[(size_t)s * NH * DH * DH + idx] = st; st = st * cd8 + t; }
}

struct Args { const float* in[30]; float* out; unsigned char* ws; int ph_lo, ph_hi; };
enum { I_X = 0, I_P, I_NMIX, I_WIN, I_GNW, I_LRE, I_LIM, I_LDT, I_BRE, I_BIM, I_CRE, I_CIM, I_SD, I_WGLU, I_WA, I_WB, I_WMERGE, I_WOUT, I_NFFN, I_WRG, I_BRG, I_WRE, I_BRE2, I_WEG, I_WEU, I_WED, I_NPLE, I_WPG, I_WPLE, I_NF };

__global__ void __launch_bounds__(NWAVES * 64, 2) mk_fwd(Args args) {
    extern __shared__ __attribute__((aligned(16))) unsigned char lds_raw[];
    Frame F;
    F.lds = (LAS unsigned char*)lds_raw;
    F.MISC = (volatile LAS unsigned*)(F.lds + MISC_OFF);
    F.tid = threadIdx.x; F.lane = F.tid & 63; F.wave = __builtin_amdgcn_readfirstlane(F.tid >> 6); F.G = gridDim.x;
    unsigned char* ws = args.ws;
    F.ctl = (unsigned*)(ws + WS_CTL);
    for (int u = F.tid; u < (LDS_BYTES - LDSCTL_OFF) / 4; u += NWAVES * 64) ((LAS unsigned*)(F.lds + LDSCTL_OFF))[u] = 0u;
    __syncthreads();
    const int lo = args.ph_lo, hi = args.ph_hi;
    const bool fused = (hi - lo) > 1;
    XcdBarrier bar; bar.bar = F.ctl + CW_BAR; bar.x = 0; bar.st = nullptr;
    if (fused) bar = xcd_barrier_post(F.ctl + CW_BAR, F.MISC + 8);
#ifndef PH_MASK
#define PH_MASK 0xffffffffu
#endif
#define IN(k) (((PH_MASK >> (k)) & 1u) && lo <= (k) && (k) < hi)
#define SEAM(k) do { if (IN(k) && IN((k) + 1)) xcd_barrier(bar); } while (0)
    bf16* WT1 = (bf16*)(ws + WS_WT1); bf16* WGLU = (bf16*)(ws + WS_WGLU); bf16* WA = (bf16*)(ws + WS_WA); bf16* WB = (bf16*)(ws + WS_WB); bf16* WOUT = (bf16*)(ws + WS_WOUT);
    bf16* WPG = (bf16*)(ws + WS_WPG); bf16* WP = (bf16*)(ws + WS_WP); bf16* BTC = (bf16*)(ws + WS_BTC); bf16* BLT = (bf16*)(ws + WS_BLT);
    bf16* HB = (bf16*)(ws + WS_HB); bf16* YRET = (bf16*)(ws + WS_YRET); bf16* YPRE = (bf16*)(ws + WS_YPRE); bf16* QKVG = (bf16*)(ws + WS_Q); bf16* UA = (bf16*)(ws + WS_UA);
    float* EST = (float*)(ws + WS_EST); float* KVS = (float*)(ws + WS_KVS); bf16* MERGED = (bf16*)(ws + WS_MERGED); bf16* YSSM = (bf16*)(ws + WS_YSSM); bf16* PB = (bf16*)(ws + WS_PB);
    float* COS = (float*)(ws + WS_COS); float* SIN = (float*)(ws + WS_SIN); float* LAMT = (float*)(ws + WS_LAM);
    bf16* GATES = (bf16*)args.out;

    if (IN(0)) {
        constexpr int I_S5 = 64;
        constexpr int I_WIN8 = (D / 64) * (INC / 32) / 8, I_WMG8 = (D / 64) * (4096 / 32) / 8, I_GLU8 = (RW / 64) * (RW / 32) / 8, I_WA8 = (RW / 64) * (D / 32) / 8, I_WO8 = (D / 64) * (D / 32) / 8, I_WPL8 = (PLE / 64) * (D / 32) / 8;
        constexpr int I_H = T / 64, I_PB = 256, I_ROPE = 256;
        constexpr int B0 = 0, B1 = B0 + I_S5, B2 = B1 + I_WIN8, B3 = B2 + I_WMG8, B4 = B3 + I_GLU8, B5 = B4 + I_WA8, B6 = B5 + I_WA8, B7 = B6 + I_WO8, B8 = B7 + I_WO8, B9 = B8 + I_WPL8, B10 = B9 + I_H, B11 = B10 + I_PB, B12 = B11 + I_ROPE, B13 = B12 + 1;
        LAS float* scr = (LAS float*)(F.lds + RING_OFF + F.wave * 8704);
        for (;;) {
            const int it = wg_next_item(F, F.ctl + CW_Q0);
            if (it >= B13) break;
            if (it < B1) { s5_tables(F, it, args.in[I_LRE], args.in[I_LIM], args.in[I_LDT], args.in[I_BRE], args.in[I_BIM], args.in[I_CRE], args.in[I_CIM], args.in[I_SD], BTC, BLT, LAMT); }
            else if (it < B2) transpose_item<0>(args.in[I_WIN], D, INC, WT1, D, 0, scr, (it - B1) * 8 + F.wave, F.lane);
            else if (it < B3) transpose_item<0>(args.in[I_WMERGE], D, 4096, WT1, D, INC, scr, (it - B2) * 8 + F.wave, F.lane);
            else if (it < B4) transpose_item<0>(args.in[I_WGLU], RW, RW, WGLU, RW, 0, scr, (it - B3) * 8 + F.wave, F.lane);
            else if (it < B5) transpose_item<0>(args.in[I_WA], RW, D, WA, RW, 0, scr, (it - B4) * 8 + F.wave, F.lane);
            else if (it < B6) transpose_item<0>(args.in[I_WB], RW, D, WB, RW, 0, scr, (it - B5) * 8 + F.wave, F.lane);
            else if (it < B7) transpose_item<0>(args.in[I_WOUT], D, D, WOUT, D, 0, scr, (it - B6) * 8 + F.wave, F.lane);
            else if (it < B8) transpose_item<0>(args.in[I_WPG], D, D, WPG, D, 0, scr, (it - B7) * 8 + F.wave, F.lane);
            else if (it < B9) transpose_item<0>(args.in[I_WPLE], PLE, D, WP, PLE, 0, scr, (it - B8) * 8 + F.wave, F.lane);
            else if (it < B10) { const int r0 = (it - B9) * 64 + F.wave * 8;
                for (int r = 0; r < 8; ++r) rms_row_to_bf16(F.lane, args.in[I_X] + (size_t)(r0 + r) * D, args.in[I_NMIX], HB + (size_t)(r0 + r) * D); }
            else if (it < B11) { const size_t e0 = (size_t)(it - B10) * 16384 + F.tid * 8;
#pragma unroll
                for (int k = 0; k < 4; ++k) { const size_t e = e0 + (size_t)k * 4096; const f32x4 a = *(const f32x4*)(args.in[I_P] + e), b = *(const f32x4*)(args.in[I_P] + e + 4); *(v4u*)(PB + e) = pack8(a, b); } }
            else if (it < B12) { const int t0 = (it - B11) * 64;
#pragma unroll
                for (int k = 0; k < 8; ++k) { const int idx = k * 512 + F.tid, t = t0 + (idx >> 6), j = idx & 63; const double inv = exp2(-(double)j * (13.287712379549449 / 64.0));
                    double sn, cs; sincos((double)t * inv, &sn, &cs); COS[(size_t)t * 64 + j] = (float)cs; SIN[(size_t)t * 64 + j] = (float)sn; } }
            else { for (int i = F.tid; i < 128 * 256 / 8; i += 512) *(v4u*)(BLT + (size_t)SG * 128 * 256 + (size_t)i * 8) = (v4u){0u, 0u, 0u, 0u}; }
        }
    }
    SEAM(0);
    if (IN(1)) {
        pg8::SchedPlain S; S.init(HB, D, WT1, D, T, N1, F.G, (int)blockIdx.x);
        EpiProj E{QKVG, UA, GATES};
        pg8::gemm_phase<EpiProj, pg8::SchedPlain>(F.lds + RING_OFF, D, S, E);
    }
    SEAM(1);
    RetCtx RC{QKVG, QKVG + (size_t)T * RW, QKVG + (size_t)2 * T * RW, QKVG + (size_t)3 * T * RW, COS, SIN, args.in[I_GNW], KVS, YRET};
    if (IN(2)) {
        pg8::SchedBatch S; S.A = (const char*)UA; S.B = (const char*)BLT; S.lda2 = S5K * 2; S.ldb2 = 256 * 2; S.sA = (size_t)S5NC * S5K * 2; S.sB = (size_t)128 * 256 * 2; S.nMz = S5NC / 256; S.nz = SG; S.G = F.G; S.c = (int)blockIdx.x;
        EpiS5A E{EST};
        pg8::gemm_phase<EpiS5A, pg8::SchedBatch>(F.lds + RING_OFF, 256, S, E);
        for (int job = blockIdx.x; job < RSC * NH; job += F.G) ret_pass_a(F, RC, job);
    }
    SEAM(2);
    if (IN(3)) {
        for (int job = blockIdx.x; job < SG * 4; job += F.G) s5_scan(F, job, EST, LAMT, UA);
        for (int job = blockIdx.x; job < NH * DH * DH / 512; job += F.G) ret_scan(F, job, KVS);
    }
    SEAM(3);
    if (IN(4)) {
        pg8::SchedBatch S; S.A = (const char*)UA; S.B = (const char*)BTC; S.lda2 = S5K * 2; S.ldb2 = S5K * 2; S.sA = (size_t)S5NC * S5K * 2; S.sB = (size_t)256 * S5K * 2; S.nMz = S5NC / 256; S.nz = SG; S.G = F.G; S.c = (int)blockIdx.x;
        EpiS5C E{YPRE};
#ifndef P4_NOGEMM
        pg8::gemm_phase<EpiS5C, pg8::SchedBatch>(F.lds + RING_OFF, S5K, S, E);
#endif
#ifndef P4_NORET
        for (int job = blockIdx.x; job < RSC * NH; job += F.G) ret_pass_c(F, RC, job);
#endif
    }
    SEAM(4);
    if (IN(5)) {
        pg8::SchedPlain S; S.init(YPRE, RW, WGLU, RW, T, RW, F.G, (int)blockIdx.x);
        EpiGlu E{YPRE, YSSM};
        pg8::gemm_phase<EpiGlu, pg8::SchedPlain>(F.lds + RING_OFF, RW, S, E);
    }
    SEAM(5);
    if (IN(6)) {
        pg8::SchedTwoPass S; S.A0 = (const char*)YRET; S.A1 = (const char*)YSSM; S.B0 = (const char*)WA; S.B1 = (const char*)WB; S.lda2 = RW * 2; S.ldb2 = RW * 2; S.nM = T / 256; S.nN = D / 256; S.G = F.G; S.c = (int)blockIdx.x;
        EpiMerge E{GATES, MERGED};
        pg8::gemm_phase<EpiMerge, pg8::SchedTwoPass>(F.lds + RING_OFF, RW, S, E);
    }
    SEAM(6);
    if (IN(7)) {
        pg8::SchedPlain S; S.init(MERGED, D, WOUT, D, T, D, F.G, (int)blockIdx.x);
        EpiOut E{args.in[I_X], args.out};
        pg8::gemm_phase<EpiOut, pg8::SchedPlain>(F.lds + RING_OFF, D, S, E);
    }
#undef IN
#undef SEAM
}

namespace base {

constexpr int T = 16384, D = 2048, CH = 64, NCH = T / CH, PLE = 256;
constexpr int NH = 8, DH = 128, RW = 1024, SW = 1024, SG = 64, SP = 64, SC = 16;
constexpr int INC = 5120, NE = 32, NGR = 4, EPG = 8, FE = 512;
constexpr float EPS = 1e-6f;

__device__ __forceinline__ float sigm(float x) { return 1.f / (1.f + __expf(-x)); }
__device__ __forceinline__ float silu(float x) { return x * sigm(x); }
__device__ __forceinline__ float gelu_tanh(float x) { const float u = 0.7978845608028654f * (x + 0.044715f * x * x * x); return 0.5f * x * (1.f + tanhf(u)); }
__device__ __forceinline__ float wave_sum(float v) {
#pragma unroll
    for (int o = 1; o < 64; o <<= 1) v += __shfl_xor(v, o);
    return v;
}

__global__ __launch_bounds__(256) void k_rmsnorm(const float* x, const float* w, float* out) {
    __shared__ float red[4];
    const size_t row = blockIdx.x; const int tid = threadIdx.x;
    const float4* xr = (const float4*)(x + row * D); const float4* wr = (const float4*)w;
    float4 a = xr[tid], b = xr[tid + 256];
    float s = a.x * a.x + a.y * a.y + a.z * a.z + a.w * a.w + b.x * b.x + b.y * b.y + b.z * b.z + b.w * b.w;
    s = wave_sum(s); if ((tid & 63) == 0) red[tid >> 6] = s; __syncthreads();
    const float r = rsqrtf((red[0] + red[1] + red[2] + red[3]) * (1.f / D) + EPS);
    float4 wa = wr[tid], wb = wr[tid + 256];
    float4* o = (float4*)(out + row * D);
    o[tid] = make_float4(a.x * r * wa.x, a.y * r * wa.y, a.z * r * wa.z, a.w * r * wa.w);
    o[tid + 256] = make_float4(b.x * r * wb.x, b.y * r * wb.y, b.z * r * wb.z, b.w * r * wb.w);
}

struct GArgs { const float* A; const float* W; const float* W2; const int* ridx; const int* cnt; long wstride; long ridx_stride; int lda, ldw, M, N, K, pad; };
template <class Epi, bool DUAL> __global__ __launch_bounds__(256) void sgemm_k(GArgs g, Epi epi) {
    __shared__ float As[16][68];
    __shared__ float Ws[16][68];
    __shared__ float Ws2[DUAL ? 16 : 1][68];
    const int tid = threadIdx.x, tx = tid & 15, ty = tid >> 4;
    const int z = blockIdx.z;
    int Mz = g.M; if (g.cnt) Mz = g.cnt[z];
    const int m0 = blockIdx.y * 64, n0 = blockIdx.x * 64;
    if (m0 >= Mz) return;
    const float* W = g.W + (size_t)z * g.wstride; const float* W2 = DUAL ? g.W2 + (size_t)z * g.wstride : nullptr;
    const int* ridx = g.ridx ? g.ridx + (size_t)z * g.ridx_stride : nullptr;
    const int arow = tid >> 2, akq = tid & 3;
    int gm = m0 + arow; if (gm >= Mz) gm = Mz - 1;
    const size_t srow = ridx ? (size_t)ridx[gm] : (size_t)gm;
    const float* ap = g.A + srow * g.lda + akq * 4;
    const int wk = tid >> 4, wn = (tid & 15) * 4;
    float acc[4][4], acc2[4][4];
#pragma unroll
    for (int i = 0; i < 4; ++i)
#pragma unroll
        for (int j = 0; j < 4; ++j) { acc[i][j] = 0.f; acc2[i][j] = 0.f; }
    for (int k0 = 0; k0 < g.K; k0 += 16) {
        const float4 a = *(const float4*)(ap + k0);
        As[akq * 4 + 0][arow] = a.x; As[akq * 4 + 1][arow] = a.y; As[akq * 4 + 2][arow] = a.z; As[akq * 4 + 3][arow] = a.w;
        *(float4*)&Ws[wk][wn] = *(const float4*)(W + (size_t)(k0 + wk) * g.ldw + n0 + wn);
        if (DUAL) *(float4*)&Ws2[wk][wn] = *(const float4*)(W2 + (size_t)(k0 + wk) * g.ldw + n0 + wn);
        __syncthreads();
#pragma unroll
        for (int kk = 0; kk < 16; ++kk) {
            const float4 av = *(const float4*)&As[kk][ty * 4]; const float4 bv = *(const float4*)&Ws[kk][tx * 4];
            const float aa[4] = {av.x, av.y, av.z, av.w}; const float bb[4] = {bv.x, bv.y, bv.z, bv.w};
#pragma unroll
            for (int i = 0; i < 4; ++i)
#pragma unroll
                for (int j = 0; j < 4; ++j) acc[i][j] += aa[i] * bb[j];
            if (DUAL) { const float4 cv = *(const float4*)&Ws2[kk][tx * 4]; const float cc[4] = {cv.x, cv.y, cv.z, cv.w};
#pragma unroll
                for (int i = 0; i < 4; ++i)
#pragma unroll
                    for (int j = 0; j < 4; ++j) acc2[i][j] += aa[i] * cc[j]; }
        }
        __syncthreads();
    }
#pragma unroll
    for (int i = 0; i < 4; ++i) { const int m = m0 + ty * 4 + i; if (m < Mz) epi(z, m, n0 + tx * 4, acc[i], acc2[i]); }
}
struct EpiStore { float* C; long ldc; __device__ void operator()(int, int m, int n, const float (&v)[4], const float (&)[4]) const { *(float4*)(C + (size_t)m * ldc + n) = make_float4(v[0], v[1], v[2], v[3]); } };
struct EpiSigm { float* C; long ldc; __device__ void operator()(int, int m, int n, const float (&v)[4], const float (&)[4]) const { *(float4*)(C + (size_t)m * ldc + n) = make_float4(sigm(v[0]), sigm(v[1]), sigm(v[2]), sigm(v[3])); } };
struct EpiGlu { const float* Y; float* C; long ldc; __device__ void operator()(int, int m, int n, const float (&v)[4], const float (&)[4]) const {
    const float4 y = *(const float4*)(Y + (size_t)m * ldc + n); *(float4*)(C + (size_t)m * ldc + n) = make_float4(y.x * sigm(v[0]), y.y * sigm(v[1]), y.z * sigm(v[2]), y.w * sigm(v[3])); } };
struct EpiMerge { const float* G; float* C; int ldg, ldc, accum, pad; __device__ void operator()(int, int m, int n, const float (&v)[4], const float (&)[4]) const {
    const float4 gt = *(const float4*)(G + (size_t)m * ldg + n); float4 o = make_float4(gt.x * v[0], gt.y * v[1], gt.z * v[2], gt.w * v[3]);
    float4* c = (float4*)(C + (size_t)m * ldc + n); if (accum) { const float4 p = *c; o.x += p.x; o.y += p.y; o.z += p.z; o.w += p.w; } *c = o; } };
struct EpiResid { const float* X; float* C; long ldc; __device__ void operator()(int, int m, int n, const float (&v)[4], const float (&)[4]) const {
    const float4 x = *(const float4*)(X + (size_t)m * ldc + n); *(float4*)(C + (size_t)m * ldc + n) = make_float4(x.x + v[0], x.y + v[1], x.z + v[2], x.w + v[3]); } };
struct EpiPle { const float* PP; float* C; long ldc; __device__ void operator()(int, int m, int n, const float (&v)[4], const float (&)[4]) const {
    const float4 pp = *(const float4*)(PP + (size_t)m * ldc + n); float4* c = (float4*)(C + (size_t)m * ldc + n); float4 x = *c;
    x.x += sigm(v[0]) * pp.x; x.y += sigm(v[1]) * pp.y; x.z += sigm(v[2]) * pp.z; x.w += sigm(v[3]) * pp.w; *c = x; } };
struct EpiGateUp { float* ACT; const int* off; __device__ void operator()(int z, int m, int n, const float (&g)[4], const float (&u)[4]) const {
    *(float4*)(ACT + (size_t)(off[z] + m) * FE + n) = make_float4(silu(g[0]) * u[0], silu(g[1]) * u[1], silu(g[2]) * u[2], silu(g[3]) * u[3]); } };
struct EpiDown { float* MOE; const int* list; const float* wgt; __device__ void operator()(int z, int m, int n, const float (&v)[4], const float (&)[4]) const {
    const int code = list[(size_t)z * T + m]; const int tok = code >> 1, slot = code & 1; const float w = wgt[code];
    *(float4*)(MOE + ((size_t)slot * T + tok) * D + n) = make_float4(w * v[0], w * v[1], w * v[2], w * v[3]); } };

__global__ void k_rope(float* __restrict__ proj) {
    const int idx = blockIdx.x * blockDim.x + threadIdx.x;
    if (idx >= T * 2 * NH * 64) return;
    const int j = idx & 63, h = (idx >> 6) & 7, qk = (idx >> 9) & 1, t = idx >> 10;
    const double inv = pow(10000.0, -(double)j / 64.0);
    double s, c; sincos((double)t * inv, &s, &c);
    float* p = proj + (size_t)t * INC + qk * RW + h * DH + j;
    const float t1 = p[0], t2 = p[64]; const float sc = qk ? 0.08838834764831845f : 1.f;
    p[0] = (t1 * (float)c - t2 * (float)s) * sc; p[64] = (t1 * (float)s + t2 * (float)c) * sc;
}
__device__ __forceinline__ float gamma_of(int h) { return 1.f - exp2f(-5.f - (float)h); }
__global__ __launch_bounds__(256) void k_ret_kv(const float* __restrict__ proj, float* __restrict__ kv) {
    __shared__ float Ks[32][128]; __shared__ float Vs[32][128];
    const int n = blockIdx.x >> 3, h = blockIdx.x & 7, tid = threadIdx.x;
    const float lg = logf(gamma_of(h));
    float acc[64];
#pragma unroll
    for (int i = 0; i < 64; ++i) acc[i] = 0.f;
    const int e = tid & 127, d0 = tid >> 7;
    for (int kh = 0; kh < 2; ++kh) {
        for (int i = tid; i < 32 * 128; i += 256) { const int k = i >> 7, c = i & 127; const size_t row = (size_t)(n * CH + kh * 32 + k) * INC;
            Ks[k][c] = proj[row + RW + h * DH + c] * __expf(lg * (float)(63 - (kh * 32 + k))); Vs[k][c] = proj[row + 2 * RW + h * DH + c]; }
        __syncthreads();
        for (int k = 0; k < 32; ++k) { const float v = Vs[k][e];
#pragma unroll
            for (int i = 0; i < 64; ++i) acc[i] += Ks[k][d0 + 2 * i] * v; }
        __syncthreads();
    }
    float* o = kv + ((size_t)(n * NH + h) * DH) * DH;
#pragma unroll
    for (int i = 0; i < 64; ++i) o[(size_t)(d0 + 2 * i) * DH + e] = acc[i];
}
__global__ void k_ret_scan(float* __restrict__ kv) {
    const int idx = blockIdx.x * blockDim.x + threadIdx.x; if (idx >= NH * DH * DH) return;
    const int h = idx / (DH * DH); const float cd = __expf(logf(gamma_of(h)) * 64.f);
    float st = 0.f;
    for (int n = 0; n < NCH; ++n) { float* p = kv + (size_t)n * NH * DH * DH + idx; const float t = *p; *p = st; st = st * cd + t; }
}
__global__ __launch_bounds__(256) void k_ret_out(const float* __restrict__ proj, const float* __restrict__ st, float* __restrict__ yraw) {
    extern __shared__ float sm[];
    float* Qs = sm; float* Ks = sm + 64 * 129; float* Ss = sm + 2 * 64 * 129;
    const int n = blockIdx.x >> 3, h = blockIdx.x & 7, tid = threadIdx.x;
    const float lg = logf(gamma_of(h));
    for (int i = tid; i < 64 * 128; i += 256) { const int k = i >> 7, c = i & 127; const size_t row = (size_t)(n * CH + k) * INC;
        Qs[k * 129 + c] = proj[row + h * DH + c]; Ks[k * 129 + c] = proj[row + RW + h * DH + c]; }
    __syncthreads();
    for (int i = tid; i < 64 * 64; i += 256) { const int q = i >> 6, k = i & 63; float s = 0.f;
        for (int d = 0; d < 128; ++d) s += Qs[q * 129 + d] * Ks[k * 129 + d];
        Ss[q * 65 + k] = s * __expf(lg * fabsf((float)(q - k))); }
    __syncthreads();
    const int e = tid & 127, q0 = tid >> 7;
    float acc[32], accx[32];
#pragma unroll
    for (int i = 0; i < 32; ++i) { acc[i] = 0.f; accx[i] = 0.f; }
    for (int k = 0; k < 64; ++k) { const float v = proj[(size_t)(n * CH + k) * INC + 2 * RW + h * DH + e];
#pragma unroll
        for (int i = 0; i < 32; ++i) acc[i] += Ss[(q0 + 2 * i) * 65 + k] * v; }
    const float* S = st + ((size_t)(n * NH + h) * DH) * DH;
    for (int d = 0; d < 128; ++d) { const float s = S[(size_t)d * DH + e];
#pragma unroll
        for (int i = 0; i < 32; ++i) accx[i] += Qs[(q0 + 2 * i) * 129 + d] * s; }
#pragma unroll
    for (int i = 0; i < 32; ++i) { const int q = q0 + 2 * i; yraw[(size_t)(n * CH + q) * RW + h * DH + e] = acc[i] + __expf(lg * (float)(q + 1)) * accx[i]; }
}
__global__ __launch_bounds__(256) void k_ret_norm(float* __restrict__ y, const float* __restrict__ proj, const float* __restrict__ gnw) {
    const int wv = blockIdx.x * 4 + (threadIdx.x >> 6), lane = threadIdx.x & 63; const int t = wv >> 3, h = wv & 7;
    float* yp = y + (size_t)t * RW + h * DH; const float a = yp[lane], b = yp[lane + 64];
    const float mu = wave_sum(a + b) * (1.f / 128.f); const float da = a - mu, db = b - mu;
    const float var = wave_sum(da * da + db * db) * (1.f / 128.f); const float r = rsqrtf(var + EPS);
    const float* gp = proj + (size_t)t * INC + 3 * RW + h * DH;
    yp[lane] = silu(gp[lane]) * da * r * gnw[h * DH + lane]; yp[lane + 64] = silu(gp[lane + 64]) * db * r * gnw[h * DH + lane + 64];
}
__global__ __launch_bounds__(64) void k_s5(const float* __restrict__ proj, const float* lam_re, const float* lam_im, const float* log_dt, const float* b_re, const float* b_im,
                                          const float* c_re, const float* c_im, const float* dvec, float* __restrict__ ypre) {
    __shared__ float Xr[64][65], Xi[64][65]; __shared__ float Us[64][16];
    const int g = blockIdx.x, p = threadIdx.x;
    const double lr = fmin((double)lam_re[g * SP + p], -1e-4), li = (double)lam_im[g * SP + p], dt = exp((double)log_dt[g]);
    const double er = exp(lr * dt); double sn, cs; sincos(li * dt, &sn, &cs);
    const double lbr = er * cs, lbi = er * sn;
    const double nr = lbr - 1.0, ni = lbi, den = lr * lr + li * li;
    const double fr = (nr * lr + ni * li) / den, fi = (ni * lr - nr * li) / den;
    float Br[16], Bi[16];
#pragma unroll
    for (int c = 0; c < 16; ++c) { const double br = b_re[(g * SP + p) * SC + c], bi = b_im[(g * SP + p) * SC + c]; Br[c] = (float)(fr * br - fi * bi); Bi[c] = (float)(fr * bi + fi * br); }
    const float flr = (float)lbr, fli = (float)lbi;
    float sr = 0.f, si = 0.f;
    for (int t0 = 0; t0 < T; t0 += 64) {
        for (int i = p; i < 64 * 16; i += 64) Us[i >> 4][i & 15] = proj[(size_t)(t0 + (i >> 4)) * INC + 4 * RW + g * SC + (i & 15)];
        __syncthreads();
        for (int t = 0; t < 64; ++t) { float br = 0.f, bi = 0.f;
#pragma unroll
            for (int c = 0; c < 16; ++c) { const float u = Us[t][c]; br += Br[c] * u; bi += Bi[c] * u; }
            const float nr2 = flr * sr - fli * si + br, ni2 = flr * si + fli * sr + bi; sr = nr2; si = ni2; Xr[t][p] = sr; Xi[t][p] = si; }
        __syncthreads();
        for (int i = p; i < 64 * 16; i += 64) { const int t = i >> 4, c = i & 15; float y = 0.f;
            for (int q = 0; q < 64; ++q) y += c_re[(g * SC + c) * SP + q] * Xr[t][q] - c_im[(g * SC + c) * SP + q] * Xi[t][q];
            y += dvec[g * SC + c] * Us[t][c]; ypre[(size_t)(t0 + t) * SW + g * SC + c] = gelu_tanh(y); }
        __syncthreads();
    }
}
__global__ __launch_bounds__(256) void k_router(const float* __restrict__ h, const float* __restrict__ wrg, const float* __restrict__ brg, const float* __restrict__ wre, const float* __restrict__ bre,
                                               int* __restrict__ cnt, int* __restrict__ list, float* __restrict__ wgt) {
    const int t = blockIdx.x * 4 + (threadIdx.x >> 6), lane = threadIdx.x & 63;
    float lg[36];
#pragma unroll
    for (int j = 0; j < 36; ++j) lg[j] = 0.f;
    for (int k = lane; k < D; k += 64) { const float x = h[(size_t)t * D + k];
#pragma unroll
        for (int j = 0; j < 4; ++j) lg[j] += x * wrg[k * NGR + j];
#pragma unroll
        for (int j = 0; j < 32; ++j) lg[4 + j] += x * wre[k * NE + j]; }
#pragma unroll
    for (int j = 0; j < 36; ++j) lg[j] = wave_sum(lg[j]);
    if (lane == 0) {
        float gl[4]; float mx = -1e30f; int gi = 0;
#pragma unroll
        for (int j = 0; j < 4; ++j) { gl[j] = lg[j] + brg[j]; if (gl[j] > mx) { mx = gl[j]; gi = j; } }
        float se = 0.f;
#pragma unroll
        for (int j = 0; j < 4; ++j) se += __expf(gl[j] - mx);
        const float gw = 1.f / se;
        float b1 = -1e30f, b2 = -1e30f; int j1 = 0, j2 = 0;
#pragma unroll
        for (int g4 = 0; g4 < 4; ++g4) if (g4 == gi) {
#pragma unroll
            for (int j = 0; j < 8; ++j) { const float v = lg[4 + g4 * 8 + j] + bre[g4 * 8 + j]; if (v > b1) { b2 = b1; j2 = j1; b1 = v; j1 = j; } else if (v > b2) { b2 = v; j2 = j; } } }
        const float e2 = __expf(b2 - b1); const float w1 = gw / (1.f + e2), w2 = gw * e2 / (1.f + e2);
        const int ea = gi * 8 + j1, eb = gi * 8 + j2;
        const int pa = atomicAdd(&cnt[ea], 1); list[(size_t)ea * T + pa] = t * 2; wgt[t * 2] = w1;
        const int pb = atomicAdd(&cnt[eb], 1); list[(size_t)eb * T + pb] = t * 2 + 1; wgt[t * 2 + 1] = w2;
    }
}
__global__ void k_offsets(const int* cnt, int* off, int* tokidx, const int* list) { if (threadIdx.x == 0) { int s = 0; for (int e = 0; e < NE; ++e) { off[e] = s; s += cnt[e]; } } }
__global__ void k_tokidx(const int* __restrict__ cnt, const int* __restrict__ list, int* __restrict__ tokidx) {
    const int e = blockIdx.y; for (int r = blockIdx.x * blockDim.x + threadIdx.x; r < cnt[e]; r += gridDim.x * blockDim.x) tokidx[(size_t)e * T + r] = list[(size_t)e * T + r] >> 1;
}
__global__ __launch_bounds__(256) void k_moe_combine(float* __restrict__ x, const float* __restrict__ moe, const float* __restrict__ w, float* __restrict__ out) {
    __shared__ float red[4];
    const size_t row = blockIdx.x; const int tid = threadIdx.x;
    float4* xr = (float4*)(x + row * D); const float4* m0 = (const float4*)(moe + row * D); const float4* m1 = (const float4*)(moe + ((size_t)T + row) * D); const float4* wr = (const float4*)w;
    float4 a = xr[tid], b = xr[tid + 256]; const float4 c0 = m0[tid], c1 = m0[tid + 256], d0 = m1[tid], d1 = m1[tid + 256];
    a.x += c0.x + d0.x; a.y += c0.y + d0.y; a.z += c0.z + d0.z; a.w += c0.w + d0.w; b.x += c1.x + d1.x; b.y += c1.y + d1.y; b.z += c1.z + d1.z; b.w += c1.w + d1.w;
    xr[tid] = a; xr[tid + 256] = b;
    float s = a.x * a.x + a.y * a.y + a.z * a.z + a.w * a.w + b.x * b.x + b.y * b.y + b.z * b.z + b.w * b.w;
    s = wave_sum(s); if ((tid & 63) == 0) red[tid >> 6] = s; __syncthreads();
    const float r = rsqrtf((red[0] + red[1] + red[2] + red[3]) * (1.f / D) + EPS);
    float4 wa = wr[tid], wb = wr[tid + 256]; float4* o = (float4*)(out + row * D);
    o[tid] = make_float4(a.x * r * wa.x, a.y * r * wa.y, a.z * r * wa.z, a.w * r * wa.w);
    o[tid + 256] = make_float4(b.x * r * wb.x, b.y * r * wb.y, b.z * r * wb.z, b.w * r * wb.w);
}
__global__ void k_fillidx(const int* cnt, const int* off, int* idx) { const int e = blockIdx.y; for (int r = blockIdx.x * blockDim.x + threadIdx.x; r < cnt[e]; r += gridDim.x * blockDim.x) idx[(size_t)e * T + r] = off[e] + r; }
template <class Epi, bool DUAL> void gemm(hipStream_t s, GArgs g, Epi e, int zdim = 1, int mmax = -1) {
    const int mm = mmax < 0 ? g.M : mmax; dim3 grid(g.N / 64, (mm + 63) / 64, zdim);
    hipLaunchKernelGGL((sgemm_k<Epi, DUAL>), grid, dim3(256), 0, s, g, e);
}

}

#ifndef RUN_HI
#define RUN_HI 8
#endif
extern "C" void kernel_launch(void* const* d_in, const int* in_sizes, int n_in, void* d_out, int out_size, void* d_ws, size_t ws_size, hipStream_t stream) {
    static int grid = 0;
    if (grid == 0) {
        if (n_in != 30 || ws_size < ((size_t)620 << 20)) { fprintf(stderr, "kernel_launch: unexpected n_in %d / ws %zu\n", n_in, ws_size); grid = -1; return; }
        int dev = 0, cus = 0;
        if (hipGetDevice(&dev) != hipSuccess || hipDeviceGetAttribute(&cus, hipDeviceAttributeMultiprocessorCount, dev) != hipSuccess) { grid = -1; return; }
        if (hipFuncSetAttribute((const void*)mk_fwd, hipFuncAttributeMaxDynamicSharedMemorySize, LDS_BYTES) != hipSuccess) { fprintf(stderr, "kernel_launch: hipFuncSetAttribute failed\n"); grid = -1; return; }
        int per_cu = 0; (void)hipOccupancyMaxActiveBlocksPerMultiprocessor(&per_cu, (const void*)mk_fwd, NWAVES * 64, LDS_BYTES); (void)hipGetLastError();
        if (per_cu < 1) fprintf(stderr, "kernel_launch: occupancy query says %d\n", per_cu);
        grid = cus;
    }
    if (grid < 0) return;
    (void)hipMemsetAsync((char*)d_ws + WS_CTL, 0, CTL_ZERO_BYTES, stream);
    Args a{};
    for (int i = 0; i < 30; ++i) a.in[i] = (const float*)d_in[i];
    a.out = (float*)d_out; a.ws = (unsigned char*)d_ws;
    for (int ph = 0; ph < RUN_HI; ++ph) { a.ph_lo = ph; a.ph_hi = ph + 1; hipLaunchKernelGGL(mk_fwd, dim3(grid), dim3(NWAVES * 64), LDS_BYTES, stream, a); }
    {
        using namespace base;
        const float* p = (const float*)d_in[1];
        const float* norm_ffn = (const float*)d_in[18];
        const float* w_rg = (const float*)d_in[19]; const float* b_rg = (const float*)d_in[20]; const float* w_re = (const float*)d_in[21]; const float* b_re2 = (const float*)d_in[22];
        const float* w_eg = (const float*)d_in[23]; const float* w_eu = (const float*)d_in[24]; const float* w_ed = (const float*)d_in[25];
        const float* norm_ple = (const float*)d_in[26]; const float* w_pg = (const float*)d_in[27]; const float* w_ple = (const float*)d_in[28]; const float* norm_f = (const float*)d_in[29];
        float* out = (float*)d_out; float* ws = (float*)d_ws;
        constexpr int T = base::T, D = base::D, INC = base::INC, RW = base::RW, SW = base::SW, NE = base::NE, FE = base::FE, PLE = base::PLE;
        float* H = ws; float* PROJ = H + (size_t)T * D; float* YRET = PROJ + (size_t)T * INC; float* YSSM = YRET + (size_t)T * RW;
        int* ctl = (int*)(YSSM + (size_t)T * SW);
        int* cnt = ctl; int* off = ctl + 64; float* wgt = (float*)(ctl + 128); int* list = ctl + 128 + 2 * T; int* tokidx = list + (size_t)NE * T;
        float* ACT = YRET; float* MOE = PROJ; float* PP = PROJ;
        hipMemsetAsync(cnt, 0, 128 * sizeof(int), stream);
        hipLaunchKernelGGL(k_rmsnorm, dim3(T), dim3(256), 0, stream, (const float*)out, norm_ffn, H);
        hipLaunchKernelGGL(k_router, dim3(T / 4), dim3(256), 0, stream, (const float*)H, w_rg, b_rg, w_re, b_re2, cnt, list, wgt);
        hipLaunchKernelGGL(k_offsets, dim3(1), dim3(64), 0, stream, (const int*)cnt, off, tokidx, (const int*)list);
        hipLaunchKernelGGL(k_tokidx, dim3(16, NE), dim3(256), 0, stream, (const int*)cnt, (const int*)list, tokidx);
        gemm<EpiGateUp, true>(stream, GArgs{H, w_eg, w_eu, tokidx, cnt, (long)D * FE, (long)T, D, FE, T, FE, D, 0}, EpiGateUp{ACT, off}, NE, T);
        hipLaunchKernelGGL(k_fillidx, dim3(16, NE), dim3(256), 0, stream, (const int*)cnt, (const int*)off, tokidx);
        gemm<EpiDown, false>(stream, GArgs{ACT, w_ed, nullptr, tokidx, cnt, (long)FE * D, (long)T, FE, D, T, D, FE, 0}, EpiDown{MOE, list, wgt}, NE, T);
        hipLaunchKernelGGL(k_moe_combine, dim3(T), dim3(256), 0, stream, out, (const float*)MOE, norm_ple, H);
        gemm<EpiStore, false>(stream, GArgs{p, w_ple, nullptr, nullptr, nullptr, 0, 0, PLE, D, T, D, PLE, 0}, EpiStore{PP, D});
        gemm<EpiPle, false>(stream, GArgs{H, w_pg, nullptr, nullptr, nullptr, 0, 0, D, D, T, D, D, 0}, EpiPle{PP, out, D});
        hipLaunchKernelGGL(k_rmsnorm, dim3(T), dim3(256), 0, stream, (const float*)out, norm_f, out);
    }
}
```

```cpp
#include <hip/hip_runtime.h>
#include <math.h>
#include <stdio.h>
#include <stdint.h>
namespace pg8 {
#define PG8_LAS __attribute__((address_space(3)))
typedef unsigned short bf16_t;
typedef short bf16x8 __attribute__((ext_vector_type(8)));
typedef float f32x4 __attribute__((ext_vector_type(4)));
typedef float f32x2 __attribute__((ext_vector_type(2)));
typedef unsigned u32x4 __attribute__((ext_vector_type(4)));
typedef unsigned u32x2 __attribute__((ext_vector_type(2)));
constexpr int BM = 256, BK = 64, HALF = 128, HTB = HALF * BK * 2  , STAGE_BYTES = 8 * HTB, NXCD = 8, WGM = 8;

__host__ __device__ __forceinline__ int lds_byte(int r, int c) { const int st = (r >> 4) * 2 + (c >> 5), rr = r & 15, cc = c & 31, ob = rr * 64 + cc * 2; return st * 1024 + (ob ^ (((ob >> 9) & 1) << 5)); }
__host__ __device__ __forceinline__ void stage_rc(int b, int& R, int& C) { const int st = b / 1024, sb = b % 1024, swz = sb ^ (((sb >> 9) & 1) << 5); R = (st >> 1) * 16 + swz / 64; C = (st & 1) * 32 + (swz % 64) / 2; }
__host__ __device__ __forceinline__ int perm32(int rho) { const int n = rho >> 4, i = rho & 15; return 8 * (i >> 2) + 4 * n + (i & 3); }

struct Unit { int pm, pn, z; };
__device__ __forceinline__ const char* uptr(const char* p) {
    const unsigned long long v = (unsigned long long)p; const unsigned lo = __builtin_amdgcn_readfirstlane((unsigned)v), hi = __builtin_amdgcn_readfirstlane((unsigned)(v >> 32));
    return (const char*)(((unsigned long long)hi << 32) | lo); }

__device__ __forceinline__ void tile_of(int L, int nM, int nN, int& pm, int& pn) {
    const int nwg = nM * nN; int wgid = L; { const int q = nwg / NXCD, r = nwg % NXCD, xcd = wgid % NXCD, off = wgid / NXCD; wgid = (xcd < r ? xcd * (q + 1) : r * (q + 1) + (xcd - r) * q) + off; }
    const int nig = WGM * nN, gid = wgid / nig, fm = gid * WGM, gsz = (nM - fm) < WGM ? (nM - fm) : WGM;
    pm = fm + ((wgid % nig) % gsz); pn = (wgid % nig) / gsz;
}
struct SchedPlain {
    static constexpr bool GATHER = false;
    const char* A; const char* B; unsigned lda2, ldb2; int nM, nN, G, c;
    __device__ __forceinline__ void init(const void* A_, int lda, const void* B_, int ldb, int M, int N, int G_, int c_) { A = (const char*)A_; B = (const char*)B_; lda2 = lda * 2; ldb2 = ldb * 2; nM = M / BM; nN = N / BM; G = G_; c = c_; }
    __device__ __forceinline__ bool next(int i, Unit& u) const { const int L = i * G + c; if (L >= nM * nN) return false; tile_of(L, nM, nN, u.pm, u.pn); u.z = 0; return true; }
    __device__ __forceinline__ const char* a_ptr(const Unit& u) const { return A + (size_t)u.pm * BM * lda2; }
    __device__ __forceinline__ const char* b_ptr(const Unit& u) const { return B + (size_t)u.pn * BM * ldb2; }
    __device__ __forceinline__ void a_off(const Unit&, const int (&R)[2], const int (&C)[2], unsigned (&v)[2][2]) const {
#pragma unroll
        for (int h = 0; h < 2; ++h)
#pragma unroll
            for (int i = 0; i < 2; ++i) v[h][i] = (unsigned)(h * HALF + R[i]) * lda2 + (unsigned)C[i] * 2u; }
};
struct SchedBatch {
    static constexpr bool GATHER = false;
    const char* A; const char* B; unsigned lda2, ldb2; size_t sA, sB; int nMz, nz, G, c;
    __device__ __forceinline__ bool next(int i, Unit& u) const { const int L = i * G + c; if (L >= nMz * nz) return false; u.z = L >> 2; u.pm = L & 3; u.pn = 0; return true; }
    __device__ __forceinline__ const char* a_ptr(const Unit& u) const { return A + (size_t)u.z * sA + (size_t)u.pm * BM * lda2; }
    __device__ __forceinline__ const char* b_ptr(const Unit& u) const { return B + (size_t)u.z * sB; }
    __device__ __forceinline__ void a_off(const Unit&, const int (&R)[2], const int (&C)[2], unsigned (&v)[2][2]) const {
#pragma unroll
        for (int h = 0; h < 2; ++h)
#pragma unroll
            for (int i = 0; i < 2; ++i) v[h][i] = (unsigned)(h * HALF + R[i]) * lda2 + (unsigned)C[i] * 2u; }
};
struct SchedTwoPass {
    static constexpr bool GATHER = false;
    const char* A0; const char* A1; const char* B0; const char* B1; unsigned lda2, ldb2; int nM, nN, G, c;
    __device__ __forceinline__ bool next(int i, Unit& u) const { const int L = (i >> 1) * G + c; if (L >= nM * nN) return false; tile_of(L, nM, nN, u.pm, u.pn); u.z = i & 1; return true; }
    __device__ __forceinline__ const char* a_ptr(const Unit& u) const { return (u.z ? A1 : A0) + (size_t)u.pm * BM * lda2; }
    __device__ __forceinline__ const char* b_ptr(const Unit& u) const { return (u.z ? B1 : B0) + (size_t)u.pn * BM * ldb2; }
    __device__ __forceinline__ void a_off(const Unit&, const int (&R)[2], const int (&C)[2], unsigned (&v)[2][2]) const {
#pragma unroll
        for (int h = 0; h < 2; ++h)
#pragma unroll
            for (int i = 0; i < 2; ++i) v[h][i] = (unsigned)(h * HALF + R[i]) * lda2 + (unsigned)C[i] * 2u; }
};

typedef float f32x2_t __attribute__((ext_vector_type(2))); typedef __bf16 bf16x2_t __attribute__((ext_vector_type(2)));
__device__ __forceinline__ unsigned cvt_pk_bf16(float lo, float hi) { f32x2_t v = {lo, hi}; bf16x2_t b = __builtin_convertvector(v, bf16x2_t); return __builtin_bit_cast(unsigned, b); }
__device__ __forceinline__ float bf_lo(unsigned w) { return __uint_as_float(w << 16); }
__device__ __forceinline__ float bf_hi(unsigned w) { return __uint_as_float(w & 0xffff0000u); }
__device__ __forceinline__ float fsigm(float x) { return __builtin_amdgcn_rcpf(1.f + __builtin_amdgcn_exp2f(-1.4426950408889634f * x)); }
__device__ __forceinline__ u32x4 pack8(const f32x4& a, const f32x4& b) { u32x4 w; w.x = cvt_pk_bf16(a[0], a[1]); w.y = cvt_pk_bf16(a[2], a[3]); w.z = cvt_pk_bf16(b[0], b[1]); w.w = cvt_pk_bf16(b[2], b[3]); return w; }
__device__ __forceinline__ void unpack8(const u32x4& w, f32x4& a, f32x4& b) { a = (f32x4){bf_lo(w.x), bf_hi(w.x), bf_lo(w.y), bf_hi(w.y)}; b = (f32x4){bf_lo(w.z), bf_hi(w.z), bf_lo(w.w), bf_hi(w.w)}; }

template <class Epi, class Sched, bool ALIGN_EPI = true>
__device__ __forceinline__ void gemm_phase(PG8_LAS unsigned char* lds, const int K, const Sched& S, const Epi& E) {
    const int tid = threadIdx.x, wid = __builtin_amdgcn_readfirstlane(tid >> 6), lane = tid & 63, wr = wid >> 2, wc = wid & 3, fr = lane & 15, fq = lane >> 4;
    const int nt = K / BK;
    int Rr[2], Cc[2]; unsigned voffB[2], voffA[2];
#pragma unroll
    for (int i = 0; i < 2; ++i) { stage_rc(tid * 16 + i * 8192, Rr[i], Cc[i]); const int Rb = Epi::PERM ? ((Rr[i] & ~31) + perm32(Rr[i] & 31)) : Rr[i];
        voffB[i] = (unsigned)Rb * S.ldb2 + (unsigned)Cc[i] * 2u; voffA[i] = (unsigned)Rr[i] * S.lda2 + (unsigned)Cc[i] * 2u; }
    const size_t ah = (size_t)HALF * S.lda2;
    const size_t kstep = (size_t)(BK * 2);
    const size_t bh = (size_t)HALF * S.ldb2;
    const unsigned ldsw = (unsigned)wid * 1024u;
    const int aoff = lds_byte(wr * 64 + fr, fq * 8), boff = lds_byte(wc * 32 + fr, fq * 8);
#define PG8_SA(b, h) (((b) * 2 + (h)) * HTB)
#define PG8_SB(b, h) ((4 + (b) * 2 + (h)) * HTB)
#define PG8_STAGE(bufoff, gbase, voff) do { _Pragma("unroll") for (int _i = 0; _i < 2; ++_i) \
        __builtin_amdgcn_global_load_lds((const unsigned*)((const char*)(gbase) + (voff)[_i]), (PG8_LAS unsigned*)(lds + (bufoff) + ldsw + _i * 8192), 16, 0, 0); } while (0)
#define PG8_STAGE_A(bufoff, h, gbase, VG) do { if constexpr (Sched::GATHER) { PG8_STAGE(bufoff, gbase, VG[h]); } else { PG8_STAGE(bufoff, (gbase) + (h) * ah, voffA); } } while (0)
#define PG8_LDA(dst, b, h) do { _Pragma("unroll") for (int m = 0; m < 4; ++m) _Pragma("unroll") for (int k = 0; k < 2; ++k) dst[m][k] = *(const PG8_LAS bf16x8*)(lds + PG8_SA(b, h) + aoff + m * 2048 + k * 1024); } while (0)
#define PG8_LDB(dst, b, h) do { _Pragma("unroll") for (int n = 0; n < 2; ++n) _Pragma("unroll") for (int k = 0; k < 2; ++k) dst[n][k] = *(const PG8_LAS bf16x8*)(lds + PG8_SB(b, h) + boff + n * 2048 + k * 1024); } while (0)
#define PG8_MMA(ai, bj, At, Bt) do { __builtin_amdgcn_s_setprio(1); _Pragma("unroll") for (int m = 0; m < 4; ++m) _Pragma("unroll") for (int n = 0; n < 2; ++n) _Pragma("unroll") for (int k = 0; k < 2; ++k) \
        acc[ai][bj][m][n] = __builtin_amdgcn_mfma_f32_16x16x32_bf16(Bt[n][k], At[m][k], acc[ai][bj][m][n], 0, 0, 0); __builtin_amdgcn_s_setprio(0); } while (0)
#define PG8_WAIT_V(n) asm volatile("s_waitcnt vmcnt(" #n ")" ::: "memory")
#define PG8_WAIT_L(n) asm volatile("s_waitcnt lgkmcnt(" #n ")" ::: "memory")
#define PG8_BAR __builtin_amdgcn_s_barrier()
#define PG8_SCHED __builtin_amdgcn_sched_barrier(0)
    Unit cur, nxt; int ui = 0;
    if (!S.next(0, cur)) return;
    f32x4 acc[2][2][4][2];
#pragma unroll
    for (int a = 0; a < 2; ++a)
#pragma unroll
        for (int b = 0; b < 2; ++b)
#pragma unroll
            for (int m = 0; m < 4; ++m)
#pragma unroll
                for (int n = 0; n < 2; ++n) acc[a][b][m][n] = (f32x4){0.f, 0.f, 0.f, 0.f};
    bf16x8 At[4][2], B0[2][2], B1[2][2];
    unsigned vAc[2][2], vAn[2][2];
    if constexpr (Sched::GATHER) S.a_off(cur, Rr, Cc, vAc);
    const char* cA = uptr(S.a_ptr(cur)); const char* cB = uptr(S.b_ptr(cur));
    PG8_STAGE(PG8_SB(0, 0), cB, voffB); PG8_STAGE(PG8_SB(0, 1), cB + bh, voffB); PG8_STAGE_A(PG8_SA(0, 0), 0, cA, vAc); PG8_STAGE_A(PG8_SA(0, 1), 1, cA, vAc);
    if (wr == 1) PG8_BAR;
    PG8_WAIT_V(2); PG8_BAR;
    PG8_STAGE(PG8_SB(1, 0), cB + kstep, voffB); PG8_STAGE_A(PG8_SA(1, 0), 0, cA + kstep, vAc); PG8_STAGE(PG8_SB(1, 1), cB + bh + kstep, voffB);
    PG8_WAIT_V(6); PG8_BAR;
    for (;;) {
        const bool has_next = S.next(ui + 1, nxt);
        const char* nA = cA; const char* nB = cB;
        if constexpr (Sched::GATHER) {
#pragma unroll
            for (int h = 0; h < 2; ++h)
#pragma unroll
                for (int i = 0; i < 2; ++i) vAn[h][i] = vAc[h][i]; }
        if (has_next) { nA = uptr(S.a_ptr(nxt)); nB = uptr(S.b_ptr(nxt)); if constexpr (Sched::GATHER) S.a_off(nxt, Rr, Cc, vAn); }
#pragma unroll 1
        for (int t = 0; t < nt; t += 2) {
            const bool last = (t == nt - 2);
            const char* a1 = cA + (size_t)(t + 1) * kstep;
            const char* a2 = last ? nA : cA + (size_t)(t + 2) * kstep; const char* b2 = last ? nB : cB + (size_t)(t + 2) * kstep;
            const char* a3 = a2 + kstep; const char* b3 = b2 + kstep;
            unsigned v2[2][2];
            if constexpr (Sched::GATHER) {
#pragma unroll
                for (int h = 0; h < 2; ++h)
#pragma unroll
                    for (int i = 0; i < 2; ++i) v2[h][i] = last ? vAn[h][i] : vAc[h][i]; }
            PG8_LDB(B0, 0, 0); PG8_LDB(B1, 0, 1); PG8_SCHED; PG8_LDA(At, 0, 0); PG8_STAGE_A(PG8_SA(1, 1), 1, a1, vAc);
            PG8_WAIT_V(8); PG8_WAIT_L(0); PG8_BAR; PG8_MMA(0, 0, At, B0); PG8_MMA(0, 1, At, B1); PG8_BAR; PG8_SCHED;
            PG8_LDA(At, 0, 1); PG8_STAGE(PG8_SB(0, 0), b2, voffB); PG8_STAGE(PG8_SB(0, 1), b2 + bh, voffB); PG8_STAGE_A(PG8_SA(0, 0), 0, a2, v2);
            PG8_WAIT_V(8); PG8_WAIT_L(0); PG8_BAR; PG8_MMA(1, 0, At, B0); PG8_MMA(1, 1, At, B1); PG8_BAR; PG8_SCHED;
            PG8_LDB(B0, 1, 0); PG8_LDB(B1, 1, 1); PG8_SCHED; PG8_LDA(At, 1, 0); PG8_STAGE_A(PG8_SA(0, 1), 1, a2, v2);
            PG8_WAIT_V(8); PG8_WAIT_L(0); PG8_BAR; PG8_MMA(0, 0, At, B0); PG8_MMA(0, 1, At, B1); PG8_BAR; PG8_SCHED;
            PG8_LDA(At, 1, 1); PG8_STAGE(PG8_SB(1, 0), b3, voffB); PG8_STAGE(PG8_SB(1, 1), b3 + bh, voffB); PG8_STAGE_A(PG8_SA(1, 0), 0, a3, v2);
            PG8_WAIT_V(8); PG8_WAIT_L(0); PG8_BAR; PG8_MMA(1, 0, At, B0); PG8_MMA(1, 1, At, B1); PG8_BAR; PG8_SCHED;
        }
        if constexpr (ALIGN_EPI) { if (wr == 0) PG8_BAR; }
        E(acc, cur, wr, wc, fr, fq);
        if (!has_next) break;
#pragma unroll
        for (int a = 0; a < 2; ++a)
#pragma unroll
            for (int b = 0; b < 2; ++b)
#pragma unroll
                for (int m = 0; m < 4; ++m)
#pragma unroll
                    for (int n = 0; n < 2; ++n) acc[a][b][m][n] = (f32x4){0.f, 0.f, 0.f, 0.f};
        cur = nxt; cA = nA; cB = nB; ++ui;
        if constexpr (Sched::GATHER) {
#pragma unroll
            for (int h = 0; h < 2; ++h)
#pragma unroll
                for (int i = 0; i < 2; ++i) vAc[h][i] = vAn[h][i]; }
        if constexpr (ALIGN_EPI) { if (wr == 1) PG8_BAR; }
    }
    PG8_WAIT_V(0);
    if constexpr (!ALIGN_EPI) { if (wr == 0) PG8_BAR; }
    PG8_BAR;
#undef PG8_SA
#undef PG8_SB
#undef PG8_STAGE
#undef PG8_STAGE_A
#undef PG8_LDA
#undef PG8_LDB
#undef PG8_MMA
#undef PG8_WAIT_V
#undef PG8_WAIT_L
#undef PG8_BAR
#undef PG8_SCHED
}
}

#define XB_TMO      128
#define XB_XCNT(j)  (256  + 64 * (j))
#define XB_XSUB(j)  (1280 + 64 * (j))
#define XB_XGEN(j)  (2304 + 64 * (j))
#define XB_TOP      3328
#define XB_TOPGEN   3392
#define XCD_BAR_WORDS 3456
#define XB_SPIN_CAP (1u << 18)
#define LAS __attribute__((address_space(3)))

__device__ __forceinline__ unsigned xb_ld(unsigned* p)              { return __hip_atomic_load(p, __ATOMIC_RELAXED, __HIP_MEMORY_SCOPE_AGENT); }
__device__ __forceinline__ unsigned xb_add(unsigned* p, unsigned v) { return __hip_atomic_fetch_add(p, v, __ATOMIC_RELAXED, __HIP_MEMORY_SCOPE_AGENT); }
__device__ __forceinline__ unsigned xb_xcc_id() { return (unsigned)__builtin_amdgcn_s_getreg((3 << 11) | 20) & 0xFu; }
#define XB_SPIN(cond, bar) do { unsigned _sp = 0; while (cond) { __builtin_amdgcn_s_sleep(1); \
    if ((++_sp & 255u) == 0u) { if (xb_ld(&(bar)[XB_TMO])) break; if (_sp > XB_SPIN_CAP) { atomicAdd(&(bar)[XB_TMO], 1u); break; } } } } while (0)

struct XcdBarrier {
    unsigned* bar; unsigned x;
    volatile LAS unsigned* st;
};

__device__ __forceinline__ XcdBarrier xcd_barrier_post(unsigned* bar, volatile LAS unsigned* st) {
    XcdBarrier b; b.bar = bar; b.x = xb_xcc_id(); b.st = st;
    if (threadIdx.x == 0) (void)xb_add(&bar[XB_XCNT(b.x)], 1u);
    return b;
}
__device__ __forceinline__ void xcd_barrier_complete(unsigned* bar, unsigned x, unsigned& nloc, unsigned& nx) {
    const unsigned G = gridDim.x * gridDim.y * gridDim.z;
    unsigned sum, cnt, mine, sp = 0u;
    for (;;) {
        sum = 0u; cnt = 0u; mine = 0u;
#pragma unroll
        for (unsigned j = 0; j < 16; ++j) { const unsigned c = xb_ld(&bar[XB_XCNT(j)]); sum += c; cnt += (c > 0u) ? 1u : 0u; mine = (j == x) ? c : mine; }
        if (sum == G) break;
        __builtin_amdgcn_s_sleep(1);
        if ((++sp & 255u) == 0u) { if (xb_ld(&bar[XB_TMO])) break; if (sp > XB_SPIN_CAP) { atomicAdd(&bar[XB_TMO], 1u); break; } }
    }
    nloc = mine > 0u ? mine : 1u; nx = cnt > 0u ? cnt : 1u;
}

__device__ __forceinline__ void xcd_barrier(const XcdBarrier& b) {
    asm volatile("s_waitcnt vmcnt(0)" ::: "memory");
    __syncthreads();
    if (threadIdx.x == 0) {
        unsigned* bar = b.bar;
        __builtin_amdgcn_s_waitcnt(0);
        unsigned nloc = b.st[0], nx = b.st[1];
        if (nloc == 0u) { xcd_barrier_complete(bar, b.x, nloc, nx); b.st[0] = nloc; b.st[1] = nx; }
        const unsigned old = xb_add(&bar[XB_XSUB(b.x)], 1u);
        const unsigned gen = old / nloc;
        if (old + 1u == (gen + 1u) * nloc) {
            __builtin_amdgcn_fence(__ATOMIC_RELEASE, "agent");
            asm volatile("s_waitcnt vmcnt(0)" ::: "memory");
            const unsigned og = xb_add(&bar[XB_TOP], 1u);
            const unsigned tg = og / nx;
            if (og + 1u == (tg + 1u) * nx) xb_add(&bar[XB_TOPGEN], 1u);
            else XB_SPIN(xb_ld(&bar[XB_TOPGEN]) == tg, bar);
            __builtin_amdgcn_fence(__ATOMIC_ACQUIRE, "agent");
            xb_add(&bar[XB_XGEN(b.x)], 1u);
            asm volatile("s_waitcnt vmcnt(0)" ::: "memory");
        } else {
            XB_SPIN(xb_ld(&bar[XB_XGEN(b.x)]) == gen, bar);
            __builtin_amdgcn_fence(__ATOMIC_ACQUIRE, "agent");
            asm volatile("s_waitcnt vmcnt(0)" ::: "memory");
        }
    }
    __syncthreads();
}


constexpr int NWAVES = 8;
constexpr int T = 16384, D = 2048, RW = 1024, NH = 8, DH = 128, SG = 64, SP = 64, SC = 16, NE = 32, FE = 512, PLE = 256, INC = 5120;
constexpr int N1 = 9216;
constexpr int S5L = 16, S5NC = T / S5L, S5K = 384;
constexpr int RSC = 32, RCH = 8;
constexpr float EPS = 1e-6f;

constexpr size_t MiB = 1u << 20;
constexpr size_t WS_CTL = 0, CTL_ZERO_BYTES = 1 * MiB;
constexpr size_t WS_LIST = 1 * MiB, WS_WGT = 3 * MiB, WS_RINV = 3 * MiB + 256 * 1024, WS_LAM = 3 * MiB + 512 * 1024;
constexpr size_t WS_COS = 4 * MiB, WS_SIN = 8 * MiB, WS_PB = 12 * MiB;
constexpr size_t WS_WT1 = 20 * MiB, WS_WGLU = 56 * MiB, WS_WA = 58 * MiB, WS_WB = 62 * MiB, WS_WOUT = 66 * MiB, WS_WPG = 74 * MiB, WS_WP = 82 * MiB, WS_BTC = 83 * MiB, WS_BLT = 95 * MiB;
constexpr size_t WS_HB = 100 * MiB, WS_YRET = 100 * MiB, WS_YPRE = 132 * MiB;
constexpr size_t WS_Q = 164 * MiB, WS_K = 196 * MiB, WS_V = 228 * MiB, WS_G = 260 * MiB, WS_UA = 292 * MiB, WS_EST = 340 * MiB, WS_KVS = 372 * MiB;
constexpr size_t WS_MERGED = 164 * MiB, WS_YSSM = 228 * MiB;
constexpr size_t WS_END = 600 * MiB;
constexpr int CW_TMO = 0, CW_CODE = 1, CW_BAR = 4096, CW_Q0 = 8192  , CW_CNT = 8256  ;

constexpr int RING_OFF = 0, RING_BYTES = 131072;
constexpr int LDSCTL_OFF = RING_BYTES, MISC_OFF = LDSCTL_OFF + 320;
constexpr int LDS_BYTES = 147456;

#define GAS __attribute__((address_space(1)))
typedef unsigned short bf16;
typedef unsigned v4u __attribute__((ext_vector_type(4)));
typedef unsigned v2u __attribute__((ext_vector_type(2)));
typedef float f32x4 __attribute__((ext_vector_type(4)));
typedef short bf16x8 __attribute__((ext_vector_type(8)));
typedef short s16x4 __attribute__((ext_vector_type(4)));
typedef short v4i16_t __attribute__((ext_vector_type(4)));
typedef GAS unsigned gu32;
#define RLX_AGENT __ATOMIC_RELAXED, __HIP_MEMORY_SCOPE_AGENT
#define LDS_WAIT() asm volatile("s_waitcnt lgkmcnt(0)" ::: "memory")
#define VM_WAIT() asm volatile("s_waitcnt vmcnt(0)" ::: "memory")
using pg8::cvt_pk_bf16; using pg8::bf_lo; using pg8::bf_hi; using pg8::fsigm;

struct Frame {
    LAS unsigned char* lds;
    volatile LAS unsigned* MISC;
    unsigned* ctl;
    int tid, lane, wave, G;
};
__device__ __forceinline__ float wave_sum(float v) {
#pragma unroll
    for (int o = 1; o < 64; o <<= 1) v += __shfl_xor(v, o);
    return v;
}
__device__ __forceinline__ int wg_next_item(Frame& F, unsigned* ctr) {
    __syncthreads();
    if (F.tid == 0) F.MISC[16] = __hip_atomic_fetch_add(ctr, 1u, RLX_AGENT);
    __syncthreads();
    return (int)F.MISC[16];
}

template <int MODE>
__device__ __forceinline__ void transpose_item(const float* W, int K, int N, bf16* WT, int ldt, int row_off, LAS float* scr, int item, int lane) {
    const int nblk = N / 32, kb = item / nblk, nb = item % nblk, k0 = 64 * kb, n0 = 32 * nb;
#pragma unroll 8
    for (int i = 0; i < 32; ++i) { const int kk = 2 * i + (lane >> 5); scr[kk * 33 + (lane & 31)] = W[(size_t)(k0 + kk) * N + n0 + (lane & 31)]; }
    LDS_WAIT(); asm volatile("" ::: "memory");
    const int c = lane & 7;
#pragma unroll
    for (int j = 0; j < 4; ++j) { const int n = (lane >> 3) + 8 * j; const LAS float* s = scr + (8 * c) * 33 + n;
        v4u o; o.x = cvt_pk_bf16(s[0 * 33], s[1 * 33]); o.y = cvt_pk_bf16(s[2 * 33], s[3 * 33]); o.z = cvt_pk_bf16(s[4 * 33], s[5 * 33]); o.w = cvt_pk_bf16(s[6 * 33], s[7 * 33]);
        const int nn = n0 + n; const int row = MODE == 0 ? row_off + nn : (MODE == 1 ? 8 * (nn >> 2) + (nn & 3) : 8 * (nn >> 2) + 4 + (nn & 3));
        *(GAS v4u*)(WT + (size_t)row * ldt + k0 + 8 * c) = o; }
    LDS_WAIT(); asm volatile("" ::: "memory");
}
__device__ __forceinline__ void rms_row_to_bf16(int lane, const float* xrow, const float* w, bf16* orow) {
    const GAS f32x4* xr = (const GAS f32x4*)xrow + lane; const GAS f32x4* wr = (const GAS f32x4*)w + lane;
    f32x4 v[8]; float s = 0.f;
#pragma unroll
    for (int j = 0; j < 8; ++j) { v[j] = xr[64 * j]; s += (v[j].x * v[j].x + v[j].y * v[j].y) + (v[j].z * v[j].z + v[j].w * v[j].w); }
    const float r = rsqrtf(wave_sum(s) * (1.f / D) + EPS);
    GAS v2u* o8 = (GAS v2u*)orow + lane;
#pragma unroll
    for (int j = 0; j < 8; ++j) { const f32x4 ww = wr[64 * j]; v2u o; o.x = cvt_pk_bf16(v[j].x * r * ww.x, v[j].y * r * ww.y); o.y = cvt_pk_bf16(v[j].z * r * ww.z, v[j].w * r * ww.w); o8[64 * j] = o; }
}
__device__ __forceinline__ void s5_tables(Frame& F, int g, const float* lam_re, const float* lam_im, const float* log_dt, const float* b_re, const float* b_im, const float* c_re, const float* c_im, const float* dvec,
                                          bf16* BTC, bf16* BLT, float* LAMT) {
    LAS double* PW = (LAS double*)(F.lds);
    LAS double* BB = (LAS double*)(F.lds + 17408);
    LAS double* CC = (LAS double*)(F.lds + 33792);
    LAS float* KM = (LAS float*)(F.lds + 50176);
    const int tid = F.tid;
    if (tid < 64) {
        const int p = tid; const double lr = fmin((double)lam_re[g * SP + p], -1e-4), li = (double)lam_im[g * SP + p], dt = exp((double)log_dt[g]);
        for (int j = 0; j <= 16; ++j) { const double mag = exp((double)j * lr * dt); double sn, cs; sincos((double)j * li * dt, &sn, &cs); PW[(j * 64 + p) * 2] = mag * cs; PW[(j * 64 + p) * 2 + 1] = mag * sn; }
        { const double mag = exp(512.0 * lr * dt); double sn, cs; sincos(512.0 * li * dt, &sn, &cs);
          LAMT[(g * 64 + p) * 4 + 2] = (float)(mag * cs); LAMT[(g * 64 + p) * 4 + 3] = (float)(mag * sn); }
        const double lbr = PW[(1 * 64 + p) * 2], lbi = PW[(1 * 64 + p) * 2 + 1];
        LAMT[(g * 64 + p) * 4 + 0] = (float)PW[(16 * 64 + p) * 2]; LAMT[(g * 64 + p) * 4 + 1] = (float)PW[(16 * 64 + p) * 2 + 1];
        const double nr = lbr - 1.0, ni = lbi, den = lr * lr + li * li; const double fr = (nr * lr + ni * li) / den, fi = (ni * lr - nr * li) / den;
        for (int c = 0; c < 16; ++c) { const double br = b_re[(g * SP + p) * SC + c], bi = b_im[(g * SP + p) * SC + c]; BB[(p * 16 + c) * 2] = fr * br - fi * bi; BB[(p * 16 + c) * 2 + 1] = fr * bi + fi * br; }
    }
    for (int idx = tid; idx < 1024; idx += 512) { const int c = idx >> 6, p = idx & 63; CC[idx * 2] = (double)c_re[(g * SC + c) * SP + p]; CC[idx * 2 + 1] = (double)c_im[(g * SC + c) * SP + p]; }
    __syncthreads();
    for (int idx = tid; idx < 4096; idx += 512) { const int j = idx >> 8, c = (idx >> 4) & 15, c2 = idx & 15; double s = 0.0;
        for (int p = 0; p < 64; ++p) { const double cr = CC[(c * 64 + p) * 2], ci = CC[(c * 64 + p) * 2 + 1], pr = PW[(j * 64 + p) * 2], pi = PW[(j * 64 + p) * 2 + 1];
            const double ar = cr * pr - ci * pi, ai = cr * pi + ci * pr; s += ar * BB[(p * 16 + c2) * 2] - ai * BB[(p * 16 + c2) * 2 + 1]; }
        if (j == 0 && c == c2) s += (double)dvec[g * SC + c];
        KM[idx] = (float)s; }
    __syncthreads();
    for (int idx = tid; idx < 256 * 48; idx += 512) { const int n = idx / 48, kc = idx % 48, s = n >> 4, c = n & 15; float v[8];
        if (kc < 32) { const int t = kc >> 1, c0 = (kc & 1) * 8;
#pragma unroll
            for (int j = 0; j < 8; ++j) v[j] = (t <= s) ? KM[((s - t) * 16 + c) * 16 + c0 + j] : 0.f;
        } else { const int q = kc - 32, part = q >> 3, p0 = (q & 7) * 8;
#pragma unroll
            for (int j = 0; j < 8; ++j) { const int p = p0 + j; const double cr = CC[(c * 64 + p) * 2], ci = CC[(c * 64 + p) * 2 + 1], pr = PW[((s + 1) * 64 + p) * 2], pi = PW[((s + 1) * 64 + p) * 2 + 1];
                v[j] = part ? (float)(-(cr * pi + ci * pr)) : (float)(cr * pr - ci * pi); } }
        v4u o; o.x = cvt_pk_bf16(v[0], v[1]); o.y = cvt_pk_bf16(v[2], v[3]); o.z = cvt_pk_bf16(v[4], v[5]); o.w = cvt_pk_bf16(v[6], v[7]);
        *(GAS v4u*)(BTC + ((size_t)(g * 256 + n) * S5K + kc * 8)) = o; }
    for (int idx = tid; idx < 128 * 32; idx += 512) { const int n = idx >> 5, kc = idx & 31, p = n & 63, part = n >> 6, t = kc >> 1, c0 = (kc & 1) * 8; float v[8];
        const double pr = PW[((15 - t) * 64 + p) * 2], pi = PW[((15 - t) * 64 + p) * 2 + 1];
#pragma unroll
        for (int j = 0; j < 8; ++j) { const double br = BB[(p * 16 + c0 + j) * 2], bi = BB[(p * 16 + c0 + j) * 2 + 1]; v[j] = part ? (float)(pr * bi + pi * br) : (float)(pr * br - pi * bi); }
        v4u o; o.x = cvt_pk_bf16(v[0], v[1]); o.y = cvt_pk_bf16(v[2], v[3]); o.z = cvt_pk_bf16(v[4], v[5]); o.w = cvt_pk_bf16(v[6], v[7]);
        *(GAS v4u*)(BLT + ((size_t)(g * 128 + n) * 256 + kc * 8)) = o; }
    __syncthreads();
}

using pg8::Unit; using pg8::pack8; using pg8::unpack8;
struct EpiProj {
    static constexpr bool PERM = true;
    bf16* QKVG; bf16* UA; bf16* GATES;
    __device__ __forceinline__ void operator()(const f32x4 (&acc)[2][2][4][2], const Unit& u, int wr, int wc, int fr, int fq) const {
        const int row0 = u.pm * 256 + wr * 64 + fr, ct = wc * 32 + 8 * fq;
        if (u.pn < 16) { bf16* dst = QKVG + (size_t)(u.pn >> 2) * T * RW + (u.pn & 3) * 256 + ct;
#pragma unroll
            for (int ai = 0; ai < 2; ++ai)
#pragma unroll
                for (int m = 0; m < 4; ++m) { const size_t row = row0 + ai * 128 + m * 16;
#pragma unroll
                    for (int bj = 0; bj < 2; ++bj) *(v4u*)(dst + row * RW + bj * 128) = pack8(acc[ai][bj][m][0], acc[ai][bj][m][1]); }
        } else if (u.pn < 20) {
#pragma unroll
            for (int ai = 0; ai < 2; ++ai)
#pragma unroll
                for (int m = 0; m < 4; ++m) { const int row = row0 + ai * 128 + m * 16, ci = row >> 4, s = row & 15;
#pragma unroll
                    for (int bj = 0; bj < 2; ++bj) { const int cu = (u.pn - 16) * 256 + bj * 128 + ct, g = cu >> 4, c0 = cu & 15;
                        *(v4u*)(UA + ((size_t)(g * S5NC + ci) * S5K + 16 * s + c0)) = pack8(acc[ai][bj][m][0], acc[ai][bj][m][1]); } }
        } else { bf16* dst = GATES + (u.pn - 20) * 256 + ct;
#pragma unroll
            for (int ai = 0; ai < 2; ++ai)
#pragma unroll
                for (int m = 0; m < 4; ++m) { const size_t row = row0 + ai * 128 + m * 16;
#pragma unroll
                    for (int bj = 0; bj < 2; ++bj) { f32x4 a = acc[ai][bj][m][0], b = acc[ai][bj][m][1];
#pragma unroll
                        for (int j = 0; j < 4; ++j) { a[j] = fsigm(a[j]); b[j] = fsigm(b[j]); }
                        *(v4u*)(dst + row * 4096 + bj * 128) = pack8(a, b); } }
        }
    }
};
struct EpiS5A {
    static constexpr bool PERM = false;
    float* EST;
    __device__ __forceinline__ void operator()(const f32x4 (&acc)[2][2][4][2], const Unit& u, int wr, int wc, int fr, int fq) const {
        const int row0 = u.pm * 256 + wr * 64 + fr, col0 = wc * 32 + 4 * fq;
#pragma unroll
        for (int ai = 0; ai < 2; ++ai)
#pragma unroll
            for (int m = 0; m < 4; ++m) { float* rowp = EST + ((size_t)u.z * S5NC + row0 + ai * 128 + m * 16) * 128 + col0;
#pragma unroll
                for (int n = 0; n < 2; ++n) *(f32x4*)(rowp + n * 16) = acc[ai][0][m][n]; }
    }
};
struct EpiS5C {
    static constexpr bool PERM = true;
    bf16* YPRE;
    __device__ __forceinline__ void operator()(const f32x4 (&acc)[2][2][4][2], const Unit& u, int wr, int wc, int fr, int fq) const {
        const int row0 = u.pm * 256 + wr * 64 + fr, ct = wc * 32 + 8 * fq;
        bf16* yb = YPRE + ((size_t)row0 * 16 * RW + u.z * 16);
#pragma unroll
        for (int ai = 0; ai < 2; ++ai)
#pragma unroll
            for (int m = 0; m < 4; ++m) {
#pragma unroll
                for (int bj = 0; bj < 2; ++bj) { const int col = bj * 128 + ct, s = col >> 4, c0 = col & 15;
                    f32x4 a = acc[ai][bj][m][0], b = acc[ai][bj][m][1];
#pragma unroll
                    for (int j = 0; j < 4; ++j) { const float xa = a[j], xb = b[j];
                        a[j] = xa * fsigm(1.5957691216057308f * (xa + 0.044715f * xa * xa * xa)); b[j] = xb * fsigm(1.5957691216057308f * (xb + 0.044715f * xb * xb * xb)); }
                    *(v4u*)(yb + (size_t)(ai * 128 + m * 16) * 16 * RW + (size_t)s * RW + c0) = pack8(a, b); } }
    }
};
struct EpiGlu {
    static constexpr bool PERM = true;
    const bf16* YPRE; bf16* YSSM;
    __device__ __forceinline__ void operator()(const f32x4 (&acc)[2][2][4][2], const Unit& u, int wr, int wc, int fr, int fq) const {
        const int row0 = u.pm * 256 + wr * 64 + fr, col0 = u.pn * 256 + wc * 32 + 8 * fq;
#pragma unroll
        for (int ai = 0; ai < 2; ++ai)
#pragma unroll
            for (int m = 0; m < 4; ++m) { const size_t off = (size_t)(row0 + ai * 128 + m * 16) * RW + col0;
#pragma unroll
                for (int bj = 0; bj < 2; ++bj) { const v4u yw = *(const v4u*)(YPRE + off + bj * 128); f32x4 y0, y1; unpack8(yw, y0, y1);
                    f32x4 a = acc[ai][bj][m][0], b = acc[ai][bj][m][1];
#pragma unroll
                    for (int j = 0; j < 4; ++j) { a[j] = y0[j] * fsigm(a[j]); b[j] = y1[j] * fsigm(b[j]); }
                    *(v4u*)(YSSM + off + bj * 128) = pack8(a, b); }
                if (m & 1) asm volatile("" ::: "memory"); }
    }
};
struct EpiMerge {
    static constexpr bool PERM = true;
    const bf16* GATES; bf16* MERGED;
    __device__ __forceinline__ void operator()(const f32x4 (&acc)[2][2][4][2], const Unit& u, int wr, int wc, int fr, int fq) const {
        const int row0 = u.pm * 256 + wr * 64 + fr, col0 = u.pn * 256 + wc * 32 + 8 * fq;
#pragma unroll
        for (int ai = 0; ai < 2; ++ai)
#pragma unroll
            for (int m = 0; m < 4; ++m) { const size_t row = row0 + ai * 128 + m * 16;
#pragma unroll
                for (int bj = 0; bj < 2; ++bj) { const v4u gw = *(const v4u*)(GATES + row * 4096 + u.z * 2048 + col0 + bj * 128); f32x4 g0, g1; unpack8(gw, g0, g1);
                    f32x4 a = acc[ai][bj][m][0] * g0, b = acc[ai][bj][m][1] * g1;
                    bf16* mp = MERGED + row * D + col0 + bj * 128;
                    if (u.z) { const v4u pw = *(const v4u*)mp; f32x4 p0, p1; unpack8(pw, p0, p1); a += p0; b += p1; }
                    *(v4u*)mp = pack8(a, b); }
                if (m & 1) asm volatile("" ::: "memory"); }
    }
};
struct EpiOut {
    static constexpr bool PERM = false;
    const float* X; float* O;
    __device__ __forceinline__ void operator()(const f32x4 (&acc)[2][2][4][2], const Unit& u, int wr, int wc, int fr, int fq) const {
        const int row0 = u.pm * 256 + wr * 64 + fr, col0 = u.pn * 256 + wc * 32 + 4 * fq;
#pragma unroll
        for (int ai = 0; ai < 2; ++ai)
#pragma unroll
            for (int m = 0; m < 4; ++m) { const size_t off = (size_t)(row0 + ai * 128 + m * 16) * D + col0;
#pragma unroll
                for (int bj = 0; bj < 2; ++bj)
#pragma unroll
                    for (int n = 0; n < 2; ++n) { const f32x4 xv = *(const f32x4*)(X + off + bj * 128 + n * 16); *(f32x4*)(O + off + bj * 128 + n * 16) = xv + acc[ai][bj][m][n]; }
                asm volatile("" ::: "memory"); }
    }
};

__device__ __forceinline__ unsigned off_b(unsigned row, unsigned ch) { return 256u * row + 16u * (ch ^ (((row & 3) << 2) | ((row >> 2) & 3))); }
__device__ __forceinline__ unsigned rrow16(unsigned lane, unsigned rb, unsigned s) { return off_b((lane & 15) + 16 * rb, 4 * s + (lane >> 4)); }
__device__ __forceinline__ unsigned rtr16(unsigned lane, unsigned c, unsigned ks, unsigned t) { const unsigned g = lane >> 4, q = (lane & 15) >> 2, p = lane & 3; return off_b(32 * ks + 8 * g + 4 * t + q, 2 * c + (p >> 1)) + 8 * (p & 1); }
__device__ __forceinline__ s16x4 vtr(LAS unsigned char* p) { return __builtin_bit_cast(s16x4, __builtin_amdgcn_ds_read_tr16_b64_v4i16((LAS v4i16_t*)p)); }
__device__ __forceinline__ bf16x8 trfrag(LAS unsigned char* img, unsigned lane, unsigned c, unsigned ks) {
    const s16x4 a = vtr(img + rtr16(lane, c, ks, 0)), b = vtr(img + rtr16(lane, c, ks, 1));
    return (bf16x8){a[0], a[1], a[2], a[3], b[0], b[1], b[2], b[3]};
}
__device__ __forceinline__ bf16x8 rowfrag(LAS unsigned char* img, unsigned lane, unsigned rb, unsigned s) { return *(const LAS bf16x8*)(img + rrow16(lane, rb, s)); }
constexpr int RL_Q = 0, RL_K = 16384, RL_KD = 32768, RL_V = 49152, RL_ST = 65536, RL_P = 98304, RL_STAT = 98304 + 9216;
constexpr int PS_STRIDE = 144;

struct RetCtx { const bf16* Q; const bf16* K; const bf16* V; const bf16* Gt; const float* COS; const float* SIN; const float* gnw; float* KVS; bf16* YRET; };

template <bool WITH_Q>
__device__ __forceinline__ void ret_stage(Frame& F, const RetCtx& R, int tok0, int h, float l2g, float wexp0) {
    const int tid = F.tid, row = tid >> 3, ch = tid & 7; const size_t tok = (size_t)tok0 + row;
    const f32x4 c0 = *(const f32x4*)(R.COS + tok * 64 + ch * 8), c1 = *(const f32x4*)(R.COS + tok * 64 + ch * 8 + 4);
    const f32x4 s0 = *(const f32x4*)(R.SIN + tok * 64 + ch * 8), s1 = *(const f32x4*)(R.SIN + tok * 64 + ch * 8 + 4);
    const size_t gofs = tok * RW + h * DH + ch * 8;
    const v4u k1w = *(const v4u*)(R.K + gofs), k2w = *(const v4u*)(R.K + gofs + 64);
    const v4u v1w = *(const v4u*)(R.V + gofs), v2w = *(const v4u*)(R.V + gofs + 64);
    f32x4 a0, a1, b0, b1;
    if (WITH_Q) { const v4u q1w = *(const v4u*)(R.Q + gofs), q2w = *(const v4u*)(R.Q + gofs + 64);
        unpack8(q1w, a0, a1); unpack8(q2w, b0, b1);
        *(LAS v4u*)(F.lds + RL_Q + off_b(row, ch)) = pack8(a0 * c0 - b0 * s0, a1 * c1 - b1 * s1);
        *(LAS v4u*)(F.lds + RL_Q + off_b(row, ch + 8)) = pack8(a0 * s0 + b0 * c0, a1 * s1 + b1 * c1); }
    unpack8(k1w, a0, a1); unpack8(k2w, b0, b1);
    const float sc = 0.08838834764831845f;
    f32x4 o0 = (a0 * c0 - b0 * s0) * sc, o1 = (a1 * c1 - b1 * s1) * sc, p0 = (a0 * s0 + b0 * c0) * sc, p1 = (a1 * s1 + b1 * c1) * sc;
    if (WITH_Q) { *(LAS v4u*)(F.lds + RL_K + off_b(row, ch)) = pack8(o0, o1); *(LAS v4u*)(F.lds + RL_K + off_b(row, ch + 8)) = pack8(p0, p1); }
    const float kw = __builtin_amdgcn_exp2f(l2g * (wexp0 - (float)row));
    *(LAS v4u*)(F.lds + RL_KD + off_b(row, ch)) = pack8(o0 * kw, o1 * kw); *(LAS v4u*)(F.lds + RL_KD + off_b(row, ch + 8)) = pack8(p0 * kw, p1 * kw);
    *(LAS v4u*)(F.lds + RL_V + off_b(row, ch)) = v1w; *(LAS v4u*)(F.lds + RL_V + off_b(row, ch + 8)) = v2w;
}
__device__ __forceinline__ void ret_kv_update(Frame& F, f32x4 (&st)[8]) {
    const unsigned lane = F.lane, w = F.wave;
#pragma unroll
    for (int ks = 0; ks < 2; ++ks) { const bf16x8 a = trfrag(F.lds + RL_KD, lane, w, ks);
#pragma unroll
        for (int et = 0; et < 8; ++et) { const bf16x8 b = trfrag(F.lds + RL_V, lane, et, ks); st[et] = __builtin_amdgcn_mfma_f32_16x16x32_bf16(a, b, st[et], 0, 0, 0); } }
}
__device__ __forceinline__ void ret_pass_a(Frame& F, const RetCtx& R, int job) {
    const int s = job >> 3, h = job & 7; const float l2g = log2f(1.f - exp2f(-5.f - (float)h));
    f32x4 st[8];
#pragma unroll
    for (int et = 0; et < 8; ++et) st[et] = (f32x4){0.f, 0.f, 0.f, 0.f};
    for (int c = 0; c < RCH; ++c) {
        __syncthreads();
        ret_stage<false>(F, R, (s * RCH + c) * 64, h, l2g, (float)(511 - 64 * c));
        __syncthreads();
        ret_kv_update(F, st);
    }
    const int fr = F.lane & 15, g = F.lane >> 4; float* o = R.KVS + ((size_t)(s * NH + h) * DH) * DH;
#pragma unroll
    for (int et = 0; et < 8; ++et)
#pragma unroll
        for (int r = 0; r < 4; ++r) o[(size_t)(16 * F.wave + 4 * g + r) * DH + 16 * et + fr] = st[et][r];
}
__device__ __forceinline__ void ret_pass_c(Frame& F, const RetCtx& R, int job) {
    const int s = job >> 3, h = job & 7; const float gam = 1.f - exp2f(-5.f - (float)h), l2g = log2f(gam), cd = __builtin_amdgcn_exp2f(l2g * 64.f);
    const unsigned lane = F.lane, w = F.wave; const int fr = lane & 15, g = lane >> 4;
    f32x4 st[8];
    { const float* o = R.KVS + ((size_t)(s * NH + h) * DH) * DH;
#pragma unroll
      for (int et = 0; et < 8; ++et)
#pragma unroll
          for (int r = 0; r < 4; ++r) st[et][r] = o[(size_t)(16 * w + 4 * g + r) * DH + 16 * et + fr]; }
    const int qt = w >> 1, eh = w & 1;
    const int kt = w >> 1, qt2 = 2 * (w & 1);
    for (int c = 0; c < RCH; ++c) {
        const int tok0 = (s * RCH + c) * 64;
        __syncthreads();
#pragma unroll
        for (int et = 0; et < 8; ++et) { v2u pk; pk.x = cvt_pk_bf16(st[et][0], st[et][1]); pk.y = cvt_pk_bf16(st[et][2], st[et][3]);
            *(LAS v2u*)(F.lds + RL_ST + off_b(16 * et + fr, 2 * w + (g >> 1)) + 8 * (g & 1)) = pk; }
        ret_stage<true>(F, R, tok0, h, l2g, 63.f);
        __syncthreads();
#pragma unroll
        for (int j = 0; j < 2; ++j) { f32x4 sc = (f32x4){0.f, 0.f, 0.f, 0.f};
#pragma unroll
            for (int ks = 0; ks < 4; ++ks) sc = __builtin_amdgcn_mfma_f32_16x16x32_bf16(rowfrag(F.lds + RL_K, lane, kt, ks), rowfrag(F.lds + RL_Q, lane, qt2 + j, ks), sc, 0, 0, 0);
            const int q = 16 * (qt2 + j) + fr;
#pragma unroll
            for (int r = 0; r < 4; ++r) { const int key = 16 * kt + 4 * g + r; sc[r] *= __builtin_amdgcn_exp2f(l2g * fabsf((float)(q - key))); }
            v2u pk; pk.x = cvt_pk_bf16(sc[0], sc[1]); pk.y = cvt_pk_bf16(sc[2], sc[3]);
            *(LAS v2u*)(F.lds + RL_P + q * PS_STRIDE + (16 * kt + 4 * g) * 2) = pk; }
        f32x4 y[4];
#pragma unroll
        for (int j = 0; j < 4; ++j) y[j] = (f32x4){0.f, 0.f, 0.f, 0.f};
#pragma unroll
        for (int ks = 0; ks < 4; ++ks) { const bf16x8 a = rowfrag(F.lds + RL_Q, lane, qt, ks);
#pragma unroll
            for (int j = 0; j < 4; ++j) y[j] = __builtin_amdgcn_mfma_f32_16x16x32_bf16(a, rowfrag(F.lds + RL_ST, lane, 4 * eh + j, ks), y[j], 0, 0, 0); }
#pragma unroll
        for (int r = 0; r < 4; ++r) { const float qd = __builtin_amdgcn_exp2f(l2g * (float)(16 * qt + 4 * g + r + 1));
#pragma unroll
            for (int j = 0; j < 4; ++j) y[j][r] *= qd; }
        __syncthreads();
#pragma unroll
        for (int ks = 0; ks < 2; ++ks) { const bf16x8 a = *(const LAS bf16x8*)(F.lds + RL_P + (16 * qt + fr) * PS_STRIDE + (32 * ks + 8 * g) * 2);
#pragma unroll
            for (int j = 0; j < 4; ++j) y[j] = __builtin_amdgcn_mfma_f32_16x16x32_bf16(a, trfrag(F.lds + RL_V, lane, 4 * eh + j, ks), y[j], 0, 0, 0); }
        LAS float* STAT = (LAS float*)(F.lds + RL_STAT);
#pragma unroll
        for (int r = 0; r < 4; ++r) { float s1 = 0.f, s2 = 0.f;
#pragma unroll
            for (int j = 0; j < 4; ++j) { s1 += y[j][r]; s2 += y[j][r] * y[j][r]; }
#pragma unroll
            for (int o = 1; o < 16; o <<= 1) { s1 += __shfl_xor(s1, o); s2 += __shfl_xor(s2, o); }
            if (fr == 0) { STAT[((16 * qt + 4 * g + r) * 2 + eh) * 2] = s1; STAT[((16 * qt + 4 * g + r) * 2 + eh) * 2 + 1] = s2; } }
#pragma unroll
        for (int et = 0; et < 8; ++et) st[et] *= cd;
        ret_kv_update(F, st);
        __syncthreads();
#pragma unroll
        for (int r = 0; r < 4; ++r) { const int q = 16 * qt + 4 * g + r; const float s1 = STAT[(q * 2) * 2] + STAT[(q * 2 + 1) * 2], s2 = STAT[(q * 2) * 2 + 1] + STAT[(q * 2 + 1) * 2 + 1];
            const float mu = s1 * (1.f / 128.f), var = s2 * (1.f / 128.f) - mu * mu, rs = rsqrtf(var + EPS); const size_t tok = (size_t)tok0 + q;
#pragma unroll
            for (int j = 0; j < 4; ++j) { const int e = h * DH + 16 * (4 * eh + j) + fr; const float gv = __uint_as_float((unsigned)R.Gt[tok * RW + e] << 16);
                const float o = (y[j][r] - mu) * rs * R.gnw[e] * gv * fsigm(gv);
                R.YRET[tok * RW + e] = (bf16)(cvt_pk_bf16(o, o) & 0xffffu); } }
    }
}

constexpr size_t WS_WR = WS_LAM + 64 * 1024;
constexpr size_t WS_WGU = 164 * MiB, WS_WDN = 292 * MiB, WS_ACT = 356 * MiB, WS_MOE = 396 * MiB, WS_PP = 524 * MiB;
constexpr size_t WS_END2 = 588 * MiB;
constexpr int CW_Q1 = 8320, CW_SS = 131072;
constexpr int MOE_TAB_OFF = LDSCTL_OFF + 1024;

__device__ __forceinline__ void router_weights_item(Frame& F, int item, const float* nf, const float* wrg, const float* wre, bf16* WRH, bf16* WRL) {
    const int j = item * 2 + (F.tid >> 8), k0 = (F.tid & 255) * 8; float v[8];
#pragma unroll
    for (int i = 0; i < 8; ++i) { const int k = k0 + i; float w = 0.f; if (j < 4) w = wrg[k * 4 + j]; else if (j < 36) w = wre[k * NE + (j - 4)]; v[i] = w * nf[k]; }
    unsigned hi[4], lo[4];
#pragma unroll
    for (int i = 0; i < 4; ++i) { hi[i] = cvt_pk_bf16(v[2 * i], v[2 * i + 1]); lo[i] = cvt_pk_bf16(v[2 * i] - bf_lo(hi[i]), v[2 * i + 1] - bf_hi(hi[i])); }
    *(v4u*)(WRH + (size_t)j * D + k0) = (v4u){hi[0], hi[1], hi[2], hi[3]}; *(v4u*)(WRL + (size_t)j * D + k0) = (v4u){lo[0], lo[1], lo[2], lo[3]};
}
__device__ __forceinline__ void router_job(Frame& F, int job, const float* X1, const float* nf, const bf16* WRH, const bf16* WRL, const float* brg, const float* bre,
                                           bf16* HX, float* RINV, unsigned* cnt, int* list, float* wgt) {
    const int lane = F.lane, fr = lane & 15, g = lane >> 4, tok0 = job * 16;
    const float* xp = X1 + (size_t)(tok0 + fr) * D + 8 * g; bf16* hp = HX + (size_t)(tok0 + fr) * D + 8 * g;
    f32x4 acc[3];
#pragma unroll
    for (int nt = 0; nt < 3; ++nt) acc[nt] = (f32x4){0.f, 0.f, 0.f, 0.f};
    float ss = 0.f;
#pragma unroll 2
    for (int ks = 0; ks < D / 32; ++ks) {
        const f32x4 x0 = *(const f32x4*)(xp + 32 * ks), x1 = *(const f32x4*)(xp + 32 * ks + 4);
        const f32x4 n0 = *(const f32x4*)(nf + 32 * ks + 8 * g), n1 = *(const f32x4*)(nf + 32 * ks + 8 * g + 4);
        ss += (x0[0] * x0[0] + x0[1] * x0[1]) + (x0[2] * x0[2] + x0[3] * x0[3]) + (x1[0] * x1[0] + x1[1] * x1[1]) + (x1[2] * x1[2] + x1[3] * x1[3]);
        *(v4u*)(hp + 32 * ks) = pack8(x0 * n0, x1 * n1);
        const unsigned h0 = cvt_pk_bf16(x0[0], x0[1]), h1 = cvt_pk_bf16(x0[2], x0[3]), h2 = cvt_pk_bf16(x1[0], x1[1]), h3 = cvt_pk_bf16(x1[2], x1[3]);
        const unsigned l0 = cvt_pk_bf16(x0[0] - bf_lo(h0), x0[1] - bf_hi(h0)), l1 = cvt_pk_bf16(x0[2] - bf_lo(h1), x0[3] - bf_hi(h1)), l2 = cvt_pk_bf16(x1[0] - bf_lo(h2), x1[1] - bf_hi(h2)), l3 = cvt_pk_bf16(x1[2] - bf_lo(h3), x1[3] - bf_hi(h3));
        const bf16x8 ah = __builtin_bit_cast(bf16x8, (v4u){h0, h1, h2, h3}), al = __builtin_bit_cast(bf16x8, (v4u){l0, l1, l2, l3});
#pragma unroll
        for (int nt = 0; nt < 3; ++nt) { const size_t bo = (size_t)(16 * nt + fr) * D + 32 * ks + 8 * g;
            const bf16x8 bh = *(const bf16x8*)(WRH + bo), bl = *(const bf16x8*)(WRL + bo);
            acc[nt] = __builtin_amdgcn_mfma_f32_16x16x32_bf16(ah, bh, acc[nt], 0, 0, 0);
            acc[nt] = __builtin_amdgcn_mfma_f32_16x16x32_bf16(al, bh, acc[nt], 0, 0, 0);
            acc[nt] = __builtin_amdgcn_mfma_f32_16x16x32_bf16(ah, bl, acc[nt], 0, 0, 0); }
    }
    ss += __shfl_xor(ss, 16); ss += __shfl_xor(ss, 32);
    const float rinv = rsqrtf(ss * (1.f / D) + EPS);
    LAS float* LG = (LAS float*)(F.lds + F.wave * 4096);
#pragma unroll
    for (int r = 0; r < 4; ++r) { const float rv = __shfl(rinv, 4 * g + r);
#pragma unroll
        for (int nt = 0; nt < 3; ++nt) LG[(4 * g + r) * 49 + 16 * nt + fr] = acc[nt][r] * rv; }
    LDS_WAIT(); asm volatile("" ::: "memory");
    if (lane < 16) {
        const int t = tok0 + lane; const LAS float* lg = LG + lane * 49;
        float mx = -1e30f; int gi = 0; float gl[4];
#pragma unroll
        for (int j = 0; j < 4; ++j) { gl[j] = lg[j] + brg[j]; if (gl[j] > mx) { mx = gl[j]; gi = j; } }
        float se = 0.f;
#pragma unroll
        for (int j = 0; j < 4; ++j) se += __expf(gl[j] - mx);
        const float gw = 1.f / se;
        float b1 = -1e30f, b2 = -1e30f; int j1 = 0, j2 = 0;
        for (int j = 0; j < 8; ++j) { const float v = lg[4 + gi * 8 + j] + bre[gi * 8 + j]; if (v > b1) { b2 = b1; j2 = j1; b1 = v; j1 = j; } else if (v > b2) { b2 = v; j2 = j; } }
        const float e2 = __expf(b2 - b1); const float w1 = gw / (1.f + e2), w2 = gw * e2 / (1.f + e2);
        const int ea = gi * 8 + j1, eb = gi * 8 + j2;
        const int pa = (int)__hip_atomic_fetch_add(cnt + ea, 1u, RLX_AGENT); list[(size_t)ea * T + pa] = t * 2; wgt[t * 2] = w1;
        const int pb = (int)__hip_atomic_fetch_add(cnt + eb, 1u, RLX_AGENT); list[(size_t)eb * T + pb] = t * 2 + 1; wgt[t * 2 + 1] = w2;
        RINV[t] = rinv;
    }
    LDS_WAIT(); asm volatile("" ::: "memory");
}

template <int NT> __device__ __forceinline__ void moe_tables(Frame& F, const unsigned* cnt) {
    LAS int* tab = (LAS int*)(F.lds + MOE_TAB_OFF);
    __syncthreads();
    if (F.tid == 0) { int cu = 0, ps = 0; for (int e = 0; e < NE; ++e) { const int c = (int)__hip_atomic_load(cnt + e, RLX_AGENT), nrb = (c + 255) >> 8; tab[e] = cu; tab[33 + e] = ps; tab[66 + e] = c; cu += nrb * NT; ps += nrb * 256; } tab[32] = cu; tab[65] = ps; }
    __syncthreads();
}
template <int NT, int NTSH> struct SchedMoe {
    LAS int* tab; int G, c;
    __device__ __forceinline__ bool next(int i, pg8::Unit& u) const { const int L = i * G + c; if (L >= tab[32]) return false; int e = 0;
#pragma unroll 1
        for (int k = 16; k >= 1; k >>= 1) if (tab[e + k] <= L) e += k;
        while (e < NE - 1 && tab[e + 1] <= L) ++e;
        const int local = L - tab[e]; u.z = e; u.pm = local >> NTSH; u.pn = local & (NT - 1); return true; }
};
struct SchedGU : SchedMoe<4, 2> {
    static constexpr bool GATHER = true;
    const char* A; const char* B; const int* list; unsigned lda2, ldb2;
    __device__ __forceinline__ const char* a_ptr(const pg8::Unit&) const { return A; }
    __device__ __forceinline__ const char* b_ptr(const pg8::Unit& u) const { return B + ((size_t)u.z * 1024 + (size_t)u.pn * 256) * ldb2; }
    __device__ __forceinline__ void a_off(const pg8::Unit& u, const int (&R)[2], const int (&C)[2], unsigned (&v)[2][2]) const { const int ce = tab[66 + u.z];
#pragma unroll
        for (int h = 0; h < 2; ++h)
#pragma unroll
            for (int i = 0; i < 2; ++i) { const int r = u.pm * 256 + h * 128 + R[i]; const int tok = r < ce ? (list[(size_t)u.z * T + r] >> 1) : 0; v[h][i] = (unsigned)tok * lda2 + (unsigned)C[i] * 2u; } }
};
struct SchedDN : SchedMoe<8, 3> {
    static constexpr bool GATHER = false;
    const char* A; const char* B; unsigned lda2, ldb2;
    __device__ __forceinline__ const char* a_ptr(const pg8::Unit& u) const { return A + (size_t)(tab[33 + u.z] + u.pm * 256) * lda2; }
    __device__ __forceinline__ const char* b_ptr(const pg8::Unit& u) const { return B + ((size_t)u.z * 2048 + (size_t)u.pn * 256) * ldb2; }
    __device__ __forceinline__ void a_off(const pg8::Unit&, const int (&)[2], const int (&)[2], unsigned (&)[2][2]) const {}
};
struct EpiGU {
    static constexpr bool PERM = true;
    bf16* ACT; const int* list; const float* RINV; LAS int* tab;
    __device__ __forceinline__ void operator()(const f32x4 (&acc)[2][2][4][2], const Unit& u, int wr, int wc, int fr, int fq) const {
        const int ce = tab[66 + u.z], ps = tab[33 + u.z], r0 = u.pm * 256 + wr * 64 + fr, c0 = u.pn * 128 + wc * 16 + 4 * fq;
#pragma unroll
        for (int ai = 0; ai < 2; ++ai)
#pragma unroll
            for (int m = 0; m < 4; ++m) { const int r = r0 + ai * 128 + m * 16;
                if (r < ce) { const float rv = RINV[list[(size_t)u.z * T + r] >> 1];
#pragma unroll
                    for (int bj = 0; bj < 2; ++bj) { f32x4 gt = acc[ai][bj][m][0] * rv, up = acc[ai][bj][m][1] * rv;
#pragma unroll
                        for (int j = 0; j < 4; ++j) gt[j] = gt[j] * fsigm(gt[j]) * up[j];
                        v2u o; o.x = cvt_pk_bf16(gt[0], gt[1]); o.y = cvt_pk_bf16(gt[2], gt[3]);
                        *(v2u*)(ACT + (size_t)(ps + r) * FE + c0 + bj * 64) = o; } } }
    }
};
struct EpiDN {
    static constexpr bool PERM = true;
    bf16* MOE; const int* list; const float* wgt; LAS int* tab;
    __device__ __forceinline__ void operator()(const f32x4 (&acc)[2][2][4][2], const Unit& u, int wr, int wc, int fr, int fq) const {
        const int ce = tab[66 + u.z], r0 = u.pm * 256 + wr * 64 + fr, c0 = u.pn * 256 + wc * 32 + 8 * fq;
#pragma unroll
        for (int ai = 0; ai < 2; ++ai)
#pragma unroll
            for (int m = 0; m < 4; ++m) { const int r = r0 + ai * 128 + m * 16;
                if (r < ce) { const int code = list[(size_t)u.z * T + r]; const float w = wgt[code]; bf16* dst = MOE + ((size_t)(code & 1) * T + (code >> 1)) * D + c0;
#pragma unroll
                    for (int bj = 0; bj < 2; ++bj) *(v4u*)(dst + bj * 128) = pack8(acc[ai][bj][m][0] * w, acc[ai][bj][m][1] * w); } }
    }
};
struct EpiPP {
    static constexpr bool PERM = false;
    bf16* PP;
    __device__ __forceinline__ void operator()(const f32x4 (&acc)[2][2][4][2], const Unit& u, int wr, int wc, int fr, int fq) const {
        const int row0 = u.pm * 256 + wr * 64 + fr, col0 = u.pn * 256 + wc * 32 + 4 * fq;
#pragma unroll
        for (int ai = 0; ai < 2; ++ai)
#pragma unroll
            for (int m = 0; m < 4; ++m) { const size_t off = (size_t)(row0 + ai * 128 + m * 16) * D + col0;
#pragma unroll
                for (int bj = 0; bj < 2; ++bj)
#pragma unroll
                    for (int n = 0; n < 2; ++n) { const f32x4 a = acc[ai][bj][m][n]; v2u o; o.x = cvt_pk_bf16(a[0], a[1]); o.y = cvt_pk_bf16(a[2], a[3]); *(v2u*)(PP + off + bj * 128 + n * 16) = o; } }
    }
};
struct EpiPle {
    static constexpr bool PERM = false;
    const bf16* PP; const float* RINV; float* O; float* SS;
    __device__ __forceinline__ void operator()(const f32x4 (&acc)[2][2][4][2], const Unit& u, int wr, int wc, int fr, int fq) const {
        const int row0 = u.pm * 256 + wr * 64 + fr, col0 = u.pn * 256 + wc * 32 + 4 * fq;
#pragma unroll
        for (int ai = 0; ai < 2; ++ai)
#pragma unroll
            for (int m = 0; m < 4; ++m) { const int row = row0 + ai * 128 + m * 16; const size_t off = (size_t)row * D + col0; const float rv = RINV[row]; float s = 0.f;
#pragma unroll
                for (int bj = 0; bj < 2; ++bj)
#pragma unroll
                    for (int n = 0; n < 2; ++n) { const v2u pw = *(const v2u*)(PP + off + bj * 128 + n * 16); const f32x4 pp = (f32x4){bf_lo(pw.x), bf_hi(pw.x), bf_lo(pw.y), bf_hi(pw.y)};
                        f32x4 x = *(const f32x4*)(O + off + bj * 128 + n * 16); const f32x4 a = acc[ai][bj][m][n] * rv;
#pragma unroll
                        for (int j = 0; j < 4; ++j) { x[j] += fsigm(a[j]) * pp[j]; s += x[j] * x[j]; }
                        *(f32x4*)(O + off + bj * 128 + n * 16) = x; asm volatile("" ::: "memory"); }
                s += __shfl_xor(s, 16); s += __shfl_xor(s, 32);
                if (fq == 0) atomicAdd(SS + row, s);
                asm volatile("" ::: "memory"); }
    }
};
__device__ __forceinline__ void combine_row(int lane, float* xrow, const bf16* m0, const bf16* m1, const float* w, bf16* hrow, float* rinv) {
    float s = 0.f;
#pragma unroll
    for (int j = 0; j < 4; ++j) { const int c = (lane + 64 * j) * 8;
        f32x4 a = *(const f32x4*)(xrow + c), b = *(const f32x4*)(xrow + c + 4); f32x4 p0, p1, q0, q1; unpack8(*(const v4u*)(m0 + c), p0, p1); unpack8(*(const v4u*)(m1 + c), q0, q1);
        a += p0 + q0; b += p1 + q1; *(f32x4*)(xrow + c) = a; *(f32x4*)(xrow + c + 4) = b;
        s += (a[0] * a[0] + a[1] * a[1]) + (a[2] * a[2] + a[3] * a[3]) + (b[0] * b[0] + b[1] * b[1]) + (b[2] * b[2] + b[3] * b[3]);
        const f32x4 w0 = *(const f32x4*)(w + c), w1 = *(const f32x4*)(w + c + 4); *(v4u*)(hrow + c) = pack8(a * w0, b * w1); }
    s = wave_sum(s); if (lane == 0) *rinv = rsqrtf(s * (1.f / D) + EPS);
}
__device__ __forceinline__ void final_row(int lane, float* xrow, float ss, const float* w) {
    const float r = rsqrtf(ss * (1.f / D) + EPS);
#pragma unroll
    for (int j = 0; j < 8; ++j) { const int c = (lane + 64 * j) * 4; const f32x4 a = *(const f32x4*)(xrow + c), ww = *(const f32x4*)(w + c); *(f32x4*)(xrow + c) = a * r * ww; }
}

__device__ __forceinline__ void s5_scan(Frame& F, int job, const float* EST, const float* LAMT, bf16* UA) {
    const int g = job >> 2, pq = job & 3, pl = F.tid & 15, seg = F.tid >> 4, p = pq * 16 + pl;
    const float l16r = LAMT[(g * 64 + p) * 4 + 0], l16i = LAMT[(g * 64 + p) * 4 + 1], lsr = LAMT[(g * 64 + p) * 4 + 2], lsi = LAMT[(g * 64 + p) * 4 + 3];
    float er[32], ei[32];
    const float* e0 = EST + ((size_t)g * S5NC + seg * 32) * 128 + p;
#pragma unroll
    for (int i = 0; i < 32; ++i) { er[i] = e0[(size_t)i * 128]; ei[i] = e0[(size_t)i * 128 + 64]; }
    float sr = 0.f, si = 0.f;
#pragma unroll
    for (int i = 0; i < 32; ++i) { const float nr = l16r * sr - l16i * si + er[i], ni = l16r * si + l16i * sr + ei[i]; sr = nr; si = ni; }
    LAS float* SE = (LAS float*)F.lds;
    __syncthreads();
    SE[(seg * 16 + pl) * 2] = sr; SE[(seg * 16 + pl) * 2 + 1] = si;
    __syncthreads();
    sr = 0.f; si = 0.f;
    for (int s2 = 0; s2 < seg; ++s2) { const float ar = SE[(s2 * 16 + pl) * 2], ai = SE[(s2 * 16 + pl) * 2 + 1]; const float nr = lsr * sr - lsi * si + ar, ni = lsr * si + lsi * sr + ai; sr = nr; si = ni; }
    bf16* o = UA + ((size_t)g * S5NC + seg * 32) * S5K + 256 + p;
#pragma unroll
    for (int i = 0; i < 32; ++i) { o[(size_t)i * S5K] = (bf16)(cvt_pk_bf16(sr, sr) & 0xffffu); o[(size_t)i * S5K + 64] = (bf16)(cvt_pk_bf16(si, si) & 0xffffu);
        const float nr = l16r * sr - l16i * si + er[i], ni = l16r * si + l16i * sr + ei[i]; sr = nr; si = ni; }
    __syncthreads();
}
__device__ __forceinline__ void ret_scan(Frame& F, int job, float* KVS) {
    const int idx = job * 512 + F.tid;
    const int h = idx >> 14; const float cd8 = __builtin_amdgcn_exp2f(log2f(1.f - exp2f(-5.f - (float)h)) * 512.f);
    float v[RSC];
#pragma unroll
    for (int s = 0; s < RSC; ++s) v[s] = KVS[(size_t)s * NH * DH * DH + idx];
    float st = 0.f;
#pragma unroll
    for (int s = 0; s < RSC; ++s) { const float t = v[s]; KVS[(size_t)s * NH * DH * DH + idx] = st; st = st * cd8 + t; }
}

struct Args { const float* in[30]; float* out; unsigned char* ws; int ph_lo, ph_hi; };
enum { I_X = 0, I_P, I_NMIX, I_WIN, I_GNW, I_LRE, I_LIM, I_LDT, I_BRE, I_BIM, I_CRE, I_CIM, I_SD, I_WGLU, I_WA, I_WB, I_WMERGE, I_WOUT, I_NFFN, I_WRG, I_BRG, I_WRE, I_BRE2, I_WEG, I_WEU, I_WED, I_NPLE, I_WPG, I_WPLE, I_NF };

__global__ void __launch_bounds__(NWAVES * 64, 2) mk_fwd(Args args) {
    extern __shared__ __attribute__((aligned(16))) unsigned char lds_raw[];
    Frame F;
    F.lds = (LAS unsigned char*)lds_raw;
    F.MISC = (volatile LAS unsigned*)(F.lds + MISC_OFF);
    F.tid = threadIdx.x; F.lane = F.tid & 63; F.wave = __builtin_amdgcn_readfirstlane(F.tid >> 6); F.G = gridDim.x;
    unsigned char* ws = args.ws;
    F.ctl = (unsigned*)(ws + WS_CTL);
    for (int u = F.tid; u < (LDS_BYTES - LDSCTL_OFF) / 4; u += NWAVES * 64) ((LAS unsigned*)(F.lds + LDSCTL_OFF))[u] = 0u;
    __syncthreads();
    const int lo = args.ph_lo, hi = args.ph_hi;
    const bool fused = (hi - lo) > 1;
    XcdBarrier bar; bar.bar = F.ctl + CW_BAR; bar.x = 0; bar.st = nullptr;
    if (fused) bar = xcd_barrier_post(F.ctl + CW_BAR, F.MISC + 8);
#ifndef PH_MASK
#define PH_MASK 0xffffffffu
#endif
#define IN(k) (((PH_MASK >> (k)) & 1u) && lo <= (k) && (k) < hi)
#define SEAM(k) do { if (IN(k) && IN((k) + 1)) xcd_barrier(bar); } while (0)
    bf16* WT1 = (bf16*)(ws + WS_WT1); bf16* WGLU = (bf16*)(ws + WS_WGLU); bf16* WA = (bf16*)(ws + WS_WA); bf16* WB = (bf16*)(ws + WS_WB); bf16* WOUT = (bf16*)(ws + WS_WOUT);
    bf16* WPG = (bf16*)(ws + WS_WPG); bf16* WP = (bf16*)(ws + WS_WP); bf16* BTC = (bf16*)(ws + WS_BTC); bf16* BLT = (bf16*)(ws + WS_BLT);
    bf16* HB = (bf16*)(ws + WS_HB); bf16* YRET = (bf16*)(ws + WS_YRET); bf16* YPRE = (bf16*)(ws + WS_YPRE); bf16* QKVG = (bf16*)(ws + WS_Q); bf16* UA = (bf16*)(ws + WS_UA);
    float* EST = (float*)(ws + WS_EST); float* KVS = (float*)(ws + WS_KVS); bf16* MERGED = (bf16*)(ws + WS_MERGED); bf16* YSSM = (bf16*)(ws + WS_YSSM); bf16* PB = (bf16*)(ws + WS_PB);
    float* COS = (float*)(ws + WS_COS); float* SIN = (float*)(ws + WS_SIN); float* LAMT = (float*)(ws + WS_LAM);
    bf16* GATES = (bf16*)args.out;

    if (IN(0)) {
        constexpr int I_S5 = 64;
        constexpr int I_WIN8 = (D / 64) * (INC / 32) / 8, I_WMG8 = (D / 64) * (4096 / 32) / 8, I_GLU8 = (RW / 64) * (RW / 32) / 8, I_WA8 = (RW / 64) * (D / 32) / 8, I_WO8 = (D / 64) * (D / 32) / 8, I_WPL8 = (PLE / 64) * (D / 32) / 8;
        constexpr int I_H = T / 64, I_PB = 256, I_ROPE = 256;
        constexpr int B0 = 0, B1 = B0 + I_S5, B2 = B1 + I_WIN8, B3 = B2 + I_WMG8, B4 = B3 + I_GLU8, B5 = B4 + I_WA8, B6 = B5 + I_WA8, B7 = B6 + I_WO8, B8 = B7 + I_WO8, B9 = B8 + I_WPL8, B10 = B9 + I_H, B11 = B10 + I_PB, B12 = B11 + I_ROPE, B13 = B12 + 1, B14 = B13 + 24;
        LAS float* scr = (LAS float*)(F.lds + RING_OFF + F.wave * 8704);
        for (;;) {
            const int it = wg_next_item(F, F.ctl + CW_Q0);
            if (it >= B14) break;
            if (it < B1) { s5_tables(F, it, args.in[I_LRE], args.in[I_LIM], args.in[I_LDT], args.in[I_BRE], args.in[I_BIM], args.in[I_CRE], args.in[I_CIM], args.in[I_SD], BTC, BLT, LAMT); }
            else if (it < B2) transpose_item<0>(args.in[I_WIN], D, INC, WT1, D, 0, scr, (it - B1) * 8 + F.wave, F.lane);
            else if (it < B3) transpose_item<0>(args.in[I_WMERGE], D, 4096, WT1, D, INC, scr, (it - B2) * 8 + F.wave, F.lane);
            else if (it < B4) transpose_item<0>(args.in[I_WGLU], RW, RW, WGLU, RW, 0, scr, (it - B3) * 8 + F.wave, F.lane);
            else if (it < B5) transpose_item<0>(args.in[I_WA], RW, D, WA, RW, 0, scr, (it - B4) * 8 + F.wave, F.lane);
            else if (it < B6) transpose_item<0>(args.in[I_WB], RW, D, WB, RW, 0, scr, (it - B5) * 8 + F.wave, F.lane);
            else if (it < B7) transpose_item<0>(args.in[I_WOUT], D, D, WOUT, D, 0, scr, (it - B6) * 8 + F.wave, F.lane);
            else if (it < B8) transpose_item<0>(args.in[I_WPG], D, D, WPG, D, 0, scr, (it - B7) * 8 + F.wave, F.lane);
            else if (it < B9) transpose_item<0>(args.in[I_WPLE], PLE, D, WP, PLE, 0, scr, (it - B8) * 8 + F.wave, F.lane);
            else if (it < B10) { const int r0 = (it - B9) * 64 + F.wave * 8;
                for (int r = 0; r < 8; ++r) rms_row_to_bf16(F.lane, args.in[I_X] + (size_t)(r0 + r) * D, args.in[I_NMIX], HB + (size_t)(r0 + r) * D); }
            else if (it < B11) { const size_t e0 = (size_t)(it - B10) * 16384 + F.tid * 8;
#pragma unroll
                for (int k = 0; k < 4; ++k) { const size_t e = e0 + (size_t)k * 4096; const f32x4 a = *(const f32x4*)(args.in[I_P] + e), b = *(const f32x4*)(args.in[I_P] + e + 4); *(v4u*)(PB + e) = pack8(a, b); } }
            else if (it < B12) { const int t0 = (it - B11) * 64;
#pragma unroll
                for (int k = 0; k < 8; ++k) { const int idx = k * 512 + F.tid, t = t0 + (idx >> 6), j = idx & 63; const double inv = exp2(-(double)j * (13.287712379549449 / 64.0));
                    double sn, cs; sincos((double)t * inv, &sn, &cs); COS[(size_t)t * 64 + j] = (float)cs; SIN[(size_t)t * 64 + j] = (float)sn; } }
            else if (it >= B13) router_weights_item(F, it - B13, args.in[I_NFFN], args.in[I_WRG], args.in[I_WRE], (bf16*)(ws + WS_WR), (bf16*)(ws + WS_WR) + 48 * D);
            else { for (int i = F.tid; i < 128 * 256 / 8; i += 512) *(v4u*)(BLT + (size_t)SG * 128 * 256 + (size_t)i * 8) = (v4u){0u, 0u, 0u, 0u}; }
        }
    }
    SEAM(0);
    if (IN(1)) {
        pg8::SchedPlain S; S.init(HB, D, WT1, D, T, N1, F.G, (int)blockIdx.x);
        EpiProj E{QKVG, UA, GATES};
        pg8::gemm_phase<EpiProj, pg8::SchedPlain>(F.lds + RING_OFF, D, S, E);
    }
    SEAM(1);
    RetCtx RC{QKVG, QKVG + (size_t)T * RW, QKVG + (size_t)2 * T * RW, QKVG + (size_t)3 * T * RW, COS, SIN, args.in[I_GNW], KVS, YRET};
    if (IN(2)) {
        pg8::SchedBatch S; S.A = (const char*)UA; S.B = (const char*)BLT; S.lda2 = S5K * 2; S.ldb2 = 256 * 2; S.sA = (size_t)S5NC * S5K * 2; S.sB = (size_t)128 * 256 * 2; S.nMz = S5NC / 256; S.nz = SG; S.G = F.G; S.c = (int)blockIdx.x;
        EpiS5A E{EST};
        pg8::gemm_phase<EpiS5A, pg8::SchedBatch>(F.lds + RING_OFF, 256, S, E);
        for (int job = blockIdx.x; job < RSC * NH; job += F.G) ret_pass_a(F, RC, job);
    }
    SEAM(2);
    if (IN(3)) {
        for (int job = blockIdx.x; job < SG * 4; job += F.G) s5_scan(F, job, EST, LAMT, UA);
        for (int job = blockIdx.x; job < NH * DH * DH / 512; job += F.G) ret_scan(F, job, KVS);
    }
    SEAM(3);
    if (IN(4)) {
        pg8::SchedBatch S; S.A = (const char*)UA; S.B = (const char*)BTC; S.lda2 = S5K * 2; S.ldb2 = S5K * 2; S.sA = (size_t)S5NC * S5K * 2; S.sB = (size_t)256 * S5K * 2; S.nMz = S5NC / 256; S.nz = SG; S.G = F.G; S.c = (int)blockIdx.x;
        EpiS5C E{YPRE};
#ifndef P4_NOGEMM
        pg8::gemm_phase<EpiS5C, pg8::SchedBatch>(F.lds + RING_OFF, S5K, S, E);
#endif
#ifndef P4_NORET
        for (int job = blockIdx.x; job < RSC * NH; job += F.G) ret_pass_c(F, RC, job);
#endif
    }
    SEAM(4);
    if (IN(5)) {
        pg8::SchedPlain S; S.init(YPRE, RW, WGLU, RW, T, RW, F.G, (int)blockIdx.x);
        EpiGlu E{YPRE, YSSM};
        pg8::gemm_phase<EpiGlu, pg8::SchedPlain>(F.lds + RING_OFF, RW, S, E);
    }
    SEAM(5);
    if (IN(6)) {
        pg8::SchedTwoPass S; S.A0 = (const char*)YRET; S.A1 = (const char*)YSSM; S.B0 = (const char*)WA; S.B1 = (const char*)WB; S.lda2 = RW * 2; S.ldb2 = RW * 2; S.nM = T / 256; S.nN = D / 256; S.G = F.G; S.c = (int)blockIdx.x;
        EpiMerge E{GATES, MERGED};
        pg8::gemm_phase<EpiMerge, pg8::SchedTwoPass>(F.lds + RING_OFF, RW, S, E);
    }
    SEAM(6);
    if (IN(7)) {
        pg8::SchedPlain S; S.init(MERGED, D, WOUT, D, T, D, F.G, (int)blockIdx.x);
        EpiOut E{args.in[I_X], args.out};
        pg8::gemm_phase<EpiOut, pg8::SchedPlain>(F.lds + RING_OFF, D, S, E);
    }
    SEAM(7);
    bf16* WRH = (bf16*)(ws + WS_WR); bf16* WRL = WRH + 48 * D; bf16* WGU = (bf16*)(ws + WS_WGU); bf16* WDN = (bf16*)(ws + WS_WDN); bf16* ACT = (bf16*)(ws + WS_ACT); bf16* MOE = (bf16*)(ws + WS_MOE); bf16* PP = (bf16*)(ws + WS_PP);
    int* LIST = (int*)(ws + WS_LIST); float* WGT = (float*)(ws + WS_WGT); float* RINV = (float*)(ws + WS_RINV); float* RINV3 = RINV + T; float* SS = (float*)(F.ctl + CW_SS);
    unsigned* CNT = F.ctl + CW_CNT;
    if (IN(8)) {
        constexpr int I_RT = T / 128, I_EW = 32 * 3 * 64;
        LAS float* scr = (LAS float*)(F.lds + RING_OFF + 32768 + F.wave * 8704);
        for (;;) {
            const int it = wg_next_item(F, F.ctl + CW_Q1);
            if (it >= I_RT + I_EW) break;
            if (it < I_RT) router_job(F, it * 8 + F.wave, args.out, args.in[I_NFFN], WRH, WRL, args.in[I_BRG], args.in[I_BRE2], HB, RINV, CNT, LIST, WGT);
            else { const int q = it - I_RT, e = q / 192, r = q % 192, mtx = r / 64, sub = (r % 64) * 8 + F.wave;
                if (mtx == 0) transpose_item<1>(args.in[I_WEG] + (size_t)e * D * FE, D, FE, WGU + (size_t)e * 1024 * D, D, 0, scr, sub, F.lane);
                else if (mtx == 1) transpose_item<2>(args.in[I_WEU] + (size_t)e * D * FE, D, FE, WGU + (size_t)e * 1024 * D, D, 0, scr, sub, F.lane);
                else transpose_item<0>(args.in[I_WED] + (size_t)e * FE * D, FE, D, WDN + (size_t)e * D * FE, FE, 0, scr, sub, F.lane); }
        }
    }
    SEAM(8);
    if (IN(9)) {
        moe_tables<4>(F, CNT);
        SchedGU S; S.tab = (LAS int*)(F.lds + MOE_TAB_OFF); S.G = F.G; S.c = (int)blockIdx.x; S.A = (const char*)HB; S.B = (const char*)WGU; S.list = LIST; S.lda2 = D * 2; S.ldb2 = D * 2;
        EpiGU E{ACT, LIST, RINV, S.tab};
        pg8::gemm_phase<EpiGU, SchedGU>(F.lds + RING_OFF, D, S, E);
    }
    SEAM(9);
    if (IN(10)) {
        moe_tables<8>(F, CNT);
        SchedDN S; S.tab = (LAS int*)(F.lds + MOE_TAB_OFF); S.G = F.G; S.c = (int)blockIdx.x; S.A = (const char*)ACT; S.B = (const char*)WDN; S.lda2 = FE * 2; S.ldb2 = FE * 2;
        EpiDN E{MOE, LIST, WGT, S.tab};
        pg8::gemm_phase<EpiDN, SchedDN>(F.lds + RING_OFF, FE, S, E);
    }
    SEAM(10);
    if (IN(11)) {
        for (int row = blockIdx.x * NWAVES + F.wave; row < T; row += F.G * NWAVES)
            combine_row(F.lane, args.out + (size_t)row * D, MOE + (size_t)row * D, MOE + ((size_t)T + row) * D, args.in[I_NPLE], HB + (size_t)row * D, RINV3 + row);
    }
    SEAM(11);
    if (IN(12)) {
#ifndef P12_NOPP
        { pg8::SchedPlain S; S.init(PB, PLE, WP, PLE, T, D, F.G, (int)blockIdx.x); EpiPP E{PP}; pg8::gemm_phase<EpiPP, pg8::SchedPlain>(F.lds + RING_OFF, PLE, S, E); }
#endif
#ifndef P12_NOGATE
        { pg8::SchedPlain S; S.init(HB, D, WPG, D, T, D, F.G, (int)blockIdx.x); EpiPle E{PP, RINV3, args.out, SS}; pg8::gemm_phase<EpiPle, pg8::SchedPlain>(F.lds + RING_OFF, D, S, E); }
#endif
    }
    SEAM(12);
    if (IN(13)) {
        for (int row = blockIdx.x * NWAVES + F.wave; row < T; row += F.G * NWAVES)
            final_row(F.lane, args.out + (size_t)row * D, __hip_atomic_load(SS + row, RLX_AGENT), args.in[I_NF]);
    }
#undef IN
#undef SEAM
}

#ifndef RUN_HI
#define RUN_HI 14
#endif
extern "C" void kernel_launch(void* const* d_in, const int* in_sizes, int n_in, void* d_out, int out_size, void* d_ws, size_t ws_size, hipStream_t stream) {
    static int grid = 0;
    if (grid == 0) {
        if (n_in != 30 || ws_size < WS_END2) { fprintf(stderr, "kernel_launch: unexpected n_in %d / ws %zu\n", n_in, ws_size); grid = -1; return; }
        int dev = 0, cus = 0;
        if (hipGetDevice(&dev) != hipSuccess || hipDeviceGetAttribute(&cus, hipDeviceAttributeMultiprocessorCount, dev) != hipSuccess) { grid = -1; return; }
        if (hipFuncSetAttribute((const void*)mk_fwd, hipFuncAttributeMaxDynamicSharedMemorySize, LDS_BYTES) != hipSuccess) { fprintf(stderr, "kernel_launch: hipFuncSetAttribute failed\n"); grid = -1; return; }
        grid = cus;
    }
    if (grid < 0) return;
    (void)hipMemsetAsync((char*)d_ws + WS_CTL, 0, CTL_ZERO_BYTES, stream);
    Args a{};
    for (int i = 0; i < 30; ++i) a.in[i] = (const float*)d_in[i];
    a.out = (float*)d_out; a.ws = (unsigned char*)d_ws;
    for (int ph = 0; ph < RUN_HI; ++ph) { a.ph_lo = ph; a.ph_hi = ph + 1; hipLaunchKernelGGL(mk_fwd, dim3(grid), dim3(NWAVES * 64), LDS_BYTES, stream, a); }
}
```

```cpp
#include <hip/hip_runtime.h>
#include <math.h>
#include <stdio.h>
#include <stdint.h>
namespace pg8 {
#define PG8_LAS __attribute__((address_space(3)))
typedef unsigned short bf16_t;
typedef short bf16x8 __attribute__((ext_vector_type(8)));
typedef float f32x4 __attribute__((ext_vector_type(4)));
typedef float f32x2 __attribute__((ext_vector_type(2)));
typedef unsigned u32x4 __attribute__((ext_vector_type(4)));
typedef unsigned u32x2 __attribute__((ext_vector_type(2)));
constexpr int BM = 256, BK = 64, HALF = 128, HTB = HALF * BK * 2  , STAGE_BYTES = 8 * HTB, NXCD = 8, WGM = 8;

__host__ __device__ __forceinline__ int lds_byte(int r, int c) { const int st = (r >> 4) * 2 + (c >> 5), rr = r & 15, cc = c & 31, ob = rr * 64 + cc * 2; return st * 1024 + (ob ^ (((ob >> 9) & 1) << 5)); }
__host__ __device__ __forceinline__ void stage_rc(int b, int& R, int& C) { const int st = b / 1024, sb = b % 1024, swz = sb ^ (((sb >> 9) & 1) << 5); R = (st >> 1) * 16 + swz / 64; C = (st & 1) * 32 + (swz % 64) / 2; }
__host__ __device__ __forceinline__ int perm32(int rho) { const int n = rho >> 4, i = rho & 15; return 8 * (i >> 2) + 4 * n + (i & 3); }

struct Unit { int pm, pn, z; };
__device__ __forceinline__ const char* uptr(const char* p) {
    const unsigned long long v = (unsigned long long)p; const unsigned lo = __builtin_amdgcn_readfirstlane((unsigned)v), hi = __builtin_amdgcn_readfirstlane((unsigned)(v >> 32));
    return (const char*)(((unsigned long long)hi << 32) | lo); }

__device__ __forceinline__ void tile_of(int L, int nM, int nN, int& pm, int& pn) {
    const int nwg = nM * nN; int wgid = L; { const int q = nwg / NXCD, r = nwg % NXCD, xcd = wgid % NXCD, off = wgid / NXCD; wgid = (xcd < r ? xcd * (q + 1) : r * (q + 1) + (xcd - r) * q) + off; }
    const int nig = WGM * nN, gid = wgid / nig, fm = gid * WGM, gsz = (nM - fm) < WGM ? (nM - fm) : WGM;
    pm = fm + ((wgid % nig) % gsz); pn = (wgid % nig) / gsz;
}
struct SchedPlain {
    static constexpr bool GATHER = false;
    const char* A; const char* B; unsigned lda2, ldb2; int nM, nN, G, c;
    __device__ __forceinline__ void init(const void* A_, int lda, const void* B_, int ldb, int M, int N, int G_, int c_) { A = (const char*)A_; B = (const char*)B_; lda2 = lda * 2; ldb2 = ldb * 2; nM = M / BM; nN = N / BM; G = G_; c = c_; }
    __device__ __forceinline__ bool next(int i, Unit& u) const { const int L = i * G + c; if (L >= nM * nN) return false; tile_of(L, nM, nN, u.pm, u.pn); u.z = 0; return true; }
    __device__ __forceinline__ const char* a_ptr(const Unit& u) const { return A + (size_t)u.pm * BM * lda2; }
    __device__ __forceinline__ const char* b_ptr(const Unit& u) const { return B + (size_t)u.pn * BM * ldb2; }
    __device__ __forceinline__ void a_off(const Unit&, const int (&R)[2], const int (&C)[2], unsigned (&v)[2][2]) const {
#pragma unroll
        for (int h = 0; h < 2; ++h)
#pragma unroll
            for (int i = 0; i < 2; ++i) v[h][i] = (unsigned)(h * HALF + R[i]) * lda2 + (unsigned)C[i] * 2u; }
};
struct SchedBatch {
    static constexpr bool GATHER = false;
    const char* A; const char* B; unsigned lda2, ldb2; size_t sA, sB; int nMz, nz, G, c;
    __device__ __forceinline__ bool next(int i, Unit& u) const { const int L = i * G + c; if (L >= nMz * nz) return false; u.z = L >> 2; u.pm = L & 3; u.pn = 0; return true; }
    __device__ __forceinline__ const char* a_ptr(const Unit& u) const { return A + (size_t)u.z * sA + (size_t)u.pm * BM * lda2; }
    __device__ __forceinline__ const char* b_ptr(const Unit& u) const { return B + (size_t)u.z * sB; }
    __device__ __forceinline__ void a_off(const Unit&, const int (&R)[2], const int (&C)[2], unsigned (&v)[2][2]) const {
#pragma unroll
        for (int h = 0; h < 2; ++h)
#pragma unroll
            for (int i = 0; i < 2; ++i) v[h][i] = (unsigned)(h * HALF + R[i]) * lda2 + (unsigned)C[i] * 2u; }
};
struct SchedTwoPass {
    static constexpr bool GATHER = false;
    const char* A0; const char* A1; const char* B0; const char* B1; unsigned lda2, ldb2; int nM, nN, G, c;
    __device__ __forceinline__ bool next(int i, Unit& u) const { const int L = (i >> 1) * G + c; if (L >= nM * nN) return false; tile_of(L, nM, nN, u.pm, u.pn); u.z = i & 1; return true; }
    __device__ __forceinline__ const char* a_ptr(const Unit& u) const { return (u.z ? A1 : A0) + (size_t)u.pm * BM * lda2; }
    __device__ __forceinline__ const char* b_ptr(const Unit& u) const { return (u.z ? B1 : B0) + (size_t)u.pn * BM * ldb2; }
    __device__ __forceinline__ void a_off(const Unit&, const int (&R)[2], const int (&C)[2], unsigned (&v)[2][2]) const {
#pragma unroll
        for (int h = 0; h < 2; ++h)
#pragma unroll
            for (int i = 0; i < 2; ++i) v[h][i] = (unsigned)(h * HALF + R[i]) * lda2 + (unsigned)C[i] * 2u; }
};

typedef float f32x2_t __attribute__((ext_vector_type(2))); typedef __bf16 bf16x2_t __attribute__((ext_vector_type(2)));
__device__ __forceinline__ unsigned cvt_pk_bf16(float lo, float hi) { f32x2_t v = {lo, hi}; bf16x2_t b = __builtin_convertvector(v, bf16x2_t); return __builtin_bit_cast(unsigned, b); }
__device__ __forceinline__ float bf_lo(unsigned w) { return __uint_as_float(w << 16); }
__device__ __forceinline__ float bf_hi(unsigned w) { return __uint_as_float(w & 0xffff0000u); }
__device__ __forceinline__ float fsigm(float x) { return __builtin_amdgcn_rcpf(1.f + __builtin_amdgcn_exp2f(-1.4426950408889634f * x)); }
__device__ __forceinline__ u32x4 pack8(const f32x4& a, const f32x4& b) { u32x4 w; w.x = cvt_pk_bf16(a[0], a[1]); w.y = cvt_pk_bf16(a[2], a[3]); w.z = cvt_pk_bf16(b[0], b[1]); w.w = cvt_pk_bf16(b[2], b[3]); return w; }
__device__ __forceinline__ void unpack8(const u32x4& w, f32x4& a, f32x4& b) { a = (f32x4){bf_lo(w.x), bf_hi(w.x), bf_lo(w.y), bf_hi(w.y)}; b = (f32x4){bf_lo(w.z), bf_hi(w.z), bf_lo(w.w), bf_hi(w.w)}; }

template <class Epi, class Sched, bool ALIGN_EPI = true>
__device__ __forceinline__ void gemm_phase(PG8_LAS unsigned char* lds, const int K, const Sched& S, const Epi& E) {
    const int tid = threadIdx.x, wid = __builtin_amdgcn_readfirstlane(tid >> 6), lane = tid & 63, wr = wid >> 2, wc = wid & 3, fr = lane & 15, fq = lane >> 4;
    const int nt = K / BK;
    int Rr[2], Cc[2]; unsigned voffB[2], voffA[2];
#pragma unroll
    for (int i = 0; i < 2; ++i) { stage_rc(tid * 16 + i * 8192, Rr[i], Cc[i]); const int Rb = Epi::PERM ? ((Rr[i] & ~31) + perm32(Rr[i] & 31)) : Rr[i];
        voffB[i] = (unsigned)Rb * S.ldb2 + (unsigned)Cc[i] * 2u; voffA[i] = (unsigned)Rr[i] * S.lda2 + (unsigned)Cc[i] * 2u; }
    const size_t ah = (size_t)HALF * S.lda2;
    const size_t kstep = (size_t)(BK * 2);
    const size_t bh = (size_t)HALF * S.ldb2;
    const unsigned ldsw = (unsigned)wid * 1024u;
    const int aoff = lds_byte(wr * 64 + fr, fq * 8), boff = lds_byte(wc * 32 + fr, fq * 8);
#define PG8_SA(b, h) (((b) * 2 + (h)) * HTB)
#define PG8_SB(b, h) ((4 + (b) * 2 + (h)) * HTB)
#define PG8_STAGE(bufoff, gbase, voff) do { _Pragma("unroll") for (int _i = 0; _i < 2; ++_i) \
        __builtin_amdgcn_global_load_lds((const unsigned*)((const char*)(gbase) + (voff)[_i]), (PG8_LAS unsigned*)(lds + (bufoff) + ldsw + _i * 8192), 16, 0, 0); } while (0)
#define PG8_STAGE_A(bufoff, h, gbase, VG) do { if constexpr (Sched::GATHER) { PG8_STAGE(bufoff, gbase, VG[h]); } else { PG8_STAGE(bufoff, (gbase) + (h) * ah, voffA); } } while (0)
#define PG8_LDA(dst, b, h) do { _Pragma("unroll") for (int m = 0; m < 4; ++m) _Pragma("unroll") for (int k = 0; k < 2; ++k) dst[m][k] = *(const PG8_LAS bf16x8*)(lds + PG8_SA(b, h) + aoff + m * 2048 + k * 1024); } while (0)
#define PG8_LDB(dst, b, h) do { _Pragma("unroll") for (int n = 0; n < 2; ++n) _Pragma("unroll") for (int k = 0; k < 2; ++k) dst[n][k] = *(const PG8_LAS bf16x8*)(lds + PG8_SB(b, h) + boff + n * 2048 + k * 1024); } while (0)
#define PG8_MMA(ai, bj, At, Bt) do { __builtin_amdgcn_s_setprio(1); _Pragma("unroll") for (int m = 0; m < 4; ++m) _Pragma("unroll") for (int n = 0; n < 2; ++n) _Pragma("unroll") for (int k = 0; k < 2; ++k) \
        acc[ai][bj][m][n] = __builtin_amdgcn_mfma_f32_16x16x32_bf16(Bt[n][k], At[m][k], acc[ai][bj][m][n], 0, 0, 0); __builtin_amdgcn_s_setprio(0); } while (0)
#define PG8_WAIT_V(n) asm volatile("s_waitcnt vmcnt(" #n ")" ::: "memory")
#define PG8_WAIT_L(n) asm volatile("s_waitcnt lgkmcnt(" #n ")" ::: "memory")
#define PG8_BAR __builtin_amdgcn_s_barrier()
#define PG8_SCHED __builtin_amdgcn_sched_barrier(0)
    Unit cur, nxt; int ui = 0;
    if (!S.next(0, cur)) return;
    f32x4 acc[2][2][4][2];
#pragma unroll
    for (int a = 0; a < 2; ++a)
#pragma unroll
        for (int b = 0; b < 2; ++b)
#pragma unroll
            for (int m = 0; m < 4; ++m)
#pragma unroll
                for (int n = 0; n < 2; ++n) acc[a][b][m][n] = (f32x4){0.f, 0.f, 0.f, 0.f};
    bf16x8 At[4][2], B0[2][2], B1[2][2];
    unsigned vAc[2][2], vAn[2][2];
    if constexpr (Sched::GATHER) S.a_off(cur, Rr, Cc, vAc);
    const char* cA = uptr(S.a_ptr(cur)); const char* cB = uptr(S.b_ptr(cur));
    PG8_STAGE(PG8_SB(0, 0), cB, voffB); PG8_STAGE(PG8_SB(0, 1), cB + bh, voffB); PG8_STAGE_A(PG8_SA(0, 0), 0, cA, vAc); PG8_STAGE_A(PG8_SA(0, 1), 1, cA, vAc);
    if (wr == 1) PG8_BAR;
    PG8_WAIT_V(2); PG8_BAR;
    PG8_STAGE(PG8_SB(1, 0), cB + kstep, voffB); PG8_STAGE_A(PG8_SA(1, 0), 0, cA + kstep, vAc); PG8_STAGE(PG8_SB(1, 1), cB + bh + kstep, voffB);
    PG8_WAIT_V(6); PG8_BAR;
    for (;;) {
        const bool has_next = S.next(ui + 1, nxt);
        const char* nA = cA; const char* nB = cB;
        if constexpr (Sched::GATHER) {
#pragma unroll
            for (int h = 0; h < 2; ++h)
#pragma unroll
                for (int i = 0; i < 2; ++i) vAn[h][i] = vAc[h][i]; }
        if (has_next) { nA = uptr(S.a_ptr(nxt)); nB = uptr(S.b_ptr(nxt)); if constexpr (Sched::GATHER) S.a_off(nxt, Rr, Cc, vAn); }
#pragma unroll 1
        for (int t = 0; t < nt; t += 2) {
            const bool last = (t == nt - 2);
            const char* a1 = cA + (size_t)(t + 1) * kstep;
            const char* a2 = last ? nA : cA + (size_t)(t + 2) * kstep; const char* b2 = last ? nB : cB + (size_t)(t + 2) * kstep;
            const char* a3 = a2 + kstep; const char* b3 = b2 + kstep;
            unsigned v2[2][2];
            if constexpr (Sched::GATHER) {
#pragma unroll
                for (int h = 0; h < 2; ++h)
#pragma unroll
                    for (int i = 0; i < 2; ++i) v2[h][i] = last ? vAn[h][i] : vAc[h][i]; }
            PG8_LDB(B0, 0, 0); PG8_LDB(B1, 0, 1); PG8_SCHED; PG8_LDA(At, 0, 0); PG8_STAGE_A(PG8_SA(1, 1), 1, a1, vAc);
            PG8_WAIT_V(8); PG8_WAIT_L(0); PG8_BAR; PG8_MMA(0, 0, At, B0); PG8_MMA(0, 1, At, B1); PG8_BAR; PG8_SCHED;
            PG8_LDA(At, 0, 1); PG8_STAGE(PG8_SB(0, 0), b2, voffB); PG8_STAGE(PG8_SB(0, 1), b2 + bh, voffB); PG8_STAGE_A(PG8_SA(0, 0), 0, a2, v2);
            PG8_WAIT_V(8); PG8_WAIT_L(0); PG8_BAR; PG8_MMA(1, 0, At, B0); PG8_MMA(1, 1, At, B1); PG8_BAR; PG8_SCHED;
            PG8_LDB(B0, 1, 0); PG8_LDB(B1, 1, 1); PG8_SCHED; PG8_LDA(At, 1, 0); PG8_STAGE_A(PG8_SA(0, 1), 1, a2, v2);
            PG8_WAIT_V(8); PG8_WAIT_L(0); PG8_BAR; PG8_MMA(0, 0, At, B0); PG8_MMA(0, 1, At, B1); PG8_BAR; PG8_SCHED;
            PG8_LDA(At, 1, 1); PG8_STAGE(PG8_SB(1, 0), b3, voffB); PG8_STAGE(PG8_SB(1, 1), b3 + bh, voffB); PG8_STAGE_A(PG8_SA(1, 0), 0, a3, v2);
            PG8_WAIT_V(8); PG8_WAIT_L(0); PG8_BAR; PG8_MMA(1, 0, At, B0); PG8_MMA(1, 1, At, B1); PG8_BAR; PG8_SCHED;
        }
        if constexpr (ALIGN_EPI) { if (wr == 0) PG8_BAR; }
        E(acc, cur, wr, wc, fr, fq);
        if (!has_next) break;
#pragma unroll
        for (int a = 0; a < 2; ++a)
#pragma unroll
            for (int b = 0; b < 2; ++b)
#pragma unroll
                for (int m = 0; m < 4; ++m)
#pragma unroll
                    for (int n = 0; n < 2; ++n) acc[a][b][m][n] = (f32x4){0.f, 0.f, 0.f, 0.f};
        cur = nxt; cA = nA; cB = nB; ++ui;
        if constexpr (Sched::GATHER) {
#pragma unroll
            for (int h = 0; h < 2; ++h)
#pragma unroll
                for (int i = 0; i < 2; ++i) vAc[h][i] = vAn[h][i]; }
        if constexpr (ALIGN_EPI) { if (wr == 1) PG8_BAR; }
    }
    PG8_WAIT_V(0);
    if constexpr (!ALIGN_EPI) { if (wr == 0) PG8_BAR; }
    PG8_BAR;
#undef PG8_SA
#undef PG8_SB
#undef PG8_STAGE
#undef PG8_STAGE_A
#undef PG8_LDA
#undef PG8_LDB
#undef PG8_MMA
#undef PG8_WAIT_V
#undef PG8_WAIT_L
#undef PG8_BAR
#undef PG8_SCHED
}
}

#define XB_TMO      128
#define XB_XCNT(j)  (256  + 64 * (j))
#define XB_XSUB(j)  (1280 + 64 * (j))
#define XB_XGEN(j)  (2304 + 64 * (j))
#define XB_TOP      3328
#define XB_TOPGEN   3392
#define XCD_BAR_WORDS 3456
#define XB_SPIN_CAP (1u << 18)
#define LAS __attribute__((address_space(3)))

__device__ __forceinline__ unsigned xb_ld(unsigned* p)              { return __hip_atomic_load(p, __ATOMIC_RELAXED, __HIP_MEMORY_SCOPE_AGENT); }
__device__ __forceinline__ unsigned xb_add(unsigned* p, unsigned v) { return __hip_atomic_fetch_add(p, v, __ATOMIC_RELAXED, __HIP_MEMORY_SCOPE_AGENT); }
__device__ __forceinline__ unsigned xb_xcc_id() { return (unsigned)__builtin_amdgcn_s_getreg((3 << 11) | 20) & 0xFu; }
#define XB_SPIN(cond, bar) do { unsigned _sp = 0; while (cond) { __builtin_amdgcn_s_sleep(1); \
    if ((++_sp & 255u) == 0u) { if (xb_ld(&(bar)[XB_TMO])) break; if (_sp > XB_SPIN_CAP) { atomicAdd(&(bar)[XB_TMO], 1u); break; } } } } while (0)

struct XcdBarrier {
    unsigned* bar; unsigned x;
    volatile LAS unsigned* st;
};

__device__ __forceinline__ XcdBarrier xcd_barrier_post(unsigned* bar, volatile LAS unsigned* st) {
    XcdBarrier b; b.bar = bar; b.x = xb_xcc_id(); b.st = st;
    if (threadIdx.x == 0) (void)xb_add(&bar[XB_XCNT(b.x)], 1u);
    return b;
}
__device__ __forceinline__ void xcd_barrier_complete(unsigned* bar, unsigned x, unsigned& nloc, unsigned& nx) {
    const unsigned G = gridDim.x * gridDim.y * gridDim.z;
    unsigned sum, cnt, mine, sp = 0u;
    for (;;) {
        sum = 0u; cnt = 0u; mine = 0u;
#pragma unroll
        for (unsigned j = 0; j < 16; ++j) { const unsigned c = xb_ld(&bar[XB_XCNT(j)]); sum += c; cnt += (c > 0u) ? 1u : 0u; mine = (j == x) ? c : mine; }
        if (sum == G) break;
        __builtin_amdgcn_s_sleep(1);
        if ((++sp & 255u) == 0u) { if (xb_ld(&bar[XB_TMO])) break; if (sp > XB_SPIN_CAP) { atomicAdd(&bar[XB_TMO], 1u); break; } }
    }
    nloc = mine > 0u ? mine : 1u; nx = cnt > 0u ? cnt : 1u;
}

__device__ __forceinline__ void xcd_barrier(const XcdBarrier& b) {
    asm volatile("s_waitcnt vmcnt(0)" ::: "memory");
    __syncthreads();
    if (threadIdx.x == 0) {
        unsigned* bar = b.bar;
        __builtin_amdgcn_s_waitcnt(0);
        unsigned nloc = b.st[0], nx = b.st[1];
        if (nloc == 0u) { xcd_barrier_complete(bar, b.x, nloc, nx); b.st[0] = nloc; b.st[1] = nx; }
        const unsigned old = xb_add(&bar[XB_XSUB(b.x)], 1u);
        const unsigned gen = old / nloc;
        if (old + 1u == (gen + 1u) * nloc) {
            __builtin_amdgcn_fence(__ATOMIC_RELEASE, "agent");
            asm volatile("s_waitcnt vmcnt(0)" ::: "memory");
            const unsigned og = xb_add(&bar[XB_TOP], 1u);
            const unsigned tg = og / nx;
            if (og + 1u == (tg + 1u) * nx) xb_add(&bar[XB_TOPGEN], 1u);
            else XB_SPIN(xb_ld(&bar[XB_TOPGEN]) == tg, bar);
            __builtin_amdgcn_fence(__ATOMIC_ACQUIRE, "agent");
            xb_add(&bar[XB_XGEN(b.x)], 1u);
            asm volatile("s_waitcnt vmcnt(0)" ::: "memory");
        } else {
            XB_SPIN(xb_ld(&bar[XB_XGEN(b.x)]) == gen, bar);
            __builtin_amdgcn_fence(__ATOMIC_ACQUIRE, "agent");
            asm volatile("s_waitcnt vmcnt(0)" ::: "memory");
        }
    }
    __syncthreads();
}


constexpr int NWAVES = 8;
constexpr int T = 16384, D = 2048, RW = 1024, NH = 8, DH = 128, SG = 64, SP = 64, SC = 16, NE = 32, FE = 512, PLE = 256, INC = 5120;
constexpr int N1 = 9216;
constexpr int S5L = 16, S5NC = T / S5L, S5K = 384;
constexpr int RSC = 32, RCH = 8;
constexpr float EPS = 1e-6f;

constexpr size_t MiB = 1u << 20;
constexpr size_t WS_CTL = 0, CTL_ZERO_BYTES = 1 * MiB;
constexpr size_t WS_LIST = 1 * MiB, WS_WGT = 3 * MiB, WS_RINV = 3 * MiB + 256 * 1024, WS_LAM = 3 * MiB + 512 * 1024;
constexpr size_t WS_COS = 4 * MiB, WS_SIN = 8 * MiB, WS_PB = 12 * MiB;
constexpr size_t WS_WT1 = 20 * MiB, WS_WGLU = 56 * MiB, WS_WA = 58 * MiB, WS_WB = 62 * MiB, WS_WOUT = 66 * MiB, WS_WPG = 74 * MiB, WS_WP = 82 * MiB, WS_BTC = 83 * MiB, WS_BLT = 95 * MiB;
constexpr size_t WS_HB = 100 * MiB, WS_YRET = 100 * MiB, WS_YPRE = 132 * MiB;
constexpr size_t WS_Q = 164 * MiB, WS_K = 196 * MiB, WS_V = 228 * MiB, WS_G = 260 * MiB, WS_UA = 292 * MiB, WS_EST = 340 * MiB, WS_KVS = 372 * MiB;
constexpr size_t WS_MERGED = 164 * MiB, WS_YSSM = 228 * MiB;
constexpr size_t WS_END = 600 * MiB;
constexpr int CW_TMO = 0, CW_CODE = 1, CW_BAR = 4096, CW_Q0 = 8192  , CW_CNT = 8256  ;

constexpr int RING_OFF = 0, RING_BYTES = 131072;
constexpr int LDSCTL_OFF = RING_BYTES, MISC_OFF = LDSCTL_OFF + 320;
constexpr int LDS_BYTES = 147456;

#define GAS __attribute__((address_space(1)))
typedef unsigned short bf16;
typedef unsigned v4u __attribute__((ext_vector_type(4)));
typedef unsigned v2u __attribute__((ext_vector_type(2)));
typedef float f32x4 __attribute__((ext_vector_type(4)));
typedef short bf16x8 __attribute__((ext_vector_type(8)));
typedef short s16x4 __attribute__((ext_vector_type(4)));
typedef short v4i16_t __attribute__((ext_vector_type(4)));
typedef GAS unsigned gu32;
#define RLX_AGENT __ATOMIC_RELAXED, __HIP_MEMORY_SCOPE_AGENT
#define LDS_WAIT() asm volatile("s_waitcnt lgkmcnt(0)" ::: "memory")
#define VM_WAIT() asm volatile("s_waitcnt vmcnt(0)" ::: "memory")
using pg8::cvt_pk_bf16; using pg8::bf_lo; using pg8::bf_hi; using pg8::fsigm;

struct Frame {
    LAS unsigned char* lds;
    volatile LAS unsigned* MISC;
    unsigned* ctl;
    int tid, lane, wave, G;
};
__device__ __forceinline__ float wave_sum(float v) {
#pragma unroll
    for (int o = 1; o < 64; o <<= 1) v += __shfl_xor(v, o);
    return v;
}
__device__ __forceinline__ int wg_next_item(Frame& F, unsigned* ctr) {
    __syncthreads();
    if (F.tid == 0) F.MISC[16] = __hip_atomic_fetch_add(ctr, 1u, RLX_AGENT);
    __syncthreads();
    return (int)F.MISC[16];
}

template <int MODE>
__device__ __forceinline__ void transpose_item(const float* W, int K, int N, bf16* WT, int ldt, int row_off, LAS float* scr, int item, int lane) {
    const int nblk = N / 32, kb = item / nblk, nb = item % nblk, k0 = 64 * kb, n0 = 32 * nb;
#pragma unroll 8
    for (int i = 0; i < 32; ++i) { const int kk = 2 * i + (lane >> 5); scr[kk * 33 + (lane & 31)] = W[(size_t)(k0 + kk) * N + n0 + (lane & 31)]; }
    LDS_WAIT(); asm volatile("" ::: "memory");
    const int c = lane & 7;
#pragma unroll
    for (int j = 0; j < 4; ++j) { const int n = (lane >> 3) + 8 * j; const LAS float* s = scr + (8 * c) * 33 + n;
        v4u o; o.x = cvt_pk_bf16(s[0 * 33], s[1 * 33]); o.y = cvt_pk_bf16(s[2 * 33], s[3 * 33]); o.z = cvt_pk_bf16(s[4 * 33], s[5 * 33]); o.w = cvt_pk_bf16(s[6 * 33], s[7 * 33]);
        const int nn = n0 + n; const int row = MODE == 0 ? row_off + nn : (MODE == 1 ? 8 * (nn >> 2) + (nn & 3) : 8 * (nn >> 2) + 4 + (nn & 3));
        *(GAS v4u*)(WT + (size_t)row * ldt + k0 + 8 * c) = o; }
    LDS_WAIT(); asm volatile("" ::: "memory");
}
__device__ __forceinline__ void rms_row_to_bf16(int lane, const float* xrow, const float* w, bf16* orow) {
    const GAS f32x4* xr = (const GAS f32x4*)xrow + lane; const GAS f32x4* wr = (const GAS f32x4*)w + lane;
    f32x4 v[8]; float s = 0.f;
#pragma unroll
    for (int j = 0; j < 8; ++j) { v[j] = xr[64 * j]; s += (v[j].x * v[j].x + v[j].y * v[j].y) + (v[j].z * v[j].z + v[j].w * v[j].w); }
    const float r = rsqrtf(wave_sum(s) * (1.f / D) + EPS);
    GAS v2u* o8 = (GAS v2u*)orow + lane;
#pragma unroll
    for (int j = 0; j < 8; ++j) { const f32x4 ww = wr[64 * j]; v2u o; o.x = cvt_pk_bf16(v[j].x * r * ww.x, v[j].y * r * ww.y); o.y = cvt_pk_bf16(v[j].z * r * ww.z, v[j].w * r * ww.w); o8[64 * j] = o; }
}
__device__ __forceinline__ void s5_tables(Frame& F, int g, const float* lam_re, const float* lam_im, const float* log_dt, const float* b_re, const float* b_im, const float* c_re, const float* c_im, const float* dvec,
                                          bf16* BTC, bf16* BLT, float* LAMT) {
    LAS double* PW = (LAS double*)(F.lds);
    LAS double* BB = (LAS double*)(F.lds + 17408);
    LAS double* CC = (LAS double*)(F.lds + 33792);
    LAS float* KM = (LAS float*)(F.lds + 50176);
    const int tid = F.tid;
    if (tid < 64) {
        const int p = tid; const double lr = fmin((double)lam_re[g * SP + p], -1e-4), li = (double)lam_im[g * SP + p], dt = exp((double)log_dt[g]);
        for (int j = 0; j <= 16; ++j) { const double mag = exp((double)j * lr * dt); double sn, cs; sincos((double)j * li * dt, &sn, &cs); PW[(j * 64 + p) * 2] = mag * cs; PW[(j * 64 + p) * 2 + 1] = mag * sn; }
        { const double mag = exp(512.0 * lr * dt); double sn, cs; sincos(512.0 * li * dt, &sn, &cs);
          LAMT[(g * 64 + p) * 4 + 2] = (float)(mag * cs); LAMT[(g * 64 + p) * 4 + 3] = (float)(mag * sn); }
        const double lbr = PW[(1 * 64 + p) * 2], lbi = PW[(1 * 64 + p) * 2 + 1];
        LAMT[(g * 64 + p) * 4 + 0] = (float)PW[(16 * 64 + p) * 2]; LAMT[(g * 64 + p) * 4 + 1] = (float)PW[(16 * 64 + p) * 2 + 1];
        const double nr = lbr - 1.0, ni = lbi, den = lr * lr + li * li; const double fr = (nr * lr + ni * li) / den, fi = (ni * lr - nr * li) / den;
        for (int c = 0; c < 16; ++c) { const double br = b_re[(g * SP + p) * SC + c], bi = b_im[(g * SP + p) * SC + c]; BB[(p * 16 + c) * 2] = fr * br - fi * bi; BB[(p * 16 + c) * 2 + 1] = fr * bi + fi * br; }
    }
    for (int idx = tid; idx < 1024; idx += 512) { const int c = idx >> 6, p = idx & 63; CC[idx * 2] = (double)c_re[(g * SC + c) * SP + p]; CC[idx * 2 + 1] = (double)c_im[(g * SC + c) * SP + p]; }
    __syncthreads();
    for (int idx = tid; idx < 4096; idx += 512) { const int j = idx >> 8, c = (idx >> 4) & 15, c2 = idx & 15; double s = 0.0;
        for (int p = 0; p < 64; ++p) { const double cr = CC[(c * 64 + p) * 2], ci = CC[(c * 64 + p) * 2 + 1], pr = PW[(j * 64 + p) * 2], pi = PW[(j * 64 + p) * 2 + 1];
            const double ar = cr * pr - ci * pi, ai = cr * pi + ci * pr; s += ar * BB[(p * 16 + c2) * 2] - ai * BB[(p * 16 + c2) * 2 + 1]; }
        if (j == 0 && c == c2) s += (double)dvec[g * SC + c];
        KM[idx] = (float)s; }
    __syncthreads();
    for (int idx = tid; idx < 256 * 48; idx += 512) { const int n = idx / 48, kc = idx % 48, s = n >> 4, c = n & 15; float v[8];
        if (kc < 32) { const int t = kc >> 1, c0 = (kc & 1) * 8;
#pragma unroll
            for (int j = 0; j < 8; ++j) v[j] = (t <= s) ? KM[((s - t) * 16 + c) * 16 + c0 + j] : 0.f;
        } else { const int q = kc - 32, part = q >> 3, p0 = (q & 7) * 8;
#pragma unroll
            for (int j = 0; j < 8; ++j) { const int p = p0 + j; const double cr = CC[(c * 64 + p) * 2], ci = CC[(c * 64 + p) * 2 + 1], pr = PW[((s + 1) * 64 + p) * 2], pi = PW[((s + 1) * 64 + p) * 2 + 1];
                v[j] = part ? (float)(-(cr * pi + ci * pr)) : (float)(cr * pr - ci * pi); } }
        v4u o; o.x = cvt_pk_bf16(v[0], v[1]); o.y = cvt_pk_bf16(v[2], v[3]); o.z = cvt_pk_bf16(v[4], v[5]); o.w = cvt_pk_bf16(v[6], v[7]);
        *(GAS v4u*)(BTC + ((size_t)(g * 256 + n) * S5K + kc * 8)) = o; }
    for (int idx = tid; idx < 128 * 32; idx += 512) { const int n = idx >> 5, kc = idx & 31, p = n & 63, part = n >> 6, t = kc >> 1, c0 = (kc & 1) * 8; float v[8];
        const double pr = PW[((15 - t) * 64 + p) * 2], pi = PW[((15 - t) * 64 + p) * 2 + 1];
#pragma unroll
        for (int j = 0; j < 8; ++j) { const double br = BB[(p * 16 + c0 + j) * 2], bi = BB[(p * 16 + c0 + j) * 2 + 1]; v[j] = part ? (float)(pr * bi + pi * br) : (float)(pr * br - pi * bi); }
        v4u o; o.x = cvt_pk_bf16(v[0], v[1]); o.y = cvt_pk_bf16(v[2], v[3]); o.z = cvt_pk_bf16(v[4], v[5]); o.w = cvt_pk_bf16(v[6], v[7]);
        *(GAS v4u*)(BLT + ((size_t)(g * 128 + n) * 256 + kc * 8)) = o; }
    __syncthreads();
}

using pg8::Unit; using pg8::pack8; using pg8::unpack8;
struct EpiProj {
    static constexpr bool PERM = true;
    bf16* QKVG; bf16* UA; bf16* GATES;
    __device__ __forceinline__ void operator()(const f32x4 (&acc)[2][2][4][2], const Unit& u, int wr, int wc, int fr, int fq) const {
        const int row0 = u.pm * 256 + wr * 64 + fr, ct = wc * 32 + 8 * fq;
        if (u.pn < 16) { bf16* dst = QKVG + (size_t)(u.pn >> 2) * T * RW + (u.pn & 3) * 256 + ct;
#pragma unroll
            for (int ai = 0; ai < 2; ++ai)
#pragma unroll
                for (int m = 0; m < 4; ++m) { const size_t row = row0 + ai * 128 + m * 16;
#pragma unroll
                    for (int bj = 0; bj < 2; ++bj) *(v4u*)(dst + row * RW + bj * 128) = pack8(acc[ai][bj][m][0], acc[ai][bj][m][1]); }
        } else if (u.pn < 20) {
#pragma unroll
            for (int ai = 0; ai < 2; ++ai)
#pragma unroll
                for (int m = 0; m < 4; ++m) { const int row = row0 + ai * 128 + m * 16, ci = row >> 4, s = row & 15;
#pragma unroll
                    for (int bj = 0; bj < 2; ++bj) { const int cu = (u.pn - 16) * 256 + bj * 128 + ct, g = cu >> 4, c0 = cu & 15;
                        *(v4u*)(UA + ((size_t)(g * S5NC + ci) * S5K + 16 * s + c0)) = pack8(acc[ai][bj][m][0], acc[ai][bj][m][1]); } }
        } else { bf16* dst = GATES + (u.pn - 20) * 256 + ct;
#pragma unroll
            for (int ai = 0; ai < 2; ++ai)
#pragma unroll
                for (int m = 0; m < 4; ++m) { const size_t row = row0 + ai * 128 + m * 16;
#pragma unroll
                    for (int bj = 0; bj < 2; ++bj) { f32x4 a = acc[ai][bj][m][0], b = acc[ai][bj][m][1];
#pragma unroll
                        for (int j = 0; j < 4; ++j) { a[j] = fsigm(a[j]); b[j] = fsigm(b[j]); }
                        *(v4u*)(dst + row * 4096 + bj * 128) = pack8(a, b); } }
        }
    }
};
struct EpiS5A {
    static constexpr bool PERM = false;
    float* EST;
    __device__ __forceinline__ void operator()(const f32x4 (&acc)[2][2][4][2], const Unit& u, int wr, int wc, int fr, int fq) const {
        const int row0 = u.pm * 256 + wr * 64 + fr, col0 = wc * 32 + 4 * fq;
#pragma unroll
        for (int ai = 0; ai < 2; ++ai)
#pragma unroll
            for (int m = 0; m < 4; ++m) { float* rowp = EST + ((size_t)u.z * S5NC + row0 + ai * 128 + m * 16) * 128 + col0;
#pragma unroll
                for (int n = 0; n < 2; ++n) *(f32x4*)(rowp + n * 16) = acc[ai][0][m][n]; }
    }
};
struct EpiS5C {
    static constexpr bool PERM = true;
    bf16* YPRE;
    __device__ __forceinline__ void operator()(const f32x4 (&acc)[2][2][4][2], const Unit& u, int wr, int wc, int fr, int fq) const {
        const int row0 = u.pm * 256 + wr * 64 + fr, ct = wc * 32 + 8 * fq;
        bf16* yb = YPRE + ((size_t)row0 * 16 * RW + u.z * 16);
#pragma unroll
        for (int ai = 0; ai < 2; ++ai)
#pragma unroll
            for (int m = 0; m < 4; ++m) {
#pragma unroll
                for (int bj = 0; bj < 2; ++bj) { const int col = bj * 128 + ct, s = col >> 4, c0 = col & 15;
                    f32x4 a = acc[ai][bj][m][0], b = acc[ai][bj][m][1];
#pragma unroll
                    for (int j = 0; j < 4; ++j) { const float xa = a[j], xb = b[j];
                        a[j] = xa * fsigm(1.5957691216057308f * (xa + 0.044715f * xa * xa * xa)); b[j] = xb * fsigm(1.5957691216057308f * (xb + 0.044715f * xb * xb * xb)); }
                    *(v4u*)(yb + (size_t)(ai * 128 + m * 16) * 16 * RW + (size_t)s * RW + c0) = pack8(a, b); } }
    }
};
struct EpiGlu {
    static constexpr bool PERM = true;
    const bf16* YPRE; bf16* YSSM;
    __device__ __forceinline__ void operator()(const f32x4 (&acc)[2][2][4][2], const Unit& u, int wr, int wc, int fr, int fq) const {
        const int row0 = u.pm * 256 + wr * 64 + fr, col0 = u.pn * 256 + wc * 32 + 8 * fq;
#pragma unroll
        for (int ai = 0; ai < 2; ++ai)
#pragma unroll
            for (int m = 0; m < 4; ++m) { const size_t off = (size_t)(row0 + ai * 128 + m * 16) * RW + col0;
#pragma unroll
                for (int bj = 0; bj < 2; ++bj) { const v4u yw = *(const v4u*)(YPRE + off + bj * 128); f32x4 y0, y1; unpack8(yw, y0, y1);
                    f32x4 a = acc[ai][bj][m][0], b = acc[ai][bj][m][1];
#pragma unroll
                    for (int j = 0; j < 4; ++j) { a[j] = y0[j] * fsigm(a[j]); b[j] = y1[j] * fsigm(b[j]); }
                    *(v4u*)(YSSM + off + bj * 128) = pack8(a, b); }
                if (m & 1) asm volatile("" ::: "memory"); }
    }
};
struct EpiMerge {
    static constexpr bool PERM = true;
    const bf16* GATES; bf16* MERGED;
    __device__ __forceinline__ void operator()(const f32x4 (&acc)[2][2][4][2], const Unit& u, int wr, int wc, int fr, int fq) const {
        const int row0 = u.pm * 256 + wr * 64 + fr, col0 = u.pn * 256 + wc * 32 + 8 * fq;
#pragma unroll
        for (int ai = 0; ai < 2; ++ai)
#pragma unroll
            for (int m = 0; m < 4; ++m) { const size_t row = row0 + ai * 128 + m * 16;
#pragma unroll
                for (int bj = 0; bj < 2; ++bj) { const v4u gw = *(const v4u*)(GATES + row * 4096 + u.z * 2048 + col0 + bj * 128); f32x4 g0, g1; unpack8(gw, g0, g1);
                    f32x4 a = acc[ai][bj][m][0] * g0, b = acc[ai][bj][m][1] * g1;
                    bf16* mp = MERGED + row * D + col0 + bj * 128;
                    if (u.z) { const v4u pw = *(const v4u*)mp; f32x4 p0, p1; unpack8(pw, p0, p1); a += p0; b += p1; }
                    *(v4u*)mp = pack8(a, b); }
                if (m & 1) asm volatile("" ::: "memory"); }
    }
};
struct EpiOut {
    static constexpr bool PERM = false;
    const float* X; float* O;
    __device__ __forceinline__ void operator()(const f32x4 (&acc)[2][2][4][2], const Unit& u, int wr, int wc, int fr, int fq) const {
        const int row0 = u.pm * 256 + wr * 64 + fr, col0 = u.pn * 256 + wc * 32 + 4 * fq;
#pragma unroll
        for (int ai = 0; ai < 2; ++ai)
#pragma unroll
            for (int m = 0; m < 4; ++m) { const size_t off = (size_t)(row0 + ai * 128 + m * 16) * D + col0;
#pragma unroll
                for (int bj = 0; bj < 2; ++bj)
#pragma unroll
                    for (int n = 0; n < 2; ++n) { const f32x4 xv = *(const f32x4*)(X + off + bj * 128 + n * 16); *(f32x4*)(O + off + bj * 128 + n * 16) = xv + acc[ai][bj][m][n]; }
                asm volatile("" ::: "memory"); }
    }
};

__device__ __forceinline__ unsigned off_b(unsigned row, unsigned ch) { return 256u * row + 16u * (ch ^ (((row & 3) << 2) | ((row >> 2) & 3))); }
__device__ __forceinline__ unsigned rrow16(unsigned lane, unsigned rb, unsigned s) { return off_b((lane & 15) + 16 * rb, 4 * s + (lane >> 4)); }
__device__ __forceinline__ unsigned rtr16(unsigned lane, unsigned c, unsigned ks, unsigned t) { const unsigned g = lane >> 4, q = (lane & 15) >> 2, p = lane & 3; return off_b(32 * ks + 8 * g + 4 * t + q, 2 * c + (p >> 1)) + 8 * (p & 1); }
__device__ __forceinline__ s16x4 vtr(LAS unsigned char* p) { return __builtin_bit_cast(s16x4, __builtin_amdgcn_ds_read_tr16_b64_v4i16((LAS v4i16_t*)p)); }
__device__ __forceinline__ bf16x8 trfrag(LAS unsigned char* img, unsigned lane, unsigned c, unsigned ks) {
    const s16x4 a = vtr(img + rtr16(lane, c, ks, 0)), b = vtr(img + rtr16(lane, c, ks, 1));
    return (bf16x8){a[0], a[1], a[2], a[3], b[0], b[1], b[2], b[3]};
}
__device__ __forceinline__ bf16x8 rowfrag(LAS unsigned char* img, unsigned lane, unsigned rb, unsigned s) { return *(const LAS bf16x8*)(img + rrow16(lane, rb, s)); }
constexpr int RL_Q = 0, RL_K = 16384, RL_KD = 32768, RL_V = 49152, RL_ST = 65536, RL_P = 98304, RL_STAT = 98304 + 9216;
constexpr int PS_STRIDE = 144;

struct RetCtx { const bf16* Q; const bf16* K; const bf16* V; const bf16* Gt; const float* COS; const float* SIN; const float* gnw; float* KVS; bf16* YRET; };

template <bool WITH_Q>
__device__ __forceinline__ void ret_stage(Frame& F, const RetCtx& R, int tok0, int h, float l2g, float wexp0) {
    const int tid = F.tid, row = tid >> 3, ch = tid & 7; const size_t tok = (size_t)tok0 + row;
    const f32x4 c0 = *(const f32x4*)(R.COS + tok * 64 + ch * 8), c1 = *(const f32x4*)(R.COS + tok * 64 + ch * 8 + 4);
    const f32x4 s0 = *(const f32x4*)(R.SIN + tok * 64 + ch * 8), s1 = *(const f32x4*)(R.SIN + tok * 64 + ch * 8 + 4);
    const size_t gofs = tok * RW + h * DH + ch * 8;
    const v4u k1w = *(const v4u*)(R.K + gofs), k2w = *(const v4u*)(R.K + gofs + 64);
    const v4u v1w = *(const v4u*)(R.V + gofs), v2w = *(const v4u*)(R.V + gofs + 64);
    f32x4 a0, a1, b0, b1;
    if (WITH_Q) { const v4u q1w = *(const v4u*)(R.Q + gofs), q2w = *(const v4u*)(R.Q + gofs + 64);
        unpack8(q1w, a0, a1); unpack8(q2w, b0, b1);
        *(LAS v4u*)(F.lds + RL_Q + off_b(row, ch)) = pack8(a0 * c0 - b0 * s0, a1 * c1 - b1 * s1);
        *(LAS v4u*)(F.lds + RL_Q + off_b(row, ch + 8)) = pack8(a0 * s0 + b0 * c0, a1 * s1 + b1 * c1); }
    unpack8(k1w, a0, a1); unpack8(k2w, b0, b1);
    const float sc = 0.08838834764831845f;
    f32x4 o0 = (a0 * c0 - b0 * s0) * sc, o1 = (a1 * c1 - b1 * s1) * sc, p0 = (a0 * s0 + b0 * c0) * sc, p1 = (a1 * s1 + b1 * c1) * sc;
    if (WITH_Q) { *(LAS v4u*)(F.lds + RL_K + off_b(row, ch)) = pack8(o0, o1); *(LAS v4u*)(F.lds + RL_K + off_b(row, ch + 8)) = pack8(p0, p1); }
    const float kw = __builtin_amdgcn_exp2f(l2g * (wexp0 - (float)row));
    *(LAS v4u*)(F.lds + RL_KD + off_b(row, ch)) = pack8(o0 * kw, o1 * kw); *(LAS v4u*)(F.lds + RL_KD + off_b(row, ch + 8)) = pack8(p0 * kw, p1 * kw);
    *(LAS v4u*)(F.lds + RL_V + off_b(row, ch)) = v1w; *(LAS v4u*)(F.lds + RL_V + off_b(row, ch + 8)) = v2w;
}
__device__ __forceinline__ void ret_kv_update(Frame& F, f32x4 (&st)[8]) {
    const unsigned lane = F.lane, w = F.wave;
#pragma unroll
    for (int ks = 0; ks < 2; ++ks) { const bf16x8 a = trfrag(F.lds + RL_KD, lane, w, ks);
#pragma unroll
        for (int et = 0; et < 8; ++et) { const bf16x8 b = trfrag(F.lds + RL_V, lane, et, ks); st[et] = __builtin_amdgcn_mfma_f32_16x16x32_bf16(a, b, st[et], 0, 0, 0); } }
}
__device__ __forceinline__ void ret_pass_a(Frame& F, const RetCtx& R, int job) {
    const int s = job >> 3, h = job & 7; const float l2g = log2f(1.f - exp2f(-5.f - (float)h));
    f32x4 st[8];
#pragma unroll
    for (int et = 0; et < 8; ++et) st[et] = (f32x4){0.f, 0.f, 0.f, 0.f};
    for (int c = 0; c < RCH; ++c) {
        __syncthreads();
        ret_stage<false>(F, R, (s * RCH + c) * 64, h, l2g, (float)(511 - 64 * c));
        __syncthreads();
        ret_kv_update(F, st);
    }
    const int fr = F.lane & 15, g = F.lane >> 4; float* o = R.KVS + ((size_t)(s * NH + h) * DH) * DH;
#pragma unroll
    for (int et = 0; et < 8; ++et)
#pragma unroll
        for (int r = 0; r < 4; ++r) o[(size_t)(16 * F.wave + 4 * g + r) * DH + 16 * et + fr] = st[et][r];
}
__device__ __forceinline__ void ret_pass_c(Frame& F, const RetCtx& R, int job) {
    const int s = job >> 3, h = job & 7; const float gam = 1.f - exp2f(-5.f - (float)h), l2g = log2f(gam), cd = __builtin_amdgcn_exp2f(l2g * 64.f);
    const unsigned lane = F.lane, w = F.wave; const int fr = lane & 15, g = lane >> 4;
    f32x4 st[8];
    { const float* o = R.KVS + ((size_t)(s * NH + h) * DH) * DH;
#pragma unroll
      for (int et = 0; et < 8; ++et)
#pragma unroll
          for (int r = 0; r < 4; ++r) st[et][r] = o[(size_t)(16 * w + 4 * g + r) * DH + 16 * et + fr]; }
    const int qt = w >> 1, eh = w & 1;
    const int kt = w >> 1, qt2 = 2 * (w & 1);
    for (int c = 0; c < RCH; ++c) {
        const int tok0 = (s * RCH + c) * 64;
        __syncthreads();
#pragma unroll
        for (int et = 0; et < 8; ++et) { v2u pk; pk.x = cvt_pk_bf16(st[et][0], st[et][1]); pk.y = cvt_pk_bf16(st[et][2], st[et][3]);
            *(LAS v2u*)(F.lds + RL_ST + off_b(16 * et + fr, 2 * w + (g >> 1)) + 8 * (g & 1)) = pk; }
        ret_stage<true>(F, R, tok0, h, l2g, 63.f);
        __syncthreads();
#pragma unroll
        for (int j = 0; j < 2; ++j) { f32x4 sc = (f32x4){0.f, 0.f, 0.f, 0.f};
#pragma unroll
            for (int ks = 0; ks < 4; ++ks) sc = __builtin_amdgcn_mfma_f32_16x16x32_bf16(rowfrag(F.lds + RL_K, lane, kt, ks), rowfrag(F.lds + RL_Q, lane, qt2 + j, ks), sc, 0, 0, 0);
            const int q = 16 * (qt2 + j) + fr;
#pragma unroll
            for (int r = 0; r < 4; ++r) { const int key = 16 * kt + 4 * g + r; sc[r] *= __builtin_amdgcn_exp2f(l2g * fabsf((float)(q - key))); }
            v2u pk; pk.x = cvt_pk_bf16(sc[0], sc[1]); pk.y = cvt_pk_bf16(sc[2], sc[3]);
            *(LAS v2u*)(F.lds + RL_P + q * PS_STRIDE + (16 * kt + 4 * g) * 2) = pk; }
        f32x4 y[4];
#pragma unroll
        for (int j = 0; j < 4; ++j) y[j] = (f32x4){0.f, 0.f, 0.f, 0.f};
#pragma unroll
        for (int ks = 0; ks < 4; ++ks) { const bf16x8 a = rowfrag(F.lds + RL_Q, lane, qt, ks);
#pragma unroll
            for (int j = 0; j < 4; ++j) y[j] = __builtin_amdgcn_mfma_f32_16x16x32_bf16(a, rowfrag(F.lds + RL_ST, lane, 4 * eh + j, ks), y[j], 0, 0, 0); }
#pragma unroll
        for (int r = 0; r < 4; ++r) { const float qd = __builtin_amdgcn_exp2f(l2g * (float)(16 * qt + 4 * g + r + 1));
#pragma unroll
            for (int j = 0; j < 4; ++j) y[j][r] *= qd; }
        __syncthreads();
#pragma unroll
        for (int ks = 0; ks < 2; ++ks) { const bf16x8 a = *(const LAS bf16x8*)(F.lds + RL_P + (16 * qt + fr) * PS_STRIDE + (32 * ks + 8 * g) * 2);
#pragma unroll
            for (int j = 0; j < 4; ++j) y[j] = __builtin_amdgcn_mfma_f32_16x16x32_bf16(a, trfrag(F.lds + RL_V, lane, 4 * eh + j, ks), y[j], 0, 0, 0); }
        LAS float* STAT = (LAS float*)(F.lds + RL_STAT);
#pragma unroll
        for (int r = 0; r < 4; ++r) { float s1 = 0.f, s2 = 0.f;
#pragma unroll
            for (int j = 0; j < 4; ++j) { s1 += y[j][r]; s2 += y[j][r] * y[j][r]; }
#pragma unroll
            for (int o = 1; o < 16; o <<= 1) { s1 += __shfl_xor(s1, o); s2 += __shfl_xor(s2, o); }
            if (fr == 0) { STAT[((16 * qt + 4 * g + r) * 2 + eh) * 2] = s1; STAT[((16 * qt + 4 * g + r) * 2 + eh) * 2 + 1] = s2; } }
#pragma unroll
        for (int et = 0; et < 8; ++et) st[et] *= cd;
        ret_kv_update(F, st);
        __syncthreads();
#pragma unroll
        for (int r = 0; r < 4; ++r) { const int q = 16 * qt + 4 * g + r; const float s1 = STAT[(q * 2) * 2] + STAT[(q * 2 + 1) * 2], s2 = STAT[(q * 2) * 2 + 1] + STAT[(q * 2 + 1) * 2 + 1];
            const float mu = s1 * (1.f / 128.f), var = s2 * (1.f / 128.f) - mu * mu, rs = rsqrtf(var + EPS); const size_t tok = (size_t)tok0 + q;
#pragma unroll
            for (int j = 0; j < 4; ++j) { const int e = h * DH + 16 * (4 * eh + j) + fr; const float gv = __uint_as_float((unsigned)R.Gt[tok * RW + e] << 16);
                const float o = (y[j][r] - mu) * rs * R.gnw[e] * gv * fsigm(gv);
                R.YRET[tok * RW + e] = (bf16)(cvt_pk_bf16(o, o) & 0xffffu); } }
    }
}

constexpr size_t WS_WR = WS_LAM + 64 * 1024;
constexpr size_t WS_WGU = 164 * MiB, WS_WDN = 292 * MiB, WS_ACT = 356 * MiB, WS_MOE = 396 * MiB, WS_PP = 524 * MiB;
constexpr size_t WS_END2 = 588 * MiB;
constexpr int CW_Q1 = 8320, CW_SS = 131072;
constexpr int MOE_TAB_OFF = LDSCTL_OFF + 1024;

__device__ __forceinline__ void router_weights_item(Frame& F, int item, const float* nf, const float* wrg, const float* wre, bf16* WRH, bf16* WRL) {
    const int j = item * 2 + (F.tid >> 8), k0 = (F.tid & 255) * 8; float v[8];
#pragma unroll
    for (int i = 0; i < 8; ++i) { const int k = k0 + i; float w = 0.f; if (j < 4) w = wrg[k * 4 + j]; else if (j < 36) w = wre[k * NE + (j - 4)]; v[i] = w * nf[k]; }
    unsigned hi[4], lo[4];
#pragma unroll
    for (int i = 0; i < 4; ++i) { hi[i] = cvt_pk_bf16(v[2 * i], v[2 * i + 1]); lo[i] = cvt_pk_bf16(v[2 * i] - bf_lo(hi[i]), v[2 * i + 1] - bf_hi(hi[i])); }
    *(v4u*)(WRH + (size_t)j * D + k0) = (v4u){hi[0], hi[1], hi[2], hi[3]}; *(v4u*)(WRL + (size_t)j * D + k0) = (v4u){lo[0], lo[1], lo[2], lo[3]};
}
__device__ __forceinline__ void router_job(Frame& F, int job, const float* X1, const float* nf, const bf16* WRH, const bf16* WRL, const float* brg, const float* bre,
                                           bf16* HX, float* RINV, unsigned* cnt, int* list, float* wgt) {
    const int lane = F.lane, fr = lane & 15, g = lane >> 4, tok0 = job * 16;
    const float* xp = X1 + (size_t)(tok0 + fr) * D + 8 * g; bf16* hp = HX + (size_t)(tok0 + fr) * D + 8 * g;
    f32x4 acc[3];
#pragma unroll
    for (int nt = 0; nt < 3; ++nt) acc[nt] = (f32x4){0.f, 0.f, 0.f, 0.f};
    float ss = 0.f;
#pragma unroll 2
    for (int ks = 0; ks < D / 32; ++ks) {
        const f32x4 x0 = *(const f32x4*)(xp + 32 * ks), x1 = *(const f32x4*)(xp + 32 * ks + 4);
        const f32x4 n0 = *(const f32x4*)(nf + 32 * ks + 8 * g), n1 = *(const f32x4*)(nf + 32 * ks + 8 * g + 4);
        ss += (x0[0] * x0[0] + x0[1] * x0[1]) + (x0[2] * x0[2] + x0[3] * x0[3]) + (x1[0] * x1[0] + x1[1] * x1[1]) + (x1[2] * x1[2] + x1[3] * x1[3]);
        *(v4u*)(hp + 32 * ks) = pack8(x0 * n0, x1 * n1);
        const unsigned h0 = cvt_pk_bf16(x0[0], x0[1]), h1 = cvt_pk_bf16(x0[2], x0[3]), h2 = cvt_pk_bf16(x1[0], x1[1]), h3 = cvt_pk_bf16(x1[2], x1[3]);
        const unsigned l0 = cvt_pk_bf16(x0[0] - bf_lo(h0), x0[1] - bf_hi(h0)), l1 = cvt_pk_bf16(x0[2] - bf_lo(h1), x0[3] - bf_hi(h1)), l2 = cvt_pk_bf16(x1[0] - bf_lo(h2), x1[1] - bf_hi(h2)), l3 = cvt_pk_bf16(x1[2] - bf_lo(h3), x1[3] - bf_hi(h3));
        const bf16x8 ah = __builtin_bit_cast(bf16x8, (v4u){h0, h1, h2, h3}), al = __builtin_bit_cast(bf16x8, (v4u){l0, l1, l2, l3});
#pragma unroll
        for (int nt = 0; nt < 3; ++nt) { const size_t bo = (size_t)(16 * nt + fr) * D + 32 * ks + 8 * g;
            const bf16x8 bh = *(const bf16x8*)(WRH + bo), bl = *(const bf16x8*)(WRL + bo);
            acc[nt] = __builtin_amdgcn_mfma_f32_16x16x32_bf16(ah, bh, acc[nt], 0, 0, 0);
            acc[nt] = __builtin_amdgcn_mfma_f32_16x16x32_bf16(al, bh, acc[nt], 0, 0, 0);
            acc[nt] = __builtin_amdgcn_mfma_f32_16x16x32_bf16(ah, bl, acc[nt], 0, 0, 0); }
    }
    ss += __shfl_xor(ss, 16); ss += __shfl_xor(ss, 32);
    const float rinv = rsqrtf(ss * (1.f / D) + EPS);
    LAS float* LG = (LAS float*)(F.lds + F.wave * 4096);
#pragma unroll
    for (int r = 0; r < 4; ++r) { const float rv = __shfl(rinv, 4 * g + r);
#pragma unroll
        for (int nt = 0; nt < 3; ++nt) LG[(4 * g + r) * 49 + 16 * nt + fr] = acc[nt][r] * rv; }
    LDS_WAIT(); asm volatile("" ::: "memory");
    if (lane < 16) {
        const int t = tok0 + lane; const LAS float* lg = LG + lane * 49;
        float mx = -1e30f; int gi = 0; float gl[4];
#pragma unroll
        for (int j = 0; j < 4; ++j) { gl[j] = lg[j] + brg[j]; if (gl[j] > mx) { mx = gl[j]; gi = j; } }
        float se = 0.f;
#pragma unroll
        for (int j = 0; j < 4; ++j) se += __expf(gl[j] - mx);
        const float gw = 1.f / se;
        float b1 = -1e30f, b2 = -1e30f; int j1 = 0, j2 = 0;
        for (int j = 0; j < 8; ++j) { const float v = lg[4 + gi * 8 + j] + bre[gi * 8 + j]; if (v > b1) { b2 = b1; j2 = j1; b1 = v; j1 = j; } else if (v > b2) { b2 = v; j2 = j; } }
        const float e2 = __expf(b2 - b1); const float w1 = gw / (1.f + e2), w2 = gw * e2 / (1.f + e2);
        const int ea = gi * 8 + j1, eb = gi * 8 + j2;
        const int pa = (int)__hip_atomic_fetch_add(cnt + ea, 1u, RLX_AGENT); list[(size_t)ea * T + pa] = t * 2; wgt[t * 2] = w1;
        const int pb = (int)__hip_atomic_fetch_add(cnt + eb, 1u, RLX_AGENT); list[(size_t)eb * T + pb] = t * 2 + 1; wgt[t * 2 + 1] = w2;
        RINV[t] = rinv;
    }
    LDS_WAIT(); asm volatile("" ::: "memory");
}

template <int NT> __device__ __forceinline__ void moe_tables(Frame& F, const unsigned* cnt) {
    LAS int* tab = (LAS int*)(F.lds + MOE_TAB_OFF);
    __syncthreads();
    if (F.tid == 0) { int cu = 0, ps = 0; for (int e = 0; e < NE; ++e) { const int c = (int)__hip_atomic_load(cnt + e, RLX_AGENT), nrb = (c + 255) >> 8; tab[e] = cu; tab[33 + e] = ps; tab[66 + e] = c; cu += nrb * NT; ps += nrb * 256; } tab[32] = cu; tab[65] = ps; }
    __syncthreads();
}
template <int NT, int NTSH> struct SchedMoe {
    LAS int* tab; int G, c;
    __device__ __forceinline__ bool next(int i, pg8::Unit& u) const { const int L = i * G + c; if (L >= tab[32]) return false; int e = 0;
#pragma unroll 1
        for (int k = 16; k >= 1; k >>= 1) if (tab[e + k] <= L) e += k;
        while (e < NE - 1 && tab[e + 1] <= L) ++e;
        const int local = L - tab[e]; u.z = e; u.pm = local >> NTSH; u.pn = local & (NT - 1); return true; }
};
struct SchedGU : SchedMoe<4, 2> {
    static constexpr bool GATHER = true;
    const char* A; const char* B; const int* list; unsigned lda2, ldb2;
    __device__ __forceinline__ const char* a_ptr(const pg8::Unit&) const { return A; }
    __device__ __forceinline__ const char* b_ptr(const pg8::Unit& u) const { return B + ((size_t)u.z * 1024 + (size_t)u.pn * 256) * ldb2; }
    __device__ __forceinline__ void a_off(const pg8::Unit& u, const int (&R)[2], const int (&C)[2], unsigned (&v)[2][2]) const { const int ce = tab[66 + u.z];
#pragma unroll
        for (int h = 0; h < 2; ++h)
#pragma unroll
            for (int i = 0; i < 2; ++i) { const int r = u.pm * 256 + h * 128 + R[i]; const int tok = r < ce ? (list[(size_t)u.z * T + r] >> 1) : 0; v[h][i] = (unsigned)tok * lda2 + (unsigned)C[i] * 2u; } }
};
struct SchedDN : SchedMoe<8, 3> {
    static constexpr bool GATHER = false;
    const char* A; const char* B; unsigned lda2, ldb2;
    __device__ __forceinline__ const char* a_ptr(const pg8::Unit& u) const { return A + (size_t)(tab[33 + u.z] + u.pm * 256) * lda2; }
    __device__ __forceinline__ const char* b_ptr(const pg8::Unit& u) const { return B + ((size_t)u.z * 2048 + (size_t)u.pn * 256) * ldb2; }
    __device__ __forceinline__ void a_off(const pg8::Unit&, const int (&)[2], const int (&)[2], unsigned (&)[2][2]) const {}
};
struct EpiGU {
    static constexpr bool PERM = true;
    bf16* ACT; const int* list; const float* RINV; LAS int* tab;
    __device__ __forceinline__ void operator()(const f32x4 (&acc)[2][2][4][2], const Unit& u, int wr, int wc, int fr, int fq) const {
        const int ce = tab[66 + u.z], ps = tab[33 + u.z], r0 = u.pm * 256 + wr * 64 + fr, c0 = u.pn * 128 + wc * 16 + 4 * fq;
#pragma unroll
        for (int ai = 0; ai < 2; ++ai)
#pragma unroll
            for (int m = 0; m < 4; ++m) { const int r = r0 + ai * 128 + m * 16;
                if (r < ce) { const float rv = RINV[list[(size_t)u.z * T + r] >> 1];
#pragma unroll
                    for (int bj = 0; bj < 2; ++bj) { f32x4 gt = acc[ai][bj][m][0] * rv, up = acc[ai][bj][m][1] * rv;
#pragma unroll
                        for (int j = 0; j < 4; ++j) gt[j] = gt[j] * fsigm(gt[j]) * up[j];
                        v2u o; o.x = cvt_pk_bf16(gt[0], gt[1]); o.y = cvt_pk_bf16(gt[2], gt[3]);
                        *(v2u*)(ACT + (size_t)(ps + r) * FE + c0 + bj * 64) = o; } } }
    }
};
struct EpiDN {
    static constexpr bool PERM = true;
    bf16* MOE; const int* list; const float* wgt; LAS int* tab;
    __device__ __forceinline__ void operator()(const f32x4 (&acc)[2][2][4][2], const Unit& u, int wr, int wc, int fr, int fq) const {
        const int ce = tab[66 + u.z], r0 = u.pm * 256 + wr * 64 + fr, c0 = u.pn * 256 + wc * 32 + 8 * fq;
#pragma unroll
        for (int ai = 0; ai < 2; ++ai)
#pragma unroll
            for (int m = 0; m < 4; ++m) { const int r = r0 + ai * 128 + m * 16;
                if (r < ce) { const int code = list[(size_t)u.z * T + r]; const float w = wgt[code]; bf16* dst = MOE + ((size_t)(code & 1) * T + (code >> 1)) * D + c0;
#pragma unroll
                    for (int bj = 0; bj < 2; ++bj) *(v4u*)(dst + bj * 128) = pack8(acc[ai][bj][m][0] * w, acc[ai][bj][m][1] * w); } }
    }
};
struct EpiPP {
    static constexpr bool PERM = false;
    bf16* PP;
    __device__ __forceinline__ void operator()(const f32x4 (&acc)[2][2][4][2], const Unit& u, int wr, int wc, int fr, int fq) const {
        const int row0 = u.pm * 256 + wr * 64 + fr, col0 = u.pn * 256 + wc * 32 + 4 * fq;
#pragma unroll
        for (int ai = 0; ai < 2; ++ai)
#pragma unroll
            for (int m = 0; m < 4; ++m) { const size_t off = (size_t)(row0 + ai * 128 + m * 16) * D + col0;
#pragma unroll
                for (int bj = 0; bj < 2; ++bj)
#pragma unroll
                    for (int n = 0; n < 2; ++n) { const f32x4 a = acc[ai][bj][m][n]; v2u o; o.x = cvt_pk_bf16(a[0], a[1]); o.y = cvt_pk_bf16(a[2], a[3]); *(v2u*)(PP + off + bj * 128 + n * 16) = o; } }
    }
};
struct EpiPle {
    static constexpr bool PERM = false;
    const bf16* PP; const float* RINV; float* O; float* SS;
    __device__ __forceinline__ void operator()(const f32x4 (&acc)[2][2][4][2], const Unit& u, int wr, int wc, int fr, int fq) const {
        const int row0 = u.pm * 256 + wr * 64 + fr, col0 = u.pn * 256 + wc * 32 + 4 * fq;
#pragma unroll
        for (int ai = 0; ai < 2; ++ai)
#pragma unroll
            for (int m = 0; m < 4; ++m) { const int row = row0 + ai * 128 + m * 16; const size_t off = (size_t)row * D + col0; const float rv = RINV[row]; float s = 0.f;
#pragma unroll
                for (int bj = 0; bj < 2; ++bj)
#pragma unroll
                    for (int n = 0; n < 2; ++n) { const v2u pw = *(const v2u*)(PP + off + bj * 128 + n * 16); const f32x4 pp = (f32x4){bf_lo(pw.x), bf_hi(pw.x), bf_lo(pw.y), bf_hi(pw.y)};
                        f32x4 x = *(const f32x4*)(O + off + bj * 128 + n * 16); const f32x4 a = acc[ai][bj][m][n] * rv;
#pragma unroll
                        for (int j = 0; j < 4; ++j) { x[j] += fsigm(a[j]) * pp[j]; s += x[j] * x[j]; }
                        *(f32x4*)(O + off + bj * 128 + n * 16) = x; asm volatile("" ::: "memory"); }
                s += __shfl_xor(s, 16); s += __shfl_xor(s, 32);
                if (fq == 0) atomicAdd(SS + row, s);
                asm volatile("" ::: "memory"); }
    }
};
__device__ __forceinline__ void combine_row(int lane, float* xrow, const bf16* m0, const bf16* m1, const float* w, bf16* hrow, float* rinv) {
    float s = 0.f;
#pragma unroll
    for (int j = 0; j < 4; ++j) { const int c = (lane + 64 * j) * 8;
        f32x4 a = *(const f32x4*)(xrow + c), b = *(const f32x4*)(xrow + c + 4); f32x4 p0, p1, q0, q1; unpack8(*(const v4u*)(m0 + c), p0, p1); unpack8(*(const v4u*)(m1 + c), q0, q1);
        a += p0 + q0; b += p1 + q1; *(f32x4*)(xrow + c) = a; *(f32x4*)(xrow + c + 4) = b;
        s += (a[0] * a[0] + a[1] * a[1]) + (a[2] * a[2] + a[3] * a[3]) + (b[0] * b[0] + b[1] * b[1]) + (b[2] * b[2] + b[3] * b[3]);
        const f32x4 w0 = *(const f32x4*)(w + c), w1 = *(const f32x4*)(w + c + 4); *(v4u*)(hrow + c) = pack8(a * w0, b * w1); }
    s = wave_sum(s); if (lane == 0) *rinv = rsqrtf(s * (1.f / D) + EPS);
}
__device__ __forceinline__ void final_row(int lane, float* xrow, float ss, const float* w) {
    const float r = rsqrtf(ss * (1.f / D) + EPS);
#pragma unroll
    for (int j = 0; j < 8; ++j) { const int c = (lane + 64 * j) * 4; const f32x4 a = *(const f32x4*)(xrow + c), ww = *(const f32x4*)(w + c); *(f32x4*)(xrow + c) = a * r * ww; }
}

__device__ __forceinline__ void s5_scan(Frame& F, int job, const float* EST, const float* LAMT, bf16* UA) {
    const int g = job >> 2, pq = job & 3, pl = F.tid & 15, seg = F.tid >> 4, p = pq * 16 + pl;
    const float l16r = LAMT[(g * 64 + p) * 4 + 0], l16i = LAMT[(g * 64 + p) * 4 + 1], lsr = LAMT[(g * 64 + p) * 4 + 2], lsi = LAMT[(g * 64 + p) * 4 + 3];
    float er[32], ei[32];
    const float* e0 = EST + ((size_t)g * S5NC + seg * 32) * 128 + p;
#pragma unroll
    for (int i = 0; i < 32; ++i) { er[i] = e0[(size_t)i * 128]; ei[i] = e0[(size_t)i * 128 + 64]; }
    float sr = 0.f, si = 0.f;
#pragma unroll
    for (int i = 0; i < 32; ++i) { const float nr = l16r * sr - l16i * si + er[i], ni = l16r * si + l16i * sr + ei[i]; sr = nr; si = ni; }
    LAS float* SE = (LAS float*)F.lds;
    __syncthreads();
    SE[(seg * 16 + pl) * 2] = sr; SE[(seg * 16 + pl) * 2 + 1] = si;
    __syncthreads();
    sr = 0.f; si = 0.f;
    for (int s2 = 0; s2 < seg; ++s2) { const float ar = SE[(s2 * 16 + pl) * 2], ai = SE[(s2 * 16 + pl) * 2 + 1]; const float nr = lsr * sr - lsi * si + ar, ni = lsr * si + lsi * sr + ai; sr = nr; si = ni; }
    bf16* o = UA + ((size_t)g * S5NC + seg * 32) * S5K + 256 + p;
#pragma unroll
    for (int i = 0; i < 32; ++i) { o[(size_t)i * S5K] = (bf16)(cvt_pk_bf16(sr, sr) & 0xffffu); o[(size_t)i * S5K + 64] = (bf16)(cvt_pk_bf16(si, si) & 0xffffu);
        const float nr = l16r * sr - l16i * si + er[i], ni = l16r * si + l16i * sr + ei[i]; sr = nr; si = ni; }
    __syncthreads();
}
__device__ __forceinline__ void ret_scan(Frame& F, int job, float* KVS) {
    const int idx = job * 512 + F.tid;
    const int h = idx >> 14; const float cd8 = __builtin_amdgcn_exp2f(log2f(1.f - exp2f(-5.f - (float)h)) * 512.f);
    float v[RSC];
#pragma unroll
    for (int s = 0; s < RSC; ++s) v[s] = KVS[(size_t)s * NH * DH * DH + idx];
    float st = 0.f;
#pragma unroll
    for (int s = 0; s < RSC; ++s) { const float t = v[s]; KVS[(size_t)s * NH * DH * DH + idx] = st; st = st * cd8 + t; }
}

struct Args { const float* in[30]; float* out; unsigned char* ws; int ph_lo, ph_hi; };
enum { I_X = 0, I_P, I_NMIX, I_WIN, I_GNW, I_LRE, I_LIM, I_LDT, I_BRE, I_BIM, I_CRE, I_CIM, I_SD, I_WGLU, I_WA, I_WB, I_WMERGE, I_WOUT, I_NFFN, I_WRG, I_BRG, I_WRE, I_BRE2, I_WEG, I_WEU, I_WED, I_NPLE, I_WPG, I_WPLE, I_NF };

__global__ void __launch_bounds__(NWAVES * 64, 2) mk_fwd(Args args) {
    extern __shared__ __attribute__((aligned(16))) unsigned char lds_raw[];
    Frame F;
    F.lds = (LAS unsigned char*)lds_raw;
    F.MISC = (volatile LAS unsigned*)(F.lds + MISC_OFF);
    F.tid = threadIdx.x; F.lane = F.tid & 63; F.wave = __builtin_amdgcn_readfirstlane(F.tid >> 6); F.G = gridDim.x;
    unsigned char* ws = args.ws;
    F.ctl = (unsigned*)(ws + WS_CTL);
    for (int u = F.tid; u < (LDS_BYTES - LDSCTL_OFF) / 4; u += NWAVES * 64) ((LAS unsigned*)(F.lds + LDSCTL_OFF))[u] = 0u;
    __syncthreads();
    const int lo = args.ph_lo, hi = args.ph_hi;
    const bool fused = (hi - lo) > 1;
    XcdBarrier bar; bar.bar = F.ctl + CW_BAR; bar.x = 0; bar.st = nullptr;
    if (fused) bar = xcd_barrier_post(F.ctl + CW_BAR, F.MISC + 8);
#ifndef PH_MASK
#define PH_MASK 0xffffffffu
#endif
#define IN(k) (((PH_MASK >> (k)) & 1u) && lo <= (k) && (k) < hi)
#define SEAM(k) do { if (IN(k) && IN((k) + 1)) xcd_barrier(bar); } while (0)
    bf16* WT1 = (bf16*)(ws + WS_WT1); bf16* WGLU = (bf16*)(ws + WS_WGLU); bf16* WA = (bf16*)(ws + WS_WA); bf16* WB = (bf16*)(ws + WS_WB); bf16* WOUT = (bf16*)(ws + WS_WOUT);
    bf16* WPG = (bf16*)(ws + WS_WPG); bf16* WP = (bf16*)(ws + WS_WP); bf16* BTC = (bf16*)(ws + WS_BTC); bf16* BLT = (bf16*)(ws + WS_BLT);
    bf16* HB = (bf16*)(ws + WS_HB); bf16* YRET = (bf16*)(ws + WS_YRET); bf16* YPRE = (bf16*)(ws + WS_YPRE); bf16* QKVG = (bf16*)(ws + WS_Q); bf16* UA = (bf16*)(ws + WS_UA);
    float* EST = (float*)(ws + WS_EST); float* KVS = (float*)(ws + WS_KVS); bf16* MERGED = (bf16*)(ws + WS_MERGED); bf16* YSSM = (bf16*)(ws + WS_YSSM); bf16* PB = (bf16*)(ws + WS_PB);
    float* COS = (float*)(ws + WS_COS); float* SIN = (float*)(ws + WS_SIN); float* LAMT = (float*)(ws + WS_LAM);
    bf16* GATES = (bf16*)args.out;

    if (IN(0)) {
        constexpr int I_S5 = 64;
        constexpr int I_WIN8 = (D / 64) * (INC / 32) / 8, I_WMG8 = (D / 64) * (4096 / 32) / 8, I_GLU8 = (RW / 64) * (RW / 32) / 8, I_WA8 = (RW / 64) * (D / 32) / 8, I_WO8 = (D / 64) * (D / 32) / 8, I_WPL8 = (PLE / 64) * (D / 32) / 8;
        constexpr int I_H = T / 64, I_PB = 256, I_ROPE = 256;
        constexpr int B0 = 0, B1 = B0 + I_S5, B2 = B1 + I_WIN8, B3 = B2 + I_WMG8, B4 = B3 + I_GLU8, B5 = B4 + I_WA8, B6 = B5 + I_WA8, B7 = B6 + I_WO8, B8 = B7 + I_WO8, B9 = B8 + I_WPL8, B10 = B9 + I_H, B11 = B10 + I_PB, B12 = B11 + I_ROPE, B13 = B12 + 1, B14 = B13 + 24;
        LAS float* scr = (LAS float*)(F.lds + RING_OFF + F.wave * 8704);
        for (;;) {
            const int it = wg_next_item(F, F.ctl + CW_Q0);
            if (it >= B14) break;
            if (it < B1) { s5_tables(F, it, args.in[I_LRE], args.in[I_LIM], args.in[I_LDT], args.in[I_BRE], args.in[I_BIM], args.in[I_CRE], args.in[I_CIM], args.in[I_SD], BTC, BLT, LAMT); }
            else if (it < B2) transpose_item<0>(args.in[I_WIN], D, INC, WT1, D, 0, scr, (it - B1) * 8 + F.wave, F.lane);
            else if (it < B3) transpose_item<0>(args.in[I_WMERGE], D, 4096, WT1, D, INC, scr, (it - B2) * 8 + F.wave, F.lane);
            else if (it < B4) transpose_item<0>(args.in[I_WGLU], RW, RW, WGLU, RW, 0, scr, (it - B3) * 8 + F.wave, F.lane);
            else if (it < B5) transpose_item<0>(args.in[I_WA], RW, D, WA, RW, 0, scr, (it - B4) * 8 + F.wave, F.lane);
            else if (it < B6) transpose_item<0>(args.in[I_WB], RW, D, WB, RW, 0, scr, (it - B5) * 8 + F.wave, F.lane);
            else if (it < B7) transpose_item<0>(args.in[I_WOUT], D, D, WOUT, D, 0, scr, (it - B6) * 8 + F.wave, F.lane);
            else if (it < B8) transpose_item<0>(args.in[I_WPG], D, D, WPG, D, 0, scr, (it - B7) * 8 + F.wave, F.lane);
            else if (it < B9) transpose_item<0>(args.in[I_WPLE], PLE, D, WP, PLE, 0, scr, (it - B8) * 8 + F.wave, F.lane);
            else if (it < B10) { const int r0 = (it - B9) * 64 + F.wave * 8;
                for (int r = 0; r < 8; ++r) rms_row_to_bf16(F.lane, args.in[I_X] + (size_t)(r0 + r) * D, args.in[I_NMIX], HB + (size_t)(r0 + r) * D); }
            else if (it < B11) { const size_t e0 = (size_t)(it - B10) * 16384 + F.tid * 8;
#pragma unroll
                for (int k = 0; k < 4; ++k) { const size_t e = e0 + (size_t)k * 4096; const f32x4 a = *(const f32x4*)(args.in[I_P] + e), b = *(const f32x4*)(args.in[I_P] + e + 4); *(v4u*)(PB + e) = pack8(a, b); } }
            else if (it < B12) { const int t0 = (it - B11) * 64;
#pragma unroll
                for (int k = 0; k < 8; ++k) { const int idx = k * 512 + F.tid, t = t0 + (idx >> 6), j = idx & 63; const double inv = exp2(-(double)j * (13.287712379549449 / 64.0));
                    double sn, cs; sincos((double)t * inv, &sn, &cs); COS[(size_t)t * 64 + j] = (float)cs; SIN[(size_t)t * 64 + j] = (float)sn; } }
            else if (it >= B13) router_weights_item(F, it - B13, args.in[I_NFFN], args.in[I_WRG], args.in[I_WRE], (bf16*)(ws + WS_WR), (bf16*)(ws + WS_WR) + 48 * D);
            else { for (int i = F.tid; i < 128 * 256 / 8; i += 512) *(v4u*)(BLT + (size_t)SG * 128 * 256 + (size_t)i * 8) = (v4u){0u, 0u, 0u, 0u}; }
        }
    }
    SEAM(0);
    if (IN(1)) {
        pg8::SchedPlain S; S.init(HB, D, WT1, D, T, N1, F.G, (int)blockIdx.x);
        EpiProj E{QKVG, UA, GATES};
        pg8::gemm_phase<EpiProj, pg8::SchedPlain>(F.lds + RING_OFF, D, S, E);
    }
    SEAM(1);
    RetCtx RC{QKVG, QKVG + (size_t)T * RW, QKVG + (size_t)2 * T * RW, QKVG + (size_t)3 * T * RW, COS, SIN, args.in[I_GNW], KVS, YRET};
    if (IN(2)) {
        pg8::SchedBatch S; S.A = (const char*)UA; S.B = (const char*)BLT; S.lda2 = S5K * 2; S.ldb2 = 256 * 2; S.sA = (size_t)S5NC * S5K * 2; S.sB = (size_t)128 * 256 * 2; S.nMz = S5NC / 256; S.nz = SG; S.G = F.G; S.c = (int)blockIdx.x;
        EpiS5A E{EST};
        pg8::gemm_phase<EpiS5A, pg8::SchedBatch>(F.lds + RING_OFF, 256, S, E);
        for (int job = blockIdx.x; job < RSC * NH; job += F.G) ret_pass_a(F, RC, job);
    }
    SEAM(2);
    if (IN(3)) {
        for (int job = blockIdx.x; job < SG * 4; job += F.G) s5_scan(F, job, EST, LAMT, UA);
        for (int job = blockIdx.x; job < NH * DH * DH / 512; job += F.G) ret_scan(F, job, KVS);
    }
    SEAM(3);
    if (IN(4)) {
        pg8::SchedBatch S; S.A = (const char*)UA; S.B = (const char*)BTC; S.lda2 = S5K * 2; S.ldb2 = S5K * 2; S.sA = (size_t)S5NC * S5K * 2; S.sB = (size_t)256 * S5K * 2; S.nMz = S5NC / 256; S.nz = SG; S.G = F.G; S.c = (int)blockIdx.x;
        EpiS5C E{YPRE};
#ifndef P4_NOGEMM
        pg8::gemm_phase<EpiS5C, pg8::SchedBatch>(F.lds + RING_OFF, S5K, S, E);
#endif
#ifndef P4_NORET
        for (int job = blockIdx.x; job < RSC * NH; job += F.G) ret_pass_c(F, RC, job);
#endif
    }
    SEAM(4);
    if (IN(5)) {
        pg8::SchedPlain S; S.init(YPRE, RW, WGLU, RW, T, RW, F.G, (int)blockIdx.x);
        EpiGlu E{YPRE, YSSM};
        pg8::gemm_phase<EpiGlu, pg8::SchedPlain>(F.lds + RING_OFF, RW, S, E);
    }
    SEAM(5);
    if (IN(6)) {
        pg8::SchedTwoPass S; S.A0 = (const char*)YRET; S.A1 = (const char*)YSSM; S.B0 = (const char*)WA; S.B1 = (const char*)WB; S.lda2 = RW * 2; S.ldb2 = RW * 2; S.nM = T / 256; S.nN = D / 256; S.G = F.G; S.c = (int)blockIdx.x;
        EpiMerge E{GATES, MERGED};
        pg8::gemm_phase<EpiMerge, pg8::SchedTwoPass>(F.lds + RING_OFF, RW, S, E);
    }
    SEAM(6);
    if (IN(7)) {
        pg8::SchedPlain S; S.init(MERGED, D, WOUT, D, T, D, F.G, (int)blockIdx.x);
        EpiOut E{args.in[I_X], args.out};
        pg8::gemm_phase<EpiOut, pg8::SchedPlain>(F.lds + RING_OFF, D, S, E);
    }
    SEAM(7);
    bf16* WRH = (bf16*)(ws + WS_WR); bf16* WRL = WRH + 48 * D; bf16* WGU = (bf16*)(ws + WS_WGU); bf16* WDN = (bf16*)(ws + WS_WDN); bf16* ACT = (bf16*)(ws + WS_ACT); bf16* MOE = (bf16*)(ws + WS_MOE); bf16* PP = (bf16*)(ws + WS_PP);
    int* LIST = (int*)(ws + WS_LIST); float* WGT = (float*)(ws + WS_WGT); float* RINV = (float*)(ws + WS_RINV); float* RINV3 = RINV + T; float* SS = (float*)(F.ctl + CW_SS);
    unsigned* CNT = F.ctl + CW_CNT;
    if (IN(8)) {
        constexpr int I_RT = T / 128, I_EW = 32 * 3 * 64;
        LAS float* scr = (LAS float*)(F.lds + RING_OFF + 32768 + F.wave * 8704);
        for (;;) {
            const int it = wg_next_item(F, F.ctl + CW_Q1);
            if (it >= I_RT + I_EW) break;
            if (it < I_RT) router_job(F, it * 8 + F.wave, args.out, args.in[I_NFFN], WRH, WRL, args.in[I_BRG], args.in[I_BRE2], HB, RINV, CNT, LIST, WGT);
            else { const int q = it - I_RT, e = q / 192, r = q % 192, mtx = r / 64, sub = (r % 64) * 8 + F.wave;
                if (mtx == 0) transpose_item<1>(args.in[I_WEG] + (size_t)e * D * FE, D, FE, WGU + (size_t)e * 1024 * D, D, 0, scr, sub, F.lane);
                else if (mtx == 1) transpose_item<2>(args.in[I_WEU] + (size_t)e * D * FE, D, FE, WGU + (size_t)e * 1024 * D, D, 0, scr, sub, F.lane);
                else transpose_item<0>(args.in[I_WED] + (size_t)e * FE * D, FE, D, WDN + (size_t)e * D * FE, FE, 0, scr, sub, F.lane); }
        }
    }
    SEAM(8);
    if (IN(9)) {
        moe_tables<4>(F, CNT);
        SchedGU S; S.tab = (LAS int*)(F.lds + MOE_TAB_OFF); S.G = F.G; S.c = (int)blockIdx.x; S.A = (const char*)HB; S.B = (const char*)WGU; S.list = LIST; S.lda2 = D * 2; S.ldb2 = D * 2;
        EpiGU E{ACT, LIST, RINV, S.tab};
        pg8::gemm_phase<EpiGU, SchedGU>(F.lds + RING_OFF, D, S, E);
    }
    SEAM(9);
    if (IN(10)) {
        moe_tables<8>(F, CNT);
        SchedDN S; S.tab = (LAS int*)(F.lds + MOE_TAB_OFF); S.G = F.G; S.c = (int)blockIdx.x; S.A = (const char*)ACT; S.B = (const char*)WDN; S.lda2 = FE * 2; S.ldb2 = FE * 2;
        EpiDN E{MOE, LIST, WGT, S.tab};
        pg8::gemm_phase<EpiDN, SchedDN>(F.lds + RING_OFF, FE, S, E);
    }
    SEAM(10);
    if (IN(11)) {
        for (int row = blockIdx.x * NWAVES + F.wave; row < T; row += F.G * NWAVES)
            combine_row(F.lane, args.out + (size_t)row * D, MOE + (size_t)row * D, MOE + ((size_t)T + row) * D, args.in[I_NPLE], HB + (size_t)row * D, RINV3 + row);
    }
    SEAM(11);
    if (IN(12)) {
#ifndef P12_NOPP
        { pg8::SchedPlain S; S.init(PB, PLE, WP, PLE, T, D, F.G, (int)blockIdx.x); EpiPP E{PP}; pg8::gemm_phase<EpiPP, pg8::SchedPlain>(F.lds + RING_OFF, PLE, S, E); }
#endif
#ifndef P12_NOGATE
        { pg8::SchedPlain S; S.init(HB, D, WPG, D, T, D, F.G, (int)blockIdx.x); EpiPle E{PP, RINV3, args.out, SS}; pg8::gemm_phase<EpiPle, pg8::SchedPlain>(F.lds + RING_OFF, D, S, E); }
#endif
    }
    SEAM(12);
    if (IN(13)) {
        for (int row = blockIdx.x * NWAVES + F.wave; row < T; row += F.G * NWAVES)
            final_row(F.lane, args.out + (size_t)row * D, __hip_atomic_load(SS + row, RLX_AGENT), args.in[I_NF]);
    }
#undef IN
#undef SEAM
}

#ifndef RUN_HI
#define RUN_HI 14
#endif
extern "C" void kernel_launch(void* const* d_in, const int* in_sizes, int n_in, void* d_out, int out_size, void* d_ws, size_t ws_size, hipStream_t stream) {
    static int grid = 0;
    if (grid == 0) {
        if (n_in != 30 || ws_size < WS_END2) { fprintf(stderr, "kernel_launch: unexpected n_in %d / ws %zu\n", n_in, ws_size); grid = -1; return; }
        int dev = 0, cus = 0;
        if (hipGetDevice(&dev) != hipSuccess || hipDeviceGetAttribute(&cus, hipDeviceAttributeMultiprocessorCount, dev) != hipSuccess) { grid = -1; return; }
        if (hipFuncSetAttribute((const void*)mk_fwd, hipFuncAttributeMaxDynamicSharedMemorySize, LDS_BYTES) != hipSuccess) { fprintf(stderr, "kernel_launch: hipFuncSetAttribute failed\n"); grid = -1; return; }
        grid = cus;
    }
    if (grid < 0) return;
    (void)hipMemsetAsync((char*)d_ws + WS_CTL, 0, CTL_ZERO_BYTES, stream);
    Args a{};
    for (int i = 0; i < 30; ++i) a.in[i] = (const float*)d_in[i];
    a.out = (float*)d_out; a.ws = (unsigned char*)d_ws;
    a.ph_lo = 0; a.ph_hi = RUN_HI; hipLaunchKernelGGL(mk_fwd, dim3(grid), dim3(NWAVES * 64), LDS_BYTES, stream, a);
}
```

```cpp
#define REP_MASK 0x0
#include <hip/hip_runtime.h>
#include <math.h>
#include <stdio.h>
#include <stdint.h>
namespace pg8 {
#define PG8_LAS __attribute__((address_space(3)))
typedef unsigned short bf16_t;
typedef short bf16x8 __attribute__((ext_vector_type(8)));
typedef float f32x4 __attribute__((ext_vector_type(4)));
typedef float f32x2 __attribute__((ext_vector_type(2)));
typedef unsigned u32x4 __attribute__((ext_vector_type(4)));
typedef unsigned u32x2 __attribute__((ext_vector_type(2)));
constexpr int BM = 256, BK = 64, HALF = 128, HTB = HALF * BK * 2  , STAGE_BYTES = 8 * HTB, NXCD = 8, WGM = 8;

__host__ __device__ __forceinline__ int lds_byte(int r, int c) { const int st = (r >> 4) * 2 + (c >> 5), rr = r & 15, cc = c & 31, ob = rr * 64 + cc * 2; return st * 1024 + (ob ^ (((ob >> 9) & 1) << 5)); }
__host__ __device__ __forceinline__ void stage_rc(int b, int& R, int& C) { const int st = b / 1024, sb = b % 1024, swz = sb ^ (((sb >> 9) & 1) << 5); R = (st >> 1) * 16 + swz / 64; C = (st & 1) * 32 + (swz % 64) / 2; }
__host__ __device__ __forceinline__ int perm32(int rho) { const int n = rho >> 4, i = rho & 15; return 8 * (i >> 2) + 4 * n + (i & 3); }

struct Unit { int pm, pn, z; };
__device__ __forceinline__ const char* uptr(const char* p) {
    const unsigned long long v = (unsigned long long)p; const unsigned lo = __builtin_amdgcn_readfirstlane((unsigned)v), hi = __builtin_amdgcn_readfirstlane((unsigned)(v >> 32));
    return (const char*)(((unsigned long long)hi << 32) | lo); }

__device__ __forceinline__ void tile_of(int L, int nM, int nN, int& pm, int& pn) {
    const int nwg = nM * nN; int wgid = L; { const int q = nwg / NXCD, r = nwg % NXCD, xcd = wgid % NXCD, off = wgid / NXCD; wgid = (xcd < r ? xcd * (q + 1) : r * (q + 1) + (xcd - r) * q) + off; }
    const int nig = WGM * nN, gid = wgid / nig, fm = gid * WGM, gsz = (nM - fm) < WGM ? (nM - fm) : WGM;
    pm = fm + ((wgid % nig) % gsz); pn = (wgid % nig) / gsz;
}
struct SchedPlain {
    static constexpr bool GATHER = false;
    const char* A; const char* B; unsigned lda2, ldb2; int nM, nN, G, c, rep, i0, icnt;
    __device__ __forceinline__ void init(const void* A_, int lda, const void* B_, int ldb, int M, int N, int G_, int c_) { A = (const char*)A_; B = (const char*)B_; lda2 = lda * 2; ldb2 = ldb * 2; nM = M / BM; nN = N / BM; G = G_; c = c_; i0 = 0; icnt = 1 << 30; rep = 1; }
    __device__ __forceinline__ bool next(int i, Unit& u) const { if (i >= icnt) return false; int L = (i + i0) * G + c; if (L >= nM * nN * rep) return false; u.z = 0; if (L >= nM * nN) { L -= nM * nN; u.z = 1; } tile_of(L, nM, nN, u.pm, u.pn); return true; }
    __device__ __forceinline__ const char* a_ptr(const Unit& u) const { return A + (size_t)u.pm * BM * lda2; }
    __device__ __forceinline__ const char* b_ptr(const Unit& u) const { return B + (size_t)u.pn * BM * ldb2; }
    __device__ __forceinline__ void a_off(const Unit&, const int (&R)[2], const int (&C)[2], unsigned (&v)[2][2]) const {
#pragma unroll
        for (int h = 0; h < 2; ++h)
#pragma unroll
            for (int i = 0; i < 2; ++i) v[h][i] = (unsigned)(h * HALF + R[i]) * lda2 + (unsigned)C[i] * 2u; }
};
template <int NM, int NN> struct SchedPlainC {
    static constexpr bool GATHER = false;
    const char* A; const char* B; unsigned lda2, ldb2; int G, c, rep;
    __device__ __forceinline__ bool next(int i, Unit& u) const { int L = i * G + c; if (L >= NM * NN * rep) return false; u.z = 0; if (L >= NM * NN) { L -= NM * NN; u.z = 1; } tile_of(L, NM, NN, u.pm, u.pn); return true; }
    __device__ __forceinline__ const char* a_ptr(const Unit& u) const { return A + (size_t)u.pm * BM * lda2; }
    __device__ __forceinline__ const char* b_ptr(const Unit& u) const { return B + (size_t)u.pn * BM * ldb2; }
    __device__ __forceinline__ void a_off(const Unit&, const int (&)[2], const int (&)[2], unsigned (&)[2][2]) const {}
};
struct SchedBatch {
    static constexpr bool GATHER = false;
    const char* A; const char* B; unsigned lda2, ldb2; size_t sA, sB; int nMz, nz, G, c, rep;
    __device__ __forceinline__ bool next(int i, Unit& u) const { int L = i * G + c; if (L >= nMz * nz * rep) return false; if (L >= nMz * nz) L -= nMz * nz; u.z = L >> 2; u.pm = L & 3; u.pn = 0; return true; }
    __device__ __forceinline__ const char* a_ptr(const Unit& u) const { return A + (size_t)u.z * sA + (size_t)u.pm * BM * lda2; }
    __device__ __forceinline__ const char* b_ptr(const Unit& u) const { return B + (size_t)u.z * sB; }
    __device__ __forceinline__ void a_off(const Unit&, const int (&R)[2], const int (&C)[2], unsigned (&v)[2][2]) const {
#pragma unroll
        for (int h = 0; h < 2; ++h)
#pragma unroll
            for (int i = 0; i < 2; ++i) v[h][i] = (unsigned)(h * HALF + R[i]) * lda2 + (unsigned)C[i] * 2u; }
};
struct SchedTwoPass {
    static constexpr bool GATHER = false;
    const char* A0; const char* A1; const char* B0; const char* B1; unsigned lda2, ldb2; int nM, nN, G, c, rep;
    __device__ __forceinline__ bool next(int i, Unit& u) const { int L = (i >> 1) * G + c; if (L >= nM * nN * rep) return false; if (L >= nM * nN) L -= nM * nN; tile_of(L, nM, nN, u.pm, u.pn); u.z = i & 1; return true; }
    __device__ __forceinline__ const char* a_ptr(const Unit& u) const { return (u.z ? A1 : A0) + (size_t)u.pm * BM * lda2; }
    __device__ __forceinline__ const char* b_ptr(const Unit& u) const { return (u.z ? B1 : B0) + (size_t)u.pn * BM * ldb2; }
    __device__ __forceinline__ void a_off(const Unit&, const int (&R)[2], const int (&C)[2], unsigned (&v)[2][2]) const {
#pragma unroll
        for (int h = 0; h < 2; ++h)
#pragma unroll
            for (int i = 0; i < 2; ++i) v[h][i] = (unsigned)(h * HALF + R[i]) * lda2 + (unsigned)C[i] * 2u; }
};

typedef float f32x2_t __attribute__((ext_vector_type(2))); typedef __bf16 bf16x2_t __attribute__((ext_vector_type(2)));
__device__ __forceinline__ unsigned cvt_pk_bf16(float lo, float hi) { f32x2_t v = {lo, hi}; bf16x2_t b = __builtin_convertvector(v, bf16x2_t); return __builtin_bit_cast(unsigned, b); }
__device__ __forceinline__ float bf_lo(unsigned w) { return __uint_as_float(w << 16); }
__device__ __forceinline__ float bf_hi(unsigned w) { return __uint_as_float(w & 0xffff0000u); }
__device__ __forceinline__ float fsigm(float x) { return __builtin_amdgcn_rcpf(1.f + __builtin_amdgcn_exp2f(-1.4426950408889634f * x)); }
__device__ __forceinline__ u32x4 pack8(const f32x4& a, const f32x4& b) { u32x4 w; w.x = cvt_pk_bf16(a[0], a[1]); w.y = cvt_pk_bf16(a[2], a[3]); w.z = cvt_pk_bf16(b[0], b[1]); w.w = cvt_pk_bf16(b[2], b[3]); return w; }
__device__ __forceinline__ void unpack8(const u32x4& w, f32x4& a, f32x4& b) { a = (f32x4){bf_lo(w.x), bf_hi(w.x), bf_lo(w.y), bf_hi(w.y)}; b = (f32x4){bf_lo(w.z), bf_hi(w.z), bf_lo(w.w), bf_hi(w.w)}; }

typedef float f32x8 __attribute__((ext_vector_type(8)));
struct AccView4 { const f32x4 (&a)[2][2][4][2]; __device__ __forceinline__ f32x4 operator()(int ai, int bj, int m, int n) const { return a[ai][bj][m][n]; } };
struct AccView8 { const f32x8 (&a)[2][2][4];    __device__ __forceinline__ f32x4 operator()(int ai, int bj, int m, int n) const { return n ? __builtin_shufflevector(a[ai][bj][m], a[ai][bj][m], 4, 5, 6, 7) : __builtin_shufflevector(a[ai][bj][m], a[ai][bj][m], 0, 1, 2, 3); } };
__device__ __forceinline__ void glds16s(const char* sbase, unsigned voff, unsigned lds_dst) { unsigned keep;
    asm volatile("s_mov_b32 %0, m0\n\ts_mov_b32 m0, %3\n\ts_nop 4\n\tglobal_load_lds_dwordx4 %1, %2\n\ts_mov_b32 m0, %0" : "=&s"(keep) : "v"(voff), "s"(sbase), "s"(lds_dst) : "memory"); }
typedef int v8i32 __attribute__((ext_vector_type(8)));
typedef int v4i32 __attribute__((ext_vector_type(4)));
template <class Epi, class Sched, bool ALIGN_EPI = true, bool FP8 = false, bool MID = false>
__device__ __forceinline__ void gemm_phase(PG8_LAS unsigned char* lds, const int K, const Sched& S, const Epi& E, const int wave_id) {
    int lane_ = (int)__builtin_amdgcn_mbcnt_hi(~0u, __builtin_amdgcn_mbcnt_lo(~0u, 0u)); asm volatile("" : "+v"(lane_));
    const int lane = lane_, wid = wave_id, tid = wid * 64 + lane, wr = wid >> 2, wc = wid & 3, fr = lane & 15, fq = lane >> 4;
    const int nt = FP8 ? K / 128 : K / BK;
    int Rr[2], Cc[2]; unsigned voffB[2], voffA[2];
#pragma unroll
    for (int i = 0; i < 2; ++i) { stage_rc(tid * 16 + i * 8192, Rr[i], Cc[i]); const int Rb = Epi::PERM ? ((Rr[i] & ~31) + perm32(Rr[i] & 31)) : Rr[i];
        voffB[i] = (unsigned)Rb * S.ldb2 + (unsigned)Cc[i] * 2u; voffA[i] = (unsigned)Rr[i] * S.lda2 + (unsigned)Cc[i] * 2u; }
    const size_t ah = (size_t)HALF * S.lda2;
    const size_t a64 = (size_t)64 * S.lda2, b64 = (size_t)64 * S.ldb2;
    const size_t kstep = (size_t)(BK * 2);
    const size_t bh = (size_t)HALF * S.ldb2;
    const unsigned ldsw = (unsigned)wid * 1024u;
    const int aoff = FP8 ? lds_byte(wr * 64 + fr, fq * 16) : lds_byte(wr * 64 + fr, fq * 8), boff = FP8 ? lds_byte(wc * 32 + fr, fq * 16) : lds_byte(wc * 32 + fr, fq * 8);
#define PG8_SA(b, h) (((b) * 2 + (h)) * HTB)
#define PG8_SB(b, h) ((4 + (b) * 2 + (h)) * HTB)
#define PG8_STAGE2(bufoff, gbase, voff, r64) do { if constexpr (FP8) { _Pragma("unroll") for (int _i = 0; _i < 2; ++_i) glds16s(uptr((const char*)(gbase) + (size_t)_i * (r64)), (voff)[0], (unsigned)(size_t)(lds + (bufoff) + ldsw + _i * 8192)); } else _Pragma("unroll") for (int _i = 0; _i < 2; ++_i) \
        __builtin_amdgcn_global_load_lds((const unsigned*)((const char*)(gbase) + (size_t)_i * (r64) + (voff)[0]), (PG8_LAS unsigned*)(lds + (bufoff) + ldsw + _i * 8192), 16, 0, 0); } while (0)
#define PG8_STAGE(bufoff, gbase, voff) do { if constexpr (FP8) { _Pragma("unroll") for (int _i = 0; _i < 2; ++_i) glds16s(uptr((const char*)(gbase)), (voff)[_i], (unsigned)(size_t)(lds + (bufoff) + ldsw + _i * 8192)); } else _Pragma("unroll") for (int _i = 0; _i < 2; ++_i) \
        __builtin_amdgcn_global_load_lds((const unsigned*)((const char*)(gbase) + (voff)[_i]), (PG8_LAS unsigned*)(lds + (bufoff) + ldsw + _i * 8192), 16, 0, 0); } while (0)
#define PG8_STAGE_A(bufoff, h, gbase, TB) do { if constexpr (Sched::GATHER) { unsigned _vg[2]; _vg[0] = (TB)[(h) * HALF + Rr[0]] + (unsigned)Cc[0] * 2u; _vg[1] = (TB)[(h) * HALF + Rr[0] + 64] + (unsigned)Cc[0] * 2u; PG8_STAGE(bufoff, gbase, _vg); } \
        else { PG8_STAGE2(bufoff, (gbase) + (h) * ah, voffA, a64); } } while (0)
#define PG8_STAGE_B(bufoff, gbase) PG8_STAGE2(bufoff, gbase, voffB, b64)
#define PG8_LDA(dst, b, h) do { if constexpr (FP8) { _Pragma("unroll") for (int m = 0; m < 4; ++m) dst##8[m] = PG8_LD8(lds + PG8_SA(b, h) + aoff + m * 2048); } else { _Pragma("unroll") for (int m = 0; m < 4; ++m) _Pragma("unroll") for (int k = 0; k < 2; ++k) dst[m][k] = *(const PG8_LAS bf16x8*)(lds + PG8_SA(b, h) + aoff + m * 2048 + k * 1024); } } while (0)
#define PG8_LDB(dst, b, h) do { if constexpr (FP8) { _Pragma("unroll") for (int n = 0; n < 2; ++n) dst##8[n] = PG8_LD8(lds + PG8_SB(b, h) + boff + n * 2048); } else { _Pragma("unroll") for (int n = 0; n < 2; ++n) _Pragma("unroll") for (int k = 0; k < 2; ++k) dst[n][k] = *(const PG8_LAS bf16x8*)(lds + PG8_SB(b, h) + boff + n * 2048 + k * 1024); } } while (0)
#define PG8_LD8(p) __builtin_shufflevector(*(const PG8_LAS v4i32*)(p), *(const PG8_LAS v4i32*)((p) + 16), 0, 1, 2, 3, 4, 5, 6, 7)
#define PG8_F8(x) __builtin_shufflevector(__builtin_bit_cast(v4i32, (x)[0]), __builtin_bit_cast(v4i32, (x)[1]), 0, 1, 2, 3, 4, 5, 6, 7)
#define PG8_MMA(ai, bj, At, Bt) do { __builtin_amdgcn_s_setprio(1); if constexpr (FP8) { _Pragma("unroll") for (int m = 0; m < 4; ++m) { \
        const f32x4 _r0 = __builtin_amdgcn_mfma_scale_f32_16x16x128_f8f6f4(Bt##8[0], At##8[m], __builtin_shufflevector(acc8[ai][bj][m], acc8[ai][bj][m], 0, 1, 2, 3), 0, 0, 0, 0, 0, 0); \
        const f32x4 _r1 = __builtin_amdgcn_mfma_scale_f32_16x16x128_f8f6f4(Bt##8[1], At##8[m], __builtin_shufflevector(acc8[ai][bj][m], acc8[ai][bj][m], 4, 5, 6, 7), 0, 0, 0, 0, 0, 0); \
        acc8[ai][bj][m] = __builtin_shufflevector(_r0, _r1, 0, 1, 2, 3, 4, 5, 6, 7); } } else { \
        _Pragma("unroll") for (int m = 0; m < 4; ++m) _Pragma("unroll") for (int n = 0; n < 2; ++n) _Pragma("unroll") for (int k = 0; k < 2; ++k) \
        acc[ai][bj][m][n] = __builtin_amdgcn_mfma_f32_16x16x32_bf16(Bt[n][k], At[m][k], acc[ai][bj][m][n], 0, 0, 0); } __builtin_amdgcn_s_setprio(0); } while (0)
#define PG8_WAIT_V(n) asm volatile("s_waitcnt vmcnt(" #n ")" ::: "memory")
#define PG8_WAIT_L(n) asm volatile("s_waitcnt lgkmcnt(" #n ")" ::: "memory")
#define PG8_BAR __builtin_amdgcn_s_barrier()
#define PG8_SCHED __builtin_amdgcn_sched_barrier(0)
    Unit cur, nxt; int ui = 0;
    if (!S.next(0, cur)) return;
    cur.pm = __builtin_amdgcn_readfirstlane(cur.pm); cur.pn = __builtin_amdgcn_readfirstlane(cur.pn); cur.z = __builtin_amdgcn_readfirstlane(cur.z);
    f32x8 acc8[2][2][4];
    f32x4 acc[2][2][4][2];
#pragma unroll
    for (int a = 0; a < 2; ++a)
#pragma unroll
        for (int b = 0; b < 2; ++b)
#pragma unroll
            for (int m = 0; m < 4; ++m)
#pragma unroll
                for (int n = 0; n < 2; ++n) { acc[a][b][m][n] = (f32x4){0.f, 0.f, 0.f, 0.f}; acc8[a][b][m] = (f32x8){0.f, 0.f, 0.f, 0.f, 0.f, 0.f, 0.f, 0.f}; }
    bf16x8 At[4][2], B0[2][2], B1[2][2];
    v8i32 At8[4], B08[2], B18[2];
    PG8_LAS unsigned* gtab = (PG8_LAS unsigned*)(lds + STAGE_BYTES + 4096);
    PG8_LAS unsigned* vAc = gtab; PG8_LAS unsigned* vAn = gtab;
    if constexpr (Sched::GATHER) { if (tid < 256) gtab[tid] = S.row_off(cur, tid); asm volatile("s_waitcnt lgkmcnt(0)" ::: "memory"); PG8_BAR; }
    const char* cA = uptr(S.a_ptr(cur)); const char* cB = uptr(S.b_ptr(cur));
    PG8_STAGE_B(PG8_SB(0, 0), cB); PG8_STAGE_B(PG8_SB(0, 1), cB + bh); PG8_STAGE_A(PG8_SA(0, 0), 0, cA, vAc); PG8_STAGE_A(PG8_SA(0, 1), 1, cA, vAc);
    if (wr == 1) PG8_BAR;
    PG8_WAIT_V(2); PG8_BAR;
    PG8_STAGE_B(PG8_SB(1, 0), cB + kstep); PG8_STAGE_A(PG8_SA(1, 0), 0, cA + kstep, vAc); PG8_STAGE_B(PG8_SB(1, 1), cB + bh + kstep);
    PG8_WAIT_V(6); PG8_BAR;
    for (;;) {
        const bool has_next = S.next(ui + 1, nxt);
        nxt.pm = __builtin_amdgcn_readfirstlane(nxt.pm); nxt.pn = __builtin_amdgcn_readfirstlane(nxt.pn); nxt.z = __builtin_amdgcn_readfirstlane(nxt.z);
        const char* nA = cA; const char* nB = cB;
        if constexpr (Sched::GATHER) vAn = vAc;
        if (has_next) { nA = uptr(S.a_ptr(nxt)); nB = uptr(S.b_ptr(nxt)); if constexpr (Sched::GATHER) { vAn = gtab + ((ui + 1) & 1) * 256; if (tid < 256) vAn[tid] = S.row_off(nxt, tid); } }
#pragma unroll 1
        for (int t = 0; t < nt; t += 2) {
            if constexpr (MID) { if (t == (nt >> 1)) E.mid(acc, cur, wr, wc, fr, fq); }
            const bool last = (t == nt - 2);
            const char* a1 = cA + (size_t)(t + 1) * kstep;
            const char* a2 = last ? nA : cA + (size_t)(t + 2) * kstep; const char* b2 = last ? nB : cB + (size_t)(t + 2) * kstep;
            const char* a3 = a2 + kstep; const char* b3 = b2 + kstep;
            PG8_LAS unsigned* v2 = last ? vAn : vAc;
            PG8_LDB(B0, 0, 0); PG8_LDB(B1, 0, 1); PG8_SCHED; PG8_LDA(At, 0, 0); PG8_STAGE_A(PG8_SA(1, 1), 1, a1, vAc);
            PG8_WAIT_V(8); PG8_WAIT_L(0); PG8_BAR; PG8_MMA(0, 0, At, B0); PG8_MMA(0, 1, At, B1); PG8_BAR; PG8_SCHED;
            PG8_LDA(At, 0, 1); PG8_STAGE_B(PG8_SB(0, 0), b2); PG8_STAGE_B(PG8_SB(0, 1), b2 + bh); PG8_STAGE_A(PG8_SA(0, 0), 0, a2, v2);
            PG8_WAIT_V(8); PG8_WAIT_L(0); PG8_BAR; PG8_MMA(1, 0, At, B0); PG8_MMA(1, 1, At, B1); PG8_BAR; PG8_SCHED;
            PG8_LDB(B0, 1, 0); PG8_LDB(B1, 1, 1); PG8_SCHED; PG8_LDA(At, 1, 0); PG8_STAGE_A(PG8_SA(0, 1), 1, a2, v2);
            PG8_WAIT_V(8); PG8_WAIT_L(0); PG8_BAR; PG8_MMA(0, 0, At, B0); PG8_MMA(0, 1, At, B1); PG8_BAR; PG8_SCHED;
            PG8_LDA(At, 1, 1); PG8_STAGE_B(PG8_SB(1, 0), b3); PG8_STAGE_B(PG8_SB(1, 1), b3 + bh); PG8_STAGE_A(PG8_SA(1, 0), 0, a3, v2);
            PG8_WAIT_V(8); PG8_WAIT_L(0); PG8_BAR; PG8_MMA(1, 0, At, B0); PG8_MMA(1, 1, At, B1); PG8_BAR; PG8_SCHED;
        }
        if constexpr (ALIGN_EPI) { if (wr == 0) PG8_BAR; }
        { int fr_o = fr, fq_o = fq; asm volatile("" : "+v"(fr_o), "+v"(fq_o));
          if constexpr (FP8) E(AccView8{acc8}, cur, wr, wc, fr_o, fq_o); else E(AccView4{acc}, cur, wr, wc, fr_o, fq_o); }
        if (!has_next) break;
#pragma unroll
        for (int a = 0; a < 2; ++a)
#pragma unroll
            for (int b = 0; b < 2; ++b)
#pragma unroll
                for (int m = 0; m < 4; ++m)
#pragma unroll
                    for (int n = 0; n < 2; ++n) { acc[a][b][m][n] = (f32x4){0.f, 0.f, 0.f, 0.f}; acc8[a][b][m] = (f32x8){0.f, 0.f, 0.f, 0.f, 0.f, 0.f, 0.f, 0.f}; }
        cur = nxt; cA = nA; cB = nB; ++ui;
        if constexpr (Sched::GATHER) vAc = vAn;
        if constexpr (ALIGN_EPI) { if (wr == 1) PG8_BAR; }
    }
    PG8_WAIT_V(0);
    if constexpr (!ALIGN_EPI) { if (wr == 0) PG8_BAR; }
    PG8_BAR;
#undef PG8_SA
#undef PG8_SB
#undef PG8_STAGE
#undef PG8_STAGE2
#undef PG8_STAGE_B
#undef PG8_STAGE_A
#undef PG8_LDA
#undef PG8_LDB
#undef PG8_MMA
#undef PG8_F8
#undef PG8_LD8
#undef PG8_WAIT_V
#undef PG8_WAIT_L
#undef PG8_BAR
#undef PG8_SCHED
}
}

#define XB_TMO      128
#define XB_XCNT(j)  (256  + 64 * (j))
#define XB_XSUB(j)  (1280 + 64 * (j))
#define XB_XGEN(j)  (2304 + 64 * (j))
#define XB_TOP      3328
#define XB_TOPGEN   3392
#define XCD_BAR_WORDS 3456
#define XB_SPIN_CAP (1u << 18)
#define LAS __attribute__((address_space(3)))

__device__ __forceinline__ unsigned xb_ld(unsigned* p)              { return __hip_atomic_load(p, __ATOMIC_RELAXED, __HIP_MEMORY_SCOPE_AGENT); }
__device__ __forceinline__ unsigned xb_add(unsigned* p, unsigned v) { return __hip_atomic_fetch_add(p, v, __ATOMIC_RELAXED, __HIP_MEMORY_SCOPE_AGENT); }
__device__ __forceinline__ unsigned xb_xcc_id() { return (unsigned)__builtin_amdgcn_s_getreg((3 << 11) | 20) & 0xFu; }
#define XB_SPIN(cond, bar) do { unsigned _sp = 0; while (cond) { __builtin_amdgcn_s_sleep(1); \
    if ((++_sp & 255u) == 0u) { if (xb_ld(&(bar)[XB_TMO])) break; if (_sp > XB_SPIN_CAP) { atomicAdd(&(bar)[XB_TMO], 1u); break; } } } } while (0)

struct XcdBarrier {
    unsigned* bar; unsigned x;
    volatile LAS unsigned* st;
    bool t0;
};

__device__ __forceinline__ XcdBarrier xcd_barrier_post(unsigned* bar, volatile LAS unsigned* st) {
    XcdBarrier b; b.bar = bar; b.x = xb_xcc_id(); b.st = st;
    if (threadIdx.x == 0) (void)xb_add(&bar[XB_XCNT(b.x)], 1u);
    return b;
}
__device__ __forceinline__ void xcd_barrier_complete(unsigned* bar, unsigned x, unsigned& nloc, unsigned& nx) {
    const unsigned G = gridDim.x * gridDim.y * gridDim.z;
    unsigned sum, cnt, mine, sp = 0u;
    for (;;) {
        sum = 0u; cnt = 0u; mine = 0u;
#pragma unroll
        for (unsigned j = 0; j < 16; ++j) { const unsigned c = xb_ld(&bar[XB_XCNT(j)]); sum += c; cnt += (c > 0u) ? 1u : 0u; mine = (j == x) ? c : mine; }
        if (sum == G) break;
        __builtin_amdgcn_s_sleep(1);
        if ((++sp & 255u) == 0u) { if (xb_ld(&bar[XB_TMO])) break; if (sp > XB_SPIN_CAP) { atomicAdd(&bar[XB_TMO], 1u); break; } }
    }
    nloc = mine > 0u ? mine : 1u; nx = cnt > 0u ? cnt : 1u;
}

__device__ __forceinline__ void xcd_barrier(const XcdBarrier& b) {
    asm volatile("s_waitcnt vmcnt(0)" ::: "memory");
    __syncthreads();
    if (b.t0) {
        unsigned* bar = b.bar;
        __builtin_amdgcn_s_waitcnt(0);
        unsigned nloc = b.st[0], nx = b.st[1];
        if (nloc == 0u) { xcd_barrier_complete(bar, b.x, nloc, nx); b.st[0] = nloc; b.st[1] = nx; }
        const unsigned old = xb_add(&bar[XB_XSUB(b.x)], 1u);
        const unsigned gen = old / nloc;
        if (old + 1u == (gen + 1u) * nloc) {
            __builtin_amdgcn_fence(__ATOMIC_RELEASE, "agent");
            asm volatile("s_waitcnt vmcnt(0)" ::: "memory");
            const unsigned og = xb_add(&bar[XB_TOP], 1u);
            const unsigned tg = og / nx;
            if (og + 1u == (tg + 1u) * nx) xb_add(&bar[XB_TOPGEN], 1u);
            else XB_SPIN(xb_ld(&bar[XB_TOPGEN]) == tg, bar);
            __builtin_amdgcn_fence(__ATOMIC_ACQUIRE, "agent");
            xb_add(&bar[XB_XGEN(b.x)], 1u);
            asm volatile("s_waitcnt vmcnt(0)" ::: "memory");
        } else {
            XB_SPIN(xb_ld(&bar[XB_XGEN(b.x)]) == gen, bar);
            __builtin_amdgcn_fence(__ATOMIC_ACQUIRE, "agent");
            asm volatile("s_waitcnt vmcnt(0)" ::: "memory");
        }
    }
    __syncthreads();
}


constexpr int NWAVES = 8;
constexpr int T = 16384, D = 2048, RW = 1024, NH = 8, DH = 128, SG = 64, SP = 64, SC = 16, NE = 32, FE = 512, PLE = 256, INC = 5120;
constexpr int N1 = 9216;
constexpr int S5L = 16, S5NC = T / S5L, S5K = 384;
constexpr int RSC = 32, RCH = 8;
constexpr float EPS = 1e-6f;

constexpr size_t MiB = 1u << 20;
constexpr size_t WS_CTL = 0, CTL_ZERO_BYTES = 1 * MiB;
constexpr size_t WS_LIST = 1 * MiB, WS_WGT = 3 * MiB, WS_RINV = 3 * MiB + 256 * 1024, WS_LAM = 3 * MiB + 512 * 1024;
constexpr size_t WS_COS = 4 * MiB, WS_SIN = 8 * MiB, WS_PB = 12 * MiB;
constexpr size_t WS_WT1 = 20 * MiB, WS_WGLU = 56 * MiB, WS_WA = 58 * MiB, WS_WB = 62 * MiB, WS_WOUT = 66 * MiB, WS_WPG = 74 * MiB, WS_WP = 82 * MiB, WS_BTC = 83 * MiB, WS_BLT = 95 * MiB;
constexpr size_t WS_HB = 100 * MiB, WS_YRET = 100 * MiB, WS_YPRE = 132 * MiB;
constexpr size_t WS_Q = 164 * MiB, WS_K = 196 * MiB, WS_V = 228 * MiB, WS_G = 260 * MiB, WS_UA = 292 * MiB, WS_EST = 340 * MiB, WS_KVS = 372 * MiB;
constexpr size_t WS_MERGED = 164 * MiB, WS_YSSM = 228 * MiB;
constexpr size_t WS_END = 600 * MiB;
constexpr int CW_TMO = 0, CW_CODE = 1, CW_BAR = 4096, CW_Q0 = 8192  , CW_CNT = 8256  ;

constexpr int RING_OFF = 0, RING_BYTES = 131072;
constexpr int LDSCTL_OFF = RING_BYTES, MISC_OFF = LDSCTL_OFF + 320;
constexpr int LDS_BYTES = 147456;

#define GAS __attribute__((address_space(1)))
typedef unsigned short bf16;
typedef unsigned v4u __attribute__((ext_vector_type(4)));
typedef unsigned v2u __attribute__((ext_vector_type(2)));
typedef float f32x4 __attribute__((ext_vector_type(4)));
typedef short bf16x8 __attribute__((ext_vector_type(8)));
typedef short s16x4 __attribute__((ext_vector_type(4)));
typedef short v4i16_t __attribute__((ext_vector_type(4)));
typedef GAS unsigned gu32;
#define RLX_AGENT __ATOMIC_RELAXED, __HIP_MEMORY_SCOPE_AGENT
#define LDS_WAIT() asm volatile("s_waitcnt lgkmcnt(0)" ::: "memory")
#define VM_WAIT() asm volatile("s_waitcnt vmcnt(0)" ::: "memory")
using pg8::cvt_pk_bf16; using pg8::bf_lo; using pg8::bf_hi; using pg8::fsigm;

__device__ __forceinline__ int flane_opaque() { int l = (int)__builtin_amdgcn_mbcnt_hi(~0u, __builtin_amdgcn_mbcnt_lo(~0u, 0u)); asm volatile("" : "+v"(l)); return l; }
#define FLANE (flane_opaque())
#define FTID (F.wave * 64 + FLANE)
struct Frame {
    LAS unsigned char* lds;
    volatile LAS unsigned* MISC;
    unsigned* ctl;
    int wave, G;
};
__device__ __forceinline__ float wave_sum(float v) {
#pragma unroll
    for (int o = 1; o < 64; o <<= 1) v += __shfl_xor(v, o);
    return v;
}
__device__ __forceinline__ int wg_next_item(Frame& F, unsigned* ctr) {
    __syncthreads();
    if (FTID == 0) F.MISC[16] = __hip_atomic_fetch_add(ctr, 1u, RLX_AGENT);
    __syncthreads();
    return (int)F.MISC[16];
}
__device__ __forceinline__ unsigned wq_begin(Frame& F, unsigned* ctr) { unsigned nx = 0u; if (FTID == 0) nx = __hip_atomic_fetch_add(ctr, 1u, RLX_AGENT); return nx; }
__device__ __forceinline__ int wq_end(Frame& F, unsigned nx) {
    __syncthreads();
    if (FTID == 0) F.MISC[16] = nx;
    __syncthreads();
    return (int)F.MISC[16];
}

__device__ __forceinline__ unsigned pk4_fp8(float a, float b, float c2, float d) { int w = 0; w = __builtin_amdgcn_cvt_pk_fp8_f32(a, b, w, false); w = __builtin_amdgcn_cvt_pk_fp8_f32(c2, d, w, true); return (unsigned)w; }
template <int MODE, bool F8 = false>
__device__ __forceinline__ void transpose_item(const float* W, int K, int N, void* WTv, int ldt, int row_off, LAS unsigned char* scr, int item, int lane, const float* kscale = nullptr, float f8scale = 1.f, int ncols = 0) {
    const int nblk = (ncols ? ncols : N) / 64, kb = item / nblk, nb = item % nblk, k0 = 64 * kb, n0 = 64 * nb;
    const float* src = W + (size_t)(k0 + (lane >> 4)) * N + n0 + (lane & 15) * 4;
    f32x4 v[16];
#pragma unroll
    for (int i = 0; i < 16; ++i) v[i] = *(const f32x4*)(src + (size_t)(4 * i) * N);
    __builtin_amdgcn_sched_barrier(0);
#pragma unroll
    for (int i = 0; i < 16; ++i) { const int k = 4 * i + (lane >> 4); f32x4 a = v[i]; if (kscale) a = a * kscale[k0 + k];
        v2u o; o.x = cvt_pk_bf16(a[0], a[1]); o.y = cvt_pk_bf16(a[2], a[3]); *(LAS v2u*)(scr + k * 144 + (lane & 15) * 8) = o; }
    LDS_WAIT(); asm volatile("" ::: "memory");
    const int i16 = lane & 15, g = lane >> 4, q = (lane & 15) >> 2, p = lane & 3;
#pragma unroll
    for (int nt = 0; nt < 4; ++nt) {
        s16x4 r[4];
#pragma unroll
        for (int t = 0; t < 4; ++t) r[t] = __builtin_bit_cast(s16x4, __builtin_amdgcn_ds_read_tr16_b64_v4i16((LAS v4i16_t*)(scr + (16 * g + 4 * t + q) * 144 + (16 * nt + 4 * p) * 2)));
        const int nn = n0 + 16 * nt + i16; const int row = MODE == 0 ? row_off + nn : (MODE == 1 ? 8 * (nn >> 2) + (nn & 3) : 8 * (nn >> 2) + 4 + (nn & 3));
        if constexpr (F8) { unsigned w[4];
#pragma unroll
            for (int t = 0; t < 4; ++t) w[t] = pk4_fp8(__uint_as_float((unsigned)(unsigned short)r[t][0] << 16) * f8scale, __uint_as_float((unsigned)(unsigned short)r[t][1] << 16) * f8scale, __uint_as_float((unsigned)(unsigned short)r[t][2] << 16) * f8scale, __uint_as_float((unsigned)(unsigned short)r[t][3] << 16) * f8scale);
            *(GAS v4u*)((unsigned char*)WTv + (size_t)row * ldt + k0 + 16 * g) = (v4u){w[0], w[1], w[2], w[3]};
        } else { bf16* WT = (bf16*)WTv;
            *(GAS bf16x8*)(WT + (size_t)row * ldt + k0 + 16 * g) = (bf16x8){r[0][0], r[0][1], r[0][2], r[0][3], r[1][0], r[1][1], r[1][2], r[1][3]};
            *(GAS bf16x8*)(WT + (size_t)row * ldt + k0 + 16 * g + 8) = (bf16x8){r[2][0], r[2][1], r[2][2], r[2][3], r[3][0], r[3][1], r[3][2], r[3][3]}; } }
    LDS_WAIT(); asm volatile("" ::: "memory");
}
#define CONV_JOB(q_, src_, dst_, N_, ldt_, mode_, k0_, n0_, sc_) { const int e_ = __builtin_amdgcn_readfirstlane((q_) / 96), r_ = __builtin_amdgcn_readfirstlane((q_) % 96), mtx_ = r_ >> 5, sub_ = (r_ & 31) * 8 + wave; \
        if (mtx_ < 2) { src_ = (mtx_ == 0 ? WEG : WEU) + (size_t)e_ * D * FE; N_ = FE; dst_ = WGU8 + (size_t)e_ * 1024 * D; ldt_ = D; mode_ = 1 + mtx_; sc_ = 64.f; } \
        else { src_ = WED + (size_t)e_ * FE * D; N_ = D; dst_ = WDN8 + (size_t)e_ * D * FE; ldt_ = FE; mode_ = 0; sc_ = 32.f; } \
        const int nblk_ = N_ >> 6, kb_ = sub_ / nblk_, nb_ = sub_ % nblk_; k0_ = 64 * kb_; n0_ = 64 * nb_; }
__device__ __forceinline__ void conv_stream(int wave, int lane, LAS unsigned char* scr, int first, int stride, int total, const float* WEG, const float* WEU, const float* WED, unsigned char* WGU8, unsigned char* WDN8) {
    if (first >= total) return;
    const float* src; unsigned char* dst; int N, ldt, mode, k0, n0; float sc;
    CONV_JOB(first, src, dst, N, ldt, mode, k0, n0, sc)
    f32x4 v[16];
    { const float* sp = src + (size_t)(k0 + (lane >> 4)) * N + n0 + (lane & 15) * 4;
#pragma unroll
      for (int i = 0; i < 16; ++i) v[i] = *(const f32x4*)(sp + (size_t)(4 * i) * N); }
#pragma unroll 1
    for (int q = first; q < total; q += stride) {
#pragma unroll
        for (int i = 0; i < 16; ++i) { const int k = 4 * i + (lane >> 4); const f32x4 a = v[i];
            v2u o; o.x = cvt_pk_bf16(a[0], a[1]); o.y = cvt_pk_bf16(a[2], a[3]); *(LAS v2u*)(scr + k * 144 + (lane & 15) * 8) = o; }
        const int qn = q + stride < total ? q + stride : q;
        const float* srcn; unsigned char* dstn; int Nn, ldtn, moden, k0n, n0n; float scn;
        CONV_JOB(qn, srcn, dstn, Nn, ldtn, moden, k0n, n0n, scn)
        { const float* sp = srcn + (size_t)(k0n + (lane >> 4)) * Nn + n0n + (lane & 15) * 4;
#pragma unroll
          for (int i = 0; i < 16; ++i) v[i] = *(const f32x4*)(sp + (size_t)(4 * i) * Nn); }
        LDS_WAIT(); asm volatile("" ::: "memory");
        const int i16 = lane & 15, g = lane >> 4, qd = (lane & 15) >> 2, p = lane & 3;
#pragma unroll
        for (int nt = 0; nt < 4; ++nt) {
            s16x4 r[4];
#pragma unroll
            for (int t = 0; t < 4; ++t) r[t] = __builtin_bit_cast(s16x4, __builtin_amdgcn_ds_read_tr16_b64_v4i16((LAS v4i16_t*)(scr + (16 * g + 4 * t + qd) * 144 + (16 * nt + 4 * p) * 2)));
            const int nn = n0 + 16 * nt + i16; const int row = mode == 0 ? nn : 8 * (nn >> 2) + (nn & 3) + (mode == 2 ? 4 : 0);
            unsigned w[4];
#pragma unroll
            for (int t = 0; t < 4; ++t) w[t] = pk4_fp8(__uint_as_float((unsigned)(unsigned short)r[t][0] << 16) * sc, __uint_as_float((unsigned)(unsigned short)r[t][1] << 16) * sc, __uint_as_float((unsigned)(unsigned short)r[t][2] << 16) * sc, __uint_as_float((unsigned)(unsigned short)r[t][3] << 16) * sc);
            *(GAS v4u*)(dst + (size_t)row * ldt + k0 + 16 * g) = (v4u){w[0], w[1], w[2], w[3]}; }
        LDS_WAIT(); asm volatile("" ::: "memory");
        src = srcn; dst = dstn; N = Nn; ldt = ldtn; mode = moden; k0 = k0n; n0 = n0n; sc = scn;
    }
}
__device__ __forceinline__ void rms_row_to_bf16(int lane, const float* xrow, const float* w, bf16* orow, unsigned char* o8row) {
    const GAS f32x4* xr = (const GAS f32x4*)xrow + lane; const GAS f32x4* wr = (const GAS f32x4*)w + lane;
    f32x4 v[8]; float s = 0.f;
#pragma unroll
    for (int j = 0; j < 8; ++j) { v[j] = xr[64 * j]; s += (v[j].x * v[j].x + v[j].y * v[j].y) + (v[j].z * v[j].z + v[j].w * v[j].w); }
    const float r = rsqrtf(wave_sum(s) * (1.f / D) + EPS);
    GAS v2u* o8 = (GAS v2u*)orow + lane;
#pragma unroll
    for (int j = 0; j < 8; ++j) { const f32x4 ww = wr[64 * j]; const f32x4 h = (f32x4){v[j].x * r * ww.x, v[j].y * r * ww.y, v[j].z * r * ww.z, v[j].w * r * ww.w};
        v2u o; o.x = cvt_pk_bf16(h[0], h[1]); o.y = cvt_pk_bf16(h[2], h[3]); o8[64 * j] = o;
        ((GAS unsigned*)o8row)[lane + 64 * j] = pk4_fp8(h[0] * 4.f, h[1] * 4.f, h[2] * 4.f, h[3] * 4.f); }
}
__device__ __forceinline__ void s5_tables(Frame& F, int g, const float* lam_re, const float* lam_im, const float* log_dt, const float* b_re, const float* b_im, const float* c_re, const float* c_im, const float* dvec,
                                          bf16* BTC, bf16* BLT, float* LAMT) {
    LAS double* PW = (LAS double*)(F.lds);
    LAS double* BB = (LAS double*)(F.lds + 17408);
    LAS double* CC = (LAS double*)(F.lds + 33792);
    LAS float* KM = (LAS float*)(F.lds + 50176);
    const int tid = FTID;
    if (tid < 64) {
        const int p = tid; const double lr = fmin((double)lam_re[g * SP + p], -1e-4), li = (double)lam_im[g * SP + p], dt = exp((double)log_dt[g]);
        for (int j = 0; j <= 16; ++j) { const double mag = exp((double)j * lr * dt); double sn, cs; sincos((double)j * li * dt, &sn, &cs); PW[(j * 64 + p) * 2] = mag * cs; PW[(j * 64 + p) * 2 + 1] = mag * sn; }
        { const double mag = exp(512.0 * lr * dt); double sn, cs; sincos(512.0 * li * dt, &sn, &cs);
          LAMT[(g * 64 + p) * 4 + 2] = (float)(mag * cs); LAMT[(g * 64 + p) * 4 + 3] = (float)(mag * sn); }
        const double lbr = PW[(1 * 64 + p) * 2], lbi = PW[(1 * 64 + p) * 2 + 1];
        LAMT[(g * 64 + p) * 4 + 0] = (float)PW[(16 * 64 + p) * 2]; LAMT[(g * 64 + p) * 4 + 1] = (float)PW[(16 * 64 + p) * 2 + 1];
        const double nr = lbr - 1.0, ni = lbi, den = lr * lr + li * li; const double fr = (nr * lr + ni * li) / den, fi = (ni * lr - nr * li) / den;
        for (int c = 0; c < 16; ++c) { const double br = b_re[(g * SP + p) * SC + c], bi = b_im[(g * SP + p) * SC + c]; BB[(p * 16 + c) * 2] = fr * br - fi * bi; BB[(p * 16 + c) * 2 + 1] = fr * bi + fi * br; }
    }
    for (int idx = tid; idx < 1024; idx += 512) { const int c = idx >> 6, p = idx & 63; CC[idx * 2] = (double)c_re[(g * SC + c) * SP + p]; CC[idx * 2 + 1] = (double)c_im[(g * SC + c) * SP + p]; }
    __syncthreads();
    for (int idx = tid; idx < 4096; idx += 512) { const int j = idx >> 8, c = (idx >> 4) & 15, c2 = idx & 15; double s = 0.0;
        for (int p = 0; p < 64; ++p) { const double cr = CC[(c * 64 + p) * 2], ci = CC[(c * 64 + p) * 2 + 1], pr = PW[(j * 64 + p) * 2], pi = PW[(j * 64 + p) * 2 + 1];
            const double ar = cr * pr - ci * pi, ai = cr * pi + ci * pr; s += ar * BB[(p * 16 + c2) * 2] - ai * BB[(p * 16 + c2) * 2 + 1]; }
        if (j == 0 && c == c2) s += (double)dvec[g * SC + c];
        KM[idx] = (float)s; }
    __syncthreads();
    for (int idx = tid; idx < 256 * 48; idx += 512) { const int n = idx / 48, kc = idx % 48, s = n >> 4, c = n & 15; float v[8];
        if (kc < 32) { const int t = kc >> 1, c0 = (kc & 1) * 8;
#pragma unroll
            for (int j = 0; j < 8; ++j) v[j] = (t <= s) ? KM[((s - t) * 16 + c) * 16 + c0 + j] : 0.f;
        } else { const int q = kc - 32, part = q >> 3, p0 = (q & 7) * 8;
#pragma unroll
            for (int j = 0; j < 8; ++j) { const int p = p0 + j; const double cr = CC[(c * 64 + p) * 2], ci = CC[(c * 64 + p) * 2 + 1], pr = PW[((s + 1) * 64 + p) * 2], pi = PW[((s + 1) * 64 + p) * 2 + 1];
                v[j] = part ? (float)(-(cr * pi + ci * pr)) : (float)(cr * pr - ci * pi); } }
        v4u o; o.x = cvt_pk_bf16(v[0], v[1]); o.y = cvt_pk_bf16(v[2], v[3]); o.z = cvt_pk_bf16(v[4], v[5]); o.w = cvt_pk_bf16(v[6], v[7]);
        *(GAS v4u*)(BTC + ((size_t)(g * 256 + n) * S5K + kc * 8)) = o; }
    for (int idx = tid; idx < 128 * 32; idx += 512) { const int n = idx >> 5, kc = idx & 31, p = n & 63, part = n >> 6, t = kc >> 1, c0 = (kc & 1) * 8; float v[8];
        const double pr = PW[((15 - t) * 64 + p) * 2], pi = PW[((15 - t) * 64 + p) * 2 + 1];
#pragma unroll
        for (int j = 0; j < 8; ++j) { const double br = BB[(p * 16 + c0 + j) * 2], bi = BB[(p * 16 + c0 + j) * 2 + 1]; v[j] = part ? (float)(pr * bi + pi * br) : (float)(pr * br - pi * bi); }
        v4u o; o.x = cvt_pk_bf16(v[0], v[1]); o.y = cvt_pk_bf16(v[2], v[3]); o.z = cvt_pk_bf16(v[4], v[5]); o.w = cvt_pk_bf16(v[6], v[7]);
        *(GAS v4u*)(BLT + ((size_t)(g * 128 + n) * 256 + kc * 8)) = o; }
    __syncthreads();
}

using pg8::Unit; using pg8::pack8; using pg8::unpack8;
struct EpiProj {
    static constexpr bool PERM = true;
    bf16* QKVG; bf16* UA; bf16* GATES;
    template <class AV> __device__ __forceinline__ void operator()(const AV& acc, const Unit& u, int wr, int wc, int fr, int fq) const {
        const int row0 = u.pm * 256 + wr * 64 + fr, ct = wc * 32 + 8 * fq;
        if (u.pn < 16) { bf16* dst = QKVG + (size_t)(u.pn >> 2) * T * RW + (u.pn & 3) * 256 + ct;
#pragma unroll
            for (int ai = 0; ai < 2; ++ai)
#pragma unroll
                for (int m = 0; m < 4; ++m) { const size_t row = row0 + ai * 128 + m * 16;
#pragma unroll
                    for (int bj = 0; bj < 2; ++bj) *(v4u*)(dst + row * RW + bj * 128) = pack8(acc(ai, bj, m, 0), acc(ai, bj, m, 1)); }
        } else if (u.pn < 20) {
#pragma unroll
            for (int ai = 0; ai < 2; ++ai)
#pragma unroll
                for (int m = 0; m < 4; ++m) { const int row = row0 + ai * 128 + m * 16, ci = row >> 4, s = row & 15;
#pragma unroll
                    for (int bj = 0; bj < 2; ++bj) { const int cu = (u.pn - 16) * 256 + bj * 128 + ct, g = cu >> 4, c0 = cu & 15;
                        *(v4u*)(UA + ((size_t)(g * S5NC + ci) * S5K + 16 * s + c0)) = pack8(acc(ai, bj, m, 0), acc(ai, bj, m, 1)); } }
        } else { bf16* dst = GATES + (u.pn - 20) * 256 + ct;
#pragma unroll
            for (int ai = 0; ai < 2; ++ai)
#pragma unroll
                for (int m = 0; m < 4; ++m) { const size_t row = row0 + ai * 128 + m * 16;
#pragma unroll
                    for (int bj = 0; bj < 2; ++bj) { f32x4 a = acc(ai, bj, m, 0), b = acc(ai, bj, m, 1);
#pragma unroll
                        for (int j = 0; j < 4; ++j) { a[j] = fsigm(a[j]); b[j] = fsigm(b[j]); }
                        *(v4u*)(dst + row * 4096 + bj * 128) = pack8(a, b); } }
        }
    }
};
struct EpiGates {
    static constexpr bool PERM = true;
    bf16* RHO; bf16* G1;
    template <class AV> __device__ __forceinline__ void operator()(const AV& acc, const Unit& u, int wr, int wc, int fr, int fq) const {
        const int row0 = u.pm * 256 + wr * 64 + fr, j0 = u.pn * 128 + wc * 32 + 8 * fq;
#pragma unroll
        for (int ai = 0; ai < 2; ++ai)
#pragma unroll
            for (int m = 0; m < 4; ++m) { const size_t row = row0 + ai * 128 + m * 16;
                f32x4 a0 = acc(ai, 0, m, 0) * (1.f / 256.f), a1 = acc(ai, 0, m, 1) * (1.f / 256.f), b0 = acc(ai, 1, m, 0) * (1.f / 256.f), b1 = acc(ai, 1, m, 1) * (1.f / 256.f);
#pragma unroll
                for (int j = 0; j < 4; ++j) { const float s0 = fsigm(a0[j]), s1 = fsigm(b0[j]); b0[j] = s1; a0[j] = s0 * __builtin_amdgcn_rcpf(s1);
                    const float t0 = fsigm(a1[j]), t1 = fsigm(b1[j]); b1[j] = t1; a1[j] = t0 * __builtin_amdgcn_rcpf(t1); }
                *(v4u*)(RHO + row * D + j0) = pack8(a0, a1); *(v4u*)(G1 + row * D + j0) = pack8(b0, b1); }
    }
};
struct EpiS5A {
    static constexpr bool PERM = false;
    float* EST;
    template <class AV> __device__ __forceinline__ void operator()(const AV& acc, const Unit& u, int wr, int wc, int fr, int fq) const {
        const int row0 = u.pm * 256 + wr * 64 + fr, col0 = wc * 32 + 4 * fq;
#pragma unroll
        for (int ai = 0; ai < 2; ++ai)
#pragma unroll
            for (int m = 0; m < 4; ++m) { float* rowp = EST + ((size_t)u.z * S5NC + row0 + ai * 128 + m * 16) * 128 + col0;
#pragma unroll
                for (int n = 0; n < 2; ++n) *(f32x4*)(rowp + n * 16) = acc(ai, 0, m, n); }
    }
};
struct EpiS5C {
    static constexpr bool PERM = true;
    bf16* YPRE;
    template <class AV> __device__ __forceinline__ void operator()(const AV& acc, const Unit& u, int wr, int wc, int fr, int fq) const {
        const int row0 = u.pm * 256 + wr * 64 + fr, ct = wc * 32 + 8 * fq;
        bf16* yb = YPRE + ((size_t)row0 * 16 * RW + u.z * 16);
#pragma unroll
        for (int ai = 0; ai < 2; ++ai)
#pragma unroll
            for (int m = 0; m < 4; ++m) {
#pragma unroll
                for (int bj = 0; bj < 2; ++bj) { const int col = bj * 128 + ct, s = col >> 4, c0 = col & 15;
                    f32x4 a = acc(ai, bj, m, 0), b = acc(ai, bj, m, 1);
#pragma unroll
                    for (int j = 0; j < 4; ++j) { const float xa = a[j], xb = b[j];
                        a[j] = xa * fsigm(1.5957691216057308f * (xa + 0.044715f * xa * xa * xa)); b[j] = xb * fsigm(1.5957691216057308f * (xb + 0.044715f * xb * xb * xb)); }
                    *(v4u*)(yb + (size_t)(ai * 128 + m * 16) * 16 * RW + (size_t)s * RW + c0) = pack8(a, b); } }
    }
};
struct EpiGlu {
    static constexpr bool PERM = true;
    const bf16* YPRE; bf16* YSSM;
    template <class AV> __device__ __forceinline__ void operator()(const AV& acc, const Unit& u, int wr, int wc, int fr, int fq) const {
        const int row0 = u.pm * 256 + wr * 64 + fr, col0 = u.pn * 256 + wc * 32 + 8 * fq;
#pragma unroll
        for (int ai = 0; ai < 2; ++ai) { v4u yw[4][2];
#pragma unroll
            for (int m = 0; m < 4; ++m)
#pragma unroll
                for (int bj = 0; bj < 2; ++bj) yw[m][bj] = *(const v4u*)(YPRE + (size_t)(row0 + ai * 128 + m * 16) * RW + col0 + bj * 128);
            __builtin_amdgcn_sched_barrier(0);
#pragma unroll
            for (int m = 0; m < 4; ++m)
#pragma unroll
                for (int bj = 0; bj < 2; ++bj) { f32x4 y0, y1; unpack8(yw[m][bj], y0, y1); f32x4 a = acc(ai, bj, m, 0), b = acc(ai, bj, m, 1);
#pragma unroll
                    for (int j = 0; j < 4; ++j) { a[j] = y0[j] * fsigm(a[j]); b[j] = y1[j] * fsigm(b[j]); }
                    *(v4u*)(YSSM + (size_t)(row0 + ai * 128 + m * 16) * (2 * RW) + col0 + bj * 128) = pack8(a, b); }
            __builtin_amdgcn_sched_barrier(0); }
    }
};
struct EpiMerge1 {
    static constexpr bool PERM = true;
    const bf16* RHO; const bf16* G1; unsigned char* M8;
    __device__ __forceinline__ void mid(f32x4 (&acc)[2][2][4][2], const Unit& u, int wr, int wc, int fr, int fq) const {
        const int row0 = u.pm * 256 + wr * 64 + fr, col0 = u.pn * 256 + wc * 32 + 8 * fq;
#pragma unroll
        for (int ai = 0; ai < 2; ++ai) { v4u rw[4][2];
#pragma unroll
            for (int m = 0; m < 4; ++m)
#pragma unroll
                for (int bj = 0; bj < 2; ++bj) rw[m][bj] = *(const v4u*)(RHO + (size_t)(row0 + ai * 128 + m * 16) * D + col0 + bj * 128);
            __builtin_amdgcn_sched_barrier(0);
#pragma unroll
            for (int m = 0; m < 4; ++m)
#pragma unroll
                for (int bj = 0; bj < 2; ++bj) { f32x4 r0, r1; unpack8(rw[m][bj], r0, r1); acc[ai][bj][m][0] *= r0; acc[ai][bj][m][1] *= r1; }
            __builtin_amdgcn_sched_barrier(0); }
    }
    template <class AV> __device__ __forceinline__ void operator()(const AV& acc, const Unit& u, int wr, int wc, int fr, int fq) const {
        const int row0 = u.pm * 256 + wr * 64 + fr, col0 = u.pn * 256 + wc * 32 + 8 * fq;
#pragma unroll
        for (int ai = 0; ai < 2; ++ai) { v4u gw[4][2];
#pragma unroll
            for (int m = 0; m < 4; ++m)
#pragma unroll
                for (int bj = 0; bj < 2; ++bj) gw[m][bj] = *(const v4u*)(G1 + (size_t)(row0 + ai * 128 + m * 16) * D + col0 + bj * 128);
            __builtin_amdgcn_sched_barrier(0);
#pragma unroll
            for (int m = 0; m < 4; ++m)
#pragma unroll
                for (int bj = 0; bj < 2; ++bj) { f32x4 g0, g1; unpack8(gw[m][bj], g0, g1); const f32x4 a = acc(ai, bj, m, 0) * g0 * 8.f, b = acc(ai, bj, m, 1) * g1 * 8.f;
                    *(v2u*)(M8 + (size_t)(row0 + ai * 128 + m * 16) * D + col0 + bj * 128) = (v2u){pk4_fp8(a[0], a[1], a[2], a[3]), pk4_fp8(b[0], b[1], b[2], b[3])}; }
            __builtin_amdgcn_sched_barrier(0); }
    }
};
struct EpiOut {
    static constexpr bool PERM = true;
    const float* X; bf16* O;
    template <class AV> __device__ __forceinline__ void operator()(const AV& acc, const Unit& u, int wr, int wc, int fr, int fq) const {
        const int row0 = u.pm * 256 + wr * 64 + fr, col0 = u.pn * 256 + wc * 32 + 8 * fq;
#pragma unroll
        for (int ai = 0; ai < 2; ++ai) { f32x4 xv[4][2][2];
#pragma unroll
            for (int m = 0; m < 4; ++m)
#pragma unroll
                for (int bj = 0; bj < 2; ++bj)
#pragma unroll
                    for (int n = 0; n < 2; ++n) xv[m][bj][n] = *(const f32x4*)(X + (size_t)(row0 + ai * 128 + m * 16) * D + col0 + bj * 128 + n * 4);
            __builtin_amdgcn_sched_barrier(0);
#pragma unroll
            for (int m = 0; m < 4; ++m)
#pragma unroll
                for (int bj = 0; bj < 2; ++bj) *(v4u*)(O + (size_t)(row0 + ai * 128 + m * 16) * D + col0 + bj * 128) = pack8(xv[m][bj][0] + acc(ai, bj, m, 0) * (1.f / 512.f), xv[m][bj][1] + acc(ai, bj, m, 1) * (1.f / 512.f));
            __builtin_amdgcn_sched_barrier(0); }
    }
};

__device__ __forceinline__ unsigned off_b(unsigned row, unsigned ch) { return 256u * row + 16u * (ch ^ (((row & 3) << 2) | ((row >> 2) & 3))); }
__device__ __forceinline__ unsigned rrow16(unsigned lane, unsigned rb, unsigned s) { return off_b((lane & 15) + 16 * rb, 4 * s + (lane >> 4)); }
__device__ __forceinline__ unsigned rtr16(unsigned lane, unsigned c, unsigned ks, unsigned t) { const unsigned g = lane >> 4, q = (lane & 15) >> 2, p = lane & 3; return off_b(32 * ks + 8 * g + 4 * t + q, 2 * c + (p >> 1)) + 8 * (p & 1); }
__device__ __forceinline__ s16x4 vtr(LAS unsigned char* p) { return __builtin_bit_cast(s16x4, __builtin_amdgcn_ds_read_tr16_b64_v4i16((LAS v4i16_t*)p)); }
__device__ __forceinline__ bf16x8 trfrag(LAS unsigned char* img, unsigned lane, unsigned c, unsigned ks) {
    const s16x4 a = vtr(img + rtr16(lane, c, ks, 0)), b = vtr(img + rtr16(lane, c, ks, 1));
    return (bf16x8){a[0], a[1], a[2], a[3], b[0], b[1], b[2], b[3]};
}
__device__ __forceinline__ bf16x8 rowfrag(LAS unsigned char* img, unsigned lane, unsigned rb, unsigned s) { return *(const LAS bf16x8*)(img + rrow16(lane, rb, s)); }
constexpr int RL_Q = 0, RL_K = 16384, RL_KD = 32768, RL_V = 49152, RL_ST = 65536, RL_P = 98304, RL_STAT = 98304 + 9216;
constexpr int PS_STRIDE = 144;

struct RetCtx { const bf16* Q; const bf16* K; const bf16* V; const bf16* Gt; const float* COS; const float* SIN; const float* gnw; float* KVS; const float* KVS2; bf16* YRET; };

struct RetRegs { v4u q1, q2, k1, k2, v1, v2; f32x4 c0, c1, s0, s1; };
template <bool WITH_Q>
__device__ __forceinline__ void ret_load(Frame& F, const RetCtx& R, int tok0, int h, RetRegs& L) {
    const int tid = FTID, row = tid >> 3, ch = tid & 7; const size_t tok = (size_t)tok0 + row;
    const size_t gofs = tok * RW + h * DH + ch * 8;
    L.k1 = *(const v4u*)(R.K + gofs); L.k2 = *(const v4u*)(R.K + gofs + 64);
    L.v1 = *(const v4u*)(R.V + gofs); L.v2 = *(const v4u*)(R.V + gofs + 64);
    if (WITH_Q) { L.q1 = *(const v4u*)(R.Q + gofs); L.q2 = *(const v4u*)(R.Q + gofs + 64); }
    L.c0 = *(const f32x4*)(R.COS + tok * 64 + ch * 8); L.c1 = *(const f32x4*)(R.COS + tok * 64 + ch * 8 + 4);
    L.s0 = *(const f32x4*)(R.SIN + tok * 64 + ch * 8); L.s1 = *(const f32x4*)(R.SIN + tok * 64 + ch * 8 + 4);
}
template <bool WITH_Q>
__device__ __forceinline__ void ret_store(Frame& F, const RetCtx& R, int tok0, const RetRegs& L, float l2g, float wexp0) {
    const int tid = FTID, row = tid >> 3, ch = tid & 7; const size_t tok = (size_t)tok0 + row;
    const f32x4 c0 = L.c0, c1 = L.c1, s0 = L.s0, s1 = L.s1;
    f32x4 a0, a1, b0, b1;
    if (WITH_Q) { unpack8(L.q1, a0, a1); unpack8(L.q2, b0, b1);
        *(LAS v4u*)(F.lds + RL_Q + off_b(row, ch)) = pack8(a0 * c0 - b0 * s0, a1 * c1 - b1 * s1);
        *(LAS v4u*)(F.lds + RL_Q + off_b(row, ch + 8)) = pack8(a0 * s0 + b0 * c0, a1 * s1 + b1 * c1); }
    unpack8(L.k1, a0, a1); unpack8(L.k2, b0, b1);
    const float sc = 0.08838834764831845f;
    f32x4 o0 = (a0 * c0 - b0 * s0) * sc, o1 = (a1 * c1 - b1 * s1) * sc, p0 = (a0 * s0 + b0 * c0) * sc, p1 = (a1 * s1 + b1 * c1) * sc;
    if (WITH_Q) { *(LAS v4u*)(F.lds + RL_K + off_b(row, ch)) = pack8(o0, o1); *(LAS v4u*)(F.lds + RL_K + off_b(row, ch + 8)) = pack8(p0, p1); }
    const float kw = __builtin_amdgcn_exp2f(l2g * (wexp0 - (float)row));
    *(LAS v4u*)(F.lds + RL_KD + off_b(row, ch)) = pack8(o0 * kw, o1 * kw); *(LAS v4u*)(F.lds + RL_KD + off_b(row, ch + 8)) = pack8(p0 * kw, p1 * kw);
    *(LAS v4u*)(F.lds + RL_V + off_b(row, ch)) = L.v1; *(LAS v4u*)(F.lds + RL_V + off_b(row, ch + 8)) = L.v2;
}
__device__ __forceinline__ void ret_kv_update(Frame& F, f32x4 (&st)[8]) {
    const unsigned lane = FLANE, w = F.wave;
#pragma unroll
    for (int ks = 0; ks < 2; ++ks) { const bf16x8 a = trfrag(F.lds + RL_KD, lane, w, ks);
#pragma unroll
        for (int et = 0; et < 8; ++et) { const bf16x8 b = trfrag(F.lds + RL_V, lane, et, ks); st[et] = __builtin_amdgcn_mfma_f32_16x16x32_bf16(a, b, st[et], 0, 0, 0); } }
}
__device__ __forceinline__ void ret_pass_a(Frame& F, const RetCtx& R, int job) {
    const int s = job >> 3, h = job & 7; const float l2g = log2f(1.f - exp2f(-5.f - (float)h));
    f32x4 st[8];
#pragma unroll
    for (int et = 0; et < 8; ++et) st[et] = (f32x4){0.f, 0.f, 0.f, 0.f};
    RetRegs L; ret_load<false>(F, R, s * RCH * 64, h, L);
#pragma unroll 1
    for (int c = 0; c < RCH; ++c) {
        __syncthreads();
        ret_store<false>(F, R, (s * RCH + c) * 64, L, l2g, (float)(511 - 64 * c));
        __syncthreads();
        if (c + 1 < RCH) ret_load<false>(F, R, (s * RCH + c + 1) * 64, h, L);
        __builtin_amdgcn_sched_barrier(0);
        ret_kv_update(F, st);
    }
    const int fr = FLANE & 15, g = FLANE >> 4; float* o = R.KVS + ((size_t)(s * NH + h) * DH) * DH;
#pragma unroll
    for (int et = 0; et < 8; ++et)
#pragma unroll
        for (int r = 0; r < 4; ++r) o[(size_t)(16 * F.wave + 4 * g + r) * DH + 16 * et + fr] = st[et][r];
}
__device__ __forceinline__ void ret_pass_c(Frame& F, const RetCtx& R, int job) {
    const int s = job >> 3, h = job & 7; const float gam = 1.f - exp2f(-5.f - (float)h), l2g = log2f(gam), cd = __builtin_amdgcn_exp2f(l2g * 64.f);
    const unsigned lane = FLANE, w = F.wave; const int fr = lane & 15, g = lane >> 4;
    f32x4 st[8];
    { const float* o = R.KVS2 + ((size_t)(s * NH + h) * DH) * DH;
#pragma unroll
      for (int et = 0; et < 8; ++et)
#pragma unroll
          for (int r = 0; r < 4; ++r) st[et][r] = o[(size_t)(16 * w + 4 * g + r) * DH + 16 * et + fr]; }
    const int qt = w >> 1, eh = w & 1;
    const int kt = w >> 1, qt2 = 2 * (w & 1);
    RetRegs L; ret_load<true>(F, R, s * RCH * 64, h, L);
    float gnv[4];
#pragma unroll
    for (int j = 0; j < 4; ++j) gnv[j] = R.gnw[h * DH + 16 * (4 * eh + j) + fr];
#pragma unroll 1
    for (int c = 0; c < RCH; ++c) {
        const int tok0 = (s * RCH + c) * 64;
        unsigned lane = FLANE; asm volatile("" : "+v"(lane));
        __syncthreads();
#pragma unroll
        for (int et = 0; et < 8; ++et) { v2u pk; pk.x = cvt_pk_bf16(st[et][0], st[et][1]); pk.y = cvt_pk_bf16(st[et][2], st[et][3]);
            *(LAS v2u*)(F.lds + RL_ST + off_b(16 * et + fr, 2 * w + (g >> 1)) + 8 * (g & 1)) = pk; }
        ret_store<true>(F, R, tok0, L, l2g, 63.f);
        __syncthreads();
        if (c + 1 < RCH) ret_load<true>(F, R, tok0 + 64, h, L);
        __builtin_amdgcn_sched_barrier(0);
#pragma unroll
        for (int j = 0; j < 2; ++j) { f32x4 sc = (f32x4){0.f, 0.f, 0.f, 0.f};
#pragma unroll
            for (int ks = 0; ks < 4; ++ks) sc = __builtin_amdgcn_mfma_f32_16x16x32_bf16(rowfrag(F.lds + RL_K, lane, kt, ks), rowfrag(F.lds + RL_Q, lane, qt2 + j, ks), sc, 0, 0, 0);
            const int q = 16 * (qt2 + j) + fr;
#pragma unroll
            for (int r = 0; r < 4; ++r) { const int key = 16 * kt + 4 * g + r; sc[r] *= __builtin_amdgcn_exp2f(l2g * fabsf((float)(q - key))); }
            v2u pk; pk.x = cvt_pk_bf16(sc[0], sc[1]); pk.y = cvt_pk_bf16(sc[2], sc[3]);
            *(LAS v2u*)(F.lds + RL_P + q * PS_STRIDE + (16 * kt + 4 * g) * 2) = pk; }
        f32x4 y[4];
#pragma unroll
        for (int j = 0; j < 4; ++j) y[j] = (f32x4){0.f, 0.f, 0.f, 0.f};
#pragma unroll
        for (int ks = 0; ks < 4; ++ks) { const bf16x8 a = rowfrag(F.lds + RL_Q, lane, qt, ks);
#pragma unroll
            for (int j = 0; j < 4; ++j) y[j] = __builtin_amdgcn_mfma_f32_16x16x32_bf16(a, rowfrag(F.lds + RL_ST, lane, 4 * eh + j, ks), y[j], 0, 0, 0); }
#pragma unroll
        for (int r = 0; r < 4; ++r) { const float qd = __builtin_amdgcn_exp2f(l2g * (float)(16 * qt + 4 * g + r + 1));
#pragma unroll
            for (int j = 0; j < 4; ++j) y[j][r] *= qd; }
        __syncthreads();
        unsigned short gq[4][4];
#pragma unroll
        for (int r = 0; r < 4; ++r)
#pragma unroll
            for (int j = 0; j < 4; ++j) gq[r][j] = R.Gt[((size_t)tok0 + 16 * qt + 4 * g + r) * RW + h * DH + 16 * (4 * eh + j) + fr];
        __builtin_amdgcn_sched_barrier(0);
#pragma unroll
        for (int ks = 0; ks < 2; ++ks) { const bf16x8 a = *(const LAS bf16x8*)(F.lds + RL_P + (16 * qt + fr) * PS_STRIDE + (32 * ks + 8 * g) * 2);
#pragma unroll
            for (int j = 0; j < 4; ++j) y[j] = __builtin_amdgcn_mfma_f32_16x16x32_bf16(a, trfrag(F.lds + RL_V, lane, 4 * eh + j, ks), y[j], 0, 0, 0); }
        LAS float* STAT = (LAS float*)(F.lds + RL_STAT);
#pragma unroll
        for (int r = 0; r < 4; ++r) { float s1 = 0.f, s2 = 0.f;
#pragma unroll
            for (int j = 0; j < 4; ++j) { s1 += y[j][r]; s2 += y[j][r] * y[j][r]; }
#pragma unroll
            for (int o = 1; o < 16; o <<= 1) { s1 += __shfl_xor(s1, o); s2 += __shfl_xor(s2, o); }
            if (fr == 0) { STAT[((16 * qt + 4 * g + r) * 2 + eh) * 2] = s1; STAT[((16 * qt + 4 * g + r) * 2 + eh) * 2 + 1] = s2; } }
#pragma unroll
        for (int et = 0; et < 8; ++et) st[et] *= cd;
        ret_kv_update(F, st);
        __syncthreads();
#pragma unroll
        for (int r = 0; r < 4; ++r) { const int q = 16 * qt + 4 * g + r; const float s1 = STAT[(q * 2) * 2] + STAT[(q * 2 + 1) * 2], s2 = STAT[(q * 2) * 2 + 1] + STAT[(q * 2 + 1) * 2 + 1];
            const float mu = s1 * (1.f / 128.f), var = s2 * (1.f / 128.f) - mu * mu, rs = rsqrtf(var + EPS); const size_t tok = (size_t)tok0 + q;
#pragma unroll
            for (int j = 0; j < 4; ++j) { const int e = h * DH + 16 * (4 * eh + j) + fr; const float gv = __uint_as_float((unsigned)gq[r][j] << 16);
                const float o = (y[j][r] - mu) * rs * gnv[j] * gv * fsigm(gv);
                R.YRET[tok * (2 * RW) + e] = (bf16)(cvt_pk_bf16(o, o) & 0xffffu); } }
    }
}

constexpr size_t WS_WR = WS_LAM + 64 * 1024;
constexpr size_t WS_WGU = 164 * MiB, WS_WDN = 292 * MiB, WS_ACT = 356 * MiB, WS_MOE = 396 * MiB, WS_PP = 524 * MiB;
constexpr size_t WS_END2 = 588 * MiB;
constexpr int CW_Q1 = 8320, CW_SS = 131072;
constexpr int MOE_TAB_OFF = LDSCTL_OFF + 1024;

__device__ __forceinline__ void router_weights_item(Frame& F, int item, const float* nf, const float* wrg, const float* wre, bf16* WRF) {
    const int tt = item * 512 + FTID, pair = tt >> 6, lane = tt & 63, ks = pair / 3, nt = pair % 3, j = 16 * nt + (lane & 15), k0 = 32 * ks + 8 * (lane >> 4); float v[8];
#pragma unroll
    for (int i = 0; i < 8; ++i) { const int k = k0 + i; float w = 0.f; if (j < 4) w = wrg[k * 4 + j]; else if (j < 36) w = wre[k * NE + (j - 4)]; v[i] = w * nf[k]; }
    unsigned hi[4], lo[4];
#pragma unroll
    for (int i = 0; i < 4; ++i) { hi[i] = cvt_pk_bf16(v[2 * i], v[2 * i + 1]); lo[i] = cvt_pk_bf16(v[2 * i] - bf_lo(hi[i]), v[2 * i + 1] - bf_hi(hi[i])); }
    *(v4u*)(WRF + ((size_t)(pair * 2 + 0) * 64 + lane) * 8) = (v4u){hi[0], hi[1], hi[2], hi[3]}; *(v4u*)(WRF + ((size_t)(pair * 2 + 1) * 64 + lane) * 8) = (v4u){lo[0], lo[1], lo[2], lo[3]};
}
__device__ __forceinline__ void router_item(Frame& F, int item, bool dry, const bf16* X1, const float* nf, const bf16* WRF, const float* brg, const float* bre,
                                            unsigned char* HX, float* RINV, unsigned* cnt, int* list, float* wgt) {
    const int lane = FLANE, fr = lane & 15, g = lane >> 4, w = F.wave, tok0 = item * 64, kb = w * 256;
    const bf16* xp = X1 + (size_t)(tok0 + fr) * D + kb + 8 * g; unsigned char* hp = HX + (size_t)(tok0 + fr) * D + kb + 8 * g; const float* np = nf + kb + 8 * g;
    const bf16* bp = WRF + ((size_t)(w * 8) * 6 * 64 + lane) * 8;
    f32x4 acc[4][3]; float ss[4];
#pragma unroll
    for (int mt = 0; mt < 4; ++mt) { ss[mt] = 0.f;
#pragma unroll
        for (int nt = 0; nt < 3; ++nt) acc[mt][nt] = (f32x4){0.f, 0.f, 0.f, 0.f}; }
#pragma unroll 1
    for (int k2 = 0; k2 < 2; ++k2) {
        v4u xw[4][4]; f32x4 n0[4], n1[4]; bf16x8 bh[3], bl[3];
#pragma unroll
        for (int s = 0; s < 4; ++s) { const int ko = 128 * k2 + 32 * s; n0[s] = *(const f32x4*)(np + ko); n1[s] = *(const f32x4*)(np + ko + 4);
#pragma unroll
            for (int mt = 0; mt < 4; ++mt) xw[s][mt] = *(const v4u*)(xp + (size_t)16 * mt * D + ko); }
#pragma unroll
        for (int nt = 0; nt < 3; ++nt) { bh[nt] = *(const bf16x8*)(bp + (size_t)(((4 * k2) * 3 + nt) * 2 + 0) * 512); bl[nt] = *(const bf16x8*)(bp + (size_t)(((4 * k2) * 3 + nt) * 2 + 1) * 512); }
        __builtin_amdgcn_sched_barrier(0);
#pragma unroll
        for (int s = 0; s < 4; ++s) {
#pragma unroll
            for (int mt = 0; mt < 4; ++mt) { const int ko = 128 * k2 + 32 * s; f32x4 a, b; unpack8(xw[s][mt], a, b);
                ss[mt] += (a[0] * a[0] + a[1] * a[1]) + (a[2] * a[2] + a[3] * a[3]) + (b[0] * b[0] + b[1] * b[1]) + (b[2] * b[2] + b[3] * b[3]);
                { const f32x4 ha = a * n0[s] * 4.f, hb = b * n1[s] * 4.f; *(v2u*)(hp + (size_t)16 * mt * D + ko) = (v2u){pk4_fp8(ha[0], ha[1], ha[2], ha[3]), pk4_fp8(hb[0], hb[1], hb[2], hb[3])}; }
                const bf16x8 ah = __builtin_bit_cast(bf16x8, xw[s][mt]);
#pragma unroll
                for (int nt = 0; nt < 3; ++nt) {
                    acc[mt][nt] = __builtin_amdgcn_mfma_f32_16x16x32_bf16(ah, bh[nt], acc[mt][nt], 0, 0, 0);
                    acc[mt][nt] = __builtin_amdgcn_mfma_f32_16x16x32_bf16(ah, bl[nt], acc[mt][nt], 0, 0, 0); } }
            if (s < 3) {
#pragma unroll
                for (int nt = 0; nt < 3; ++nt) { bh[nt] = *(const bf16x8*)(bp + (size_t)(((4 * k2 + s + 1) * 3 + nt) * 2 + 0) * 512); bl[nt] = *(const bf16x8*)(bp + (size_t)(((4 * k2 + s + 1) * 3 + nt) * 2 + 1) * 512); } } }
    }
    LAS float* LG = (LAS float*)(F.lds + w * 12544);
    LAS float* SSP = (LAS float*)(F.lds + 8 * 12544 + w * 256);
#pragma unroll
    for (int mt = 0; mt < 4; ++mt) { float s = ss[mt]; s += __shfl_xor(s, 16); s += __shfl_xor(s, 32); if (g == 0) SSP[16 * mt + fr] = s;
#pragma unroll
        for (int r = 0; r < 4; ++r)
#pragma unroll
            for (int nt = 0; nt < 3; ++nt) LG[(16 * mt + 4 * g + r) * 49 + 16 * nt + fr] = acc[mt][nt][r]; }
    __syncthreads();
    if (FTID < 64 && !dry) {
        const int tl = FTID, t = tok0 + tl; float s = 0.f;
#pragma unroll
        for (int q = 0; q < 8; ++q) s += ((const LAS float*)(F.lds + 8 * 12544 + q * 256))[tl];
        const float rinv = rsqrtf(s * (1.f / D) + EPS);
        const LAS float* lg = (const LAS float*)F.lds + tl * 49;
        float mx = -1e30f; int gi = 0; float gl[4];
#pragma unroll
        for (int j = 0; j < 4; ++j) { float a = 0.f;
#pragma unroll
            for (int q = 0; q < 8; ++q) a += lg[q * 3136 + j];
            gl[j] = a * rinv + brg[j]; if (gl[j] > mx) { mx = gl[j]; gi = j; } }
        float se = 0.f;
#pragma unroll
        for (int j = 0; j < 4; ++j) se += __expf(gl[j] - mx);
        const float gw = 1.f / se;
        float b1 = -1e30f, b2 = -1e30f; int j1 = 0, j2 = 0;
        for (int j = 0; j < 8; ++j) { float a = 0.f;
#pragma unroll
            for (int q = 0; q < 8; ++q) a += lg[q * 3136 + 4 + gi * 8 + j];
            const float v = a * rinv + bre[gi * 8 + j]; if (v > b1) { b2 = b1; j2 = j1; b1 = v; j1 = j; } else if (v > b2) { b2 = v; j2 = j; } }
        const float e2 = __expf(b2 - b1); const float w1 = gw / (1.f + e2), w2 = gw * e2 / (1.f + e2);
        const int ea = gi * 8 + j1, eb = gi * 8 + j2;
        LAS unsigned* LC = (LAS unsigned*)(F.lds + 8 * 12544 + 2048);
        if (tl < 32) LC[tl] = 0u;
        asm volatile("s_waitcnt lgkmcnt(0)" ::: "memory");
        const unsigned la = __hip_atomic_fetch_add(LC + ea, 1u, __ATOMIC_RELAXED, __HIP_MEMORY_SCOPE_WORKGROUP);
        const unsigned lb = __hip_atomic_fetch_add(LC + eb, 1u, __ATOMIC_RELAXED, __HIP_MEMORY_SCOPE_WORKGROUP);
        asm volatile("s_waitcnt lgkmcnt(0)" ::: "memory");
        if (tl < 32) { const unsigned n = LC[tl]; unsigned base = 0u; if (n) base = __hip_atomic_fetch_add(cnt + tl, n, RLX_AGENT); LC[32 + tl] = base; }
        asm volatile("s_waitcnt vmcnt(0) lgkmcnt(0)" ::: "memory");
        const int pa = (int)(LC[32 + ea] + la), pb = (int)(LC[32 + eb] + lb);
        list[(size_t)ea * T + pa] = t * 2; wgt[t * 2] = w1;
        list[(size_t)eb * T + pb] = t * 2 + 1; wgt[t * 2 + 1] = w2;
        RINV[t] = rinv;
    }
}

template <int NT> __device__ __forceinline__ void moe_tables(Frame& F, const unsigned* cnt) {
    LAS int* tab = (LAS int*)(F.lds + MOE_TAB_OFF);
    __syncthreads();
    if (FTID == 0) { int cu = 0, ps = 0; for (int e = 0; e < NE; ++e) { const int c = (int)__hip_atomic_load(cnt + e, RLX_AGENT), nrb = (c + 255) >> 8; tab[e] = cu; tab[33 + e] = ps; tab[66 + e] = c; cu += nrb * NT; ps += nrb * 256; } tab[32] = cu; tab[65] = ps; }
    __syncthreads();
}
template <int NT, int NTSH> struct SchedMoe {
    LAS int* tab; int G, c, rep;
    __device__ __forceinline__ bool next(int i, pg8::Unit& u) const {
        const int nRB = tab[32] >> NTSH; int RB, pn;
        if (G == 256) { const int x = c & 7, slot = c >> 3; RB = (i * 8 + x) * (32 >> NTSH) + (slot >> NTSH); pn = slot & (NT - 1); }
        else { const int L = i * G + c; RB = L >> NTSH; pn = L & (NT - 1); }
        if (RB >= nRB * rep) return false; if (RB >= nRB) RB -= nRB;
        const int L = RB << NTSH; int e = 0;
        while (e < NE - 1 && tab[e + 1] <= L) ++e;
        u.z = e; u.pm = (L - tab[e]) >> NTSH; u.pn = pn; return true; }
};
struct SchedGU : SchedMoe<4, 2> {
    static constexpr bool GATHER = true;
    const char* A; const char* B; const int* list; unsigned lda2, ldb2;
    __device__ __forceinline__ const char* a_ptr(const pg8::Unit&) const { return A; }
    __device__ __forceinline__ const char* b_ptr(const pg8::Unit& u) const { return B + ((size_t)u.z * 1024 + (size_t)u.pn * 256) * ldb2; }
    __device__ __forceinline__ unsigned row_off(const pg8::Unit& u, int rr) const { const int r = u.pm * 256 + rr; const int tok = r < tab[66 + u.z] ? (list[(size_t)u.z * T + r] >> 1) : 0; return (unsigned)tok * lda2; }
};
struct SchedDN : SchedMoe<8, 3> {
    static constexpr bool GATHER = false;
    const char* A; const char* B; unsigned lda2, ldb2;
    __device__ __forceinline__ const char* a_ptr(const pg8::Unit& u) const { return A + (size_t)(tab[33 + u.z] + u.pm * 256) * lda2; }
    __device__ __forceinline__ const char* b_ptr(const pg8::Unit& u) const { return B + ((size_t)u.z * 2048 + (size_t)u.pn * 256) * ldb2; }
    __device__ __forceinline__ void a_off(const pg8::Unit&, const int (&)[2], const int (&)[2], unsigned (&)[2][2]) const {}
};
struct EpiGU {
    static constexpr bool PERM = true;
    unsigned char* ACT; const int* list; const float* RINV; LAS int* tab;
    template <class AV> __device__ __forceinline__ void operator()(const AV& acc, const Unit& u, int wr, int wc, int fr, int fq) const {
        const int ce = tab[66 + u.z], ps = tab[33 + u.z], r0 = u.pm * 256 + wr * 64 + fr, c0 = u.pn * 128 + wc * 16 + 4 * fq;
        int code[2][4]; float rvv[2][4];
#pragma unroll
        for (int ai = 0; ai < 2; ++ai)
#pragma unroll
            for (int m = 0; m < 4; ++m) { const int r = r0 + ai * 128 + m * 16; code[ai][m] = r < ce ? list[(size_t)u.z * T + r] : 0; }
#pragma unroll
        for (int ai = 0; ai < 2; ++ai)
#pragma unroll
            for (int m = 0; m < 4; ++m) rvv[ai][m] = RINV[code[ai][m] >> 1] * (1.f / 256.f);
#pragma unroll
        for (int ai = 0; ai < 2; ++ai)
#pragma unroll
            for (int m = 0; m < 4; ++m) { const int r = r0 + ai * 128 + m * 16;
                if (r < ce) { const float rv = rvv[ai][m];
#pragma unroll
                    for (int bj = 0; bj < 2; ++bj) { f32x4 gt = acc(ai, bj, m, 0) * rv, up = acc(ai, bj, m, 1) * rv;
#pragma unroll
                        for (int j = 0; j < 4; ++j) gt[j] = __builtin_fminf(__builtin_fmaxf(gt[j] * fsigm(gt[j]) * up[j] * 16.f, -440.f), 440.f);
                        *(unsigned*)(ACT + (size_t)(ps + r) * FE + c0 + bj * 64) = pk4_fp8(gt[0], gt[1], gt[2], gt[3]); } } }
    }
};
struct EpiDN {
    static constexpr bool PERM = true;
    bf16* MOE; const int* list; const float* wgt; LAS int* tab;
    template <class AV> __device__ __forceinline__ void operator()(const AV& acc, const Unit& u, int wr, int wc, int fr, int fq) const {
        const int ce = tab[66 + u.z], r0 = u.pm * 256 + wr * 64 + fr, c0 = u.pn * 256 + wc * 32 + 8 * fq;
        int code[2][4]; float wv[2][4];
#pragma unroll
        for (int ai = 0; ai < 2; ++ai)
#pragma unroll
            for (int m = 0; m < 4; ++m) { const int r = r0 + ai * 128 + m * 16; code[ai][m] = r < ce ? list[(size_t)u.z * T + r] : 0; }
#pragma unroll
        for (int ai = 0; ai < 2; ++ai)
#pragma unroll
            for (int m = 0; m < 4; ++m) wv[ai][m] = wgt[code[ai][m]] * (1.f / 512.f);
#pragma unroll
        for (int ai = 0; ai < 2; ++ai)
#pragma unroll
            for (int m = 0; m < 4; ++m) { const int r = r0 + ai * 128 + m * 16;
                if (r < ce) { const int cd = code[ai][m]; const float w = wv[ai][m]; bf16* dst = MOE + ((size_t)(cd & 1) * T + (cd >> 1)) * D + c0;
#pragma unroll
                    for (int bj = 0; bj < 2; ++bj) *(v4u*)(dst + bj * 128) = pack8(acc(ai, bj, m, 0) * w, acc(ai, bj, m, 1) * w); } }
    }
};
struct EpiPP {
    static constexpr bool PERM = false;
    bf16* PP;
    template <class AV> __device__ __forceinline__ void operator()(const AV& acc, const Unit& u, int wr, int wc, int fr, int fq) const {
        const int row0 = u.pm * 256 + wr * 64 + fr, col0 = u.pn * 256 + wc * 32 + 4 * fq;
#pragma unroll
        for (int ai = 0; ai < 2; ++ai)
#pragma unroll
            for (int m = 0; m < 4; ++m) { const size_t off = (size_t)(row0 + ai * 128 + m * 16) * D + col0;
#pragma unroll
                for (int bj = 0; bj < 2; ++bj)
#pragma unroll
                    for (int n = 0; n < 2; ++n) { const f32x4 a = acc(ai, bj, m, n); v2u o; o.x = cvt_pk_bf16(a[0], a[1]); o.y = cvt_pk_bf16(a[2], a[3]); *(v2u*)(PP + off + bj * 128 + n * 16) = o; } }
    }
};
struct EpiPle {
    static constexpr bool PERM = true;
    const bf16* PP; const bf16* X2B; const float* RINV; bf16* X3B;
    template <class AV> __device__ __forceinline__ void operator()(const AV& acc, const Unit& u, int wr, int wc, int fr, int fq) const {
        const int row0 = u.pm * 256 + wr * 64 + fr, col0 = u.pn * 256 + wc * 32 + 8 * fq;
#pragma unroll
        for (int ai = 0; ai < 2; ++ai) { v4u pw[4][2], xw[4][2]; float rvv[4];
#pragma unroll
            for (int m = 0; m < 4; ++m) { const int row = row0 + ai * 128 + m * 16; rvv[m] = RINV[row];
#pragma unroll
                for (int bj = 0; bj < 2; ++bj) { const size_t o = (size_t)row * D + col0 + bj * 128; pw[m][bj] = *(const v4u*)(PP + o); xw[m][bj] = *(const v4u*)(X2B + o); } }
            __builtin_amdgcn_sched_barrier(0);
#pragma unroll
            for (int m = 0; m < 4; ++m) { const int row = row0 + ai * 128 + m * 16; const float rv = rvv[m] * (1.f / 256.f)  ;
#pragma unroll
                for (int bj = 0; bj < 2; ++bj) { f32x4 p0, p1, x0, x1; unpack8(pw[m][bj], p0, p1); unpack8(xw[m][bj], x0, x1);
                    const f32x4 a0 = acc(ai, bj, m, 0) * rv, a1 = acc(ai, bj, m, 1) * rv;
#pragma unroll
                    for (int j = 0; j < 4; ++j) { x0[j] += fsigm(a0[j]) * p0[j]; x1[j] += fsigm(a1[j]) * p1[j]; }
                    *(v4u*)(X3B + (size_t)row * D + col0 + bj * 128) = pack8(x0, x1); } }
            __builtin_amdgcn_sched_barrier(0); }
    }
};
__device__ __forceinline__ void combine_row(int lane, const bf16* xrow, const bf16* m0, const bf16* m1, bf16* hrow, unsigned char* h8row, float* rinv) {
    v4u xw[4], u0[4], u1[4];
#pragma unroll
    for (int j = 0; j < 4; ++j) { const int c = (lane + 64 * j) * 8; xw[j] = *(const v4u*)(xrow + c); u0[j] = *(const v4u*)(m0 + c); u1[j] = *(const v4u*)(m1 + c); }
    __builtin_amdgcn_sched_barrier(0);
    float s = 0.f;
#pragma unroll
    for (int j = 0; j < 4; ++j) { const int c = (lane + 64 * j) * 8; f32x4 a, b, p0, p1, q0, q1; unpack8(xw[j], a, b); unpack8(u0[j], p0, p1); unpack8(u1[j], q0, q1);
        a += p0 + q0; b += p1 + q1;
        s += (a[0] * a[0] + a[1] * a[1]) + (a[2] * a[2] + a[3] * a[3]) + (b[0] * b[0] + b[1] * b[1]) + (b[2] * b[2] + b[3] * b[3]);
        *(v4u*)(hrow + c) = pack8(a, b); *(v2u*)(h8row + c) = (v2u){pk4_fp8(a[0] * 4.f, a[1] * 4.f, a[2] * 4.f, a[3] * 4.f), pk4_fp8(b[0] * 4.f, b[1] * 4.f, b[2] * 4.f, b[3] * 4.f)}; }
    s = wave_sum(s); if (lane == 0) *rinv = rsqrtf(s * (1.f / D) + EPS);
}
__device__ __forceinline__ void final_row(int lane, const bf16* xrow, float* orow, const float* w) {
    v4u xw[4]; f32x4 w0[4], w1[4];
#pragma unroll
    for (int j = 0; j < 4; ++j) { const int c = (lane + 64 * j) * 8; xw[j] = *(const v4u*)(xrow + c); w0[j] = *(const f32x4*)(w + c); w1[j] = *(const f32x4*)(w + c + 4); }
    __builtin_amdgcn_sched_barrier(0);
    f32x4 a[4], b[4]; float s = 0.f;
#pragma unroll
    for (int j = 0; j < 4; ++j) { unpack8(xw[j], a[j], b[j]); s += (a[j][0] * a[j][0] + a[j][1] * a[j][1]) + (a[j][2] * a[j][2] + a[j][3] * a[j][3]) + (b[j][0] * b[j][0] + b[j][1] * b[j][1]) + (b[j][2] * b[j][2] + b[j][3] * b[j][3]); }
    const float r = rsqrtf(wave_sum(s) * (1.f / D) + EPS);
#pragma unroll
    for (int j = 0; j < 4; ++j) { const int c = (lane + 64 * j) * 8; *(f32x4*)(orow + c) = a[j] * r * w0[j]; *(f32x4*)(orow + c + 4) = b[j] * r * w1[j]; }
}

__device__ __forceinline__ void s5_scan(Frame& F, int job, const float* EST, const float* LAMT, bf16* UA) {
    const int g = job >> 2, pq = job & 3, pl = FTID & 15, seg = FTID >> 4, p = pq * 16 + pl;
    const float l16r = LAMT[(g * 64 + p) * 4 + 0], l16i = LAMT[(g * 64 + p) * 4 + 1], lsr = LAMT[(g * 64 + p) * 4 + 2], lsi = LAMT[(g * 64 + p) * 4 + 3];
    float er[32], ei[32];
    const float* e0 = EST + ((size_t)g * S5NC + seg * 32) * 128 + p;
#pragma unroll
    for (int i = 0; i < 32; ++i) { er[i] = e0[(size_t)i * 128]; ei[i] = e0[(size_t)i * 128 + 64]; }
    float sr = 0.f, si = 0.f;
#pragma unroll
    for (int i = 0; i < 32; ++i) { const float nr = l16r * sr - l16i * si + er[i], ni = l16r * si + l16i * sr + ei[i]; sr = nr; si = ni; }
    LAS float* SE = (LAS float*)F.lds;
    __syncthreads();
    SE[(seg * 16 + pl) * 2] = sr; SE[(seg * 16 + pl) * 2 + 1] = si;
    __syncthreads();
    sr = 0.f; si = 0.f;
    for (int s2 = 0; s2 < seg; ++s2) { const float ar = SE[(s2 * 16 + pl) * 2], ai = SE[(s2 * 16 + pl) * 2 + 1]; const float nr = lsr * sr - lsi * si + ar, ni = lsr * si + lsi * sr + ai; sr = nr; si = ni; }
    bf16* o = UA + ((size_t)g * S5NC + seg * 32) * S5K + 256 + p;
#pragma unroll
    for (int i = 0; i < 32; ++i) { o[(size_t)i * S5K] = (bf16)(cvt_pk_bf16(sr, sr) & 0xffffu); o[(size_t)i * S5K + 64] = (bf16)(cvt_pk_bf16(si, si) & 0xffffu);
        const float nr = l16r * sr - l16i * si + er[i], ni = l16r * si + l16i * sr + ei[i]; sr = nr; si = ni; }
    __syncthreads();
}
__device__ __forceinline__ void ret_scan(Frame& F, int job, const float* KVS, float* KVS2) {
    const int idx = job * 512 + FTID;
    const int h = idx >> 14; const float cd8 = __builtin_amdgcn_exp2f(log2f(1.f - exp2f(-5.f - (float)h)) * 512.f);
    float v[RSC];
#pragma unroll
    for (int s = 0; s < RSC; ++s) v[s] = KVS[(size_t)s * NH * DH * DH + idx];
    float st = 0.f;
#pragma unroll
    for (int s = 0; s < RSC; ++s) { const float t = v[s]; KVS2[(size_t)s * NH * DH * DH + idx] = st; st = st * cd8 + t; }
}

struct Args { const float* in[30]; float* out; unsigned char* ws; int ph_lo, ph_hi, rep_mask, pad; };
enum { I_X = 0, I_P, I_NMIX, I_WIN, I_GNW, I_LRE, I_LIM, I_LDT, I_BRE, I_BIM, I_CRE, I_CIM, I_SD, I_WGLU, I_WA, I_WB, I_WMERGE, I_WOUT, I_NFFN, I_WRG, I_BRG, I_WRE, I_BRE2, I_WEG, I_WEU, I_WED, I_NPLE, I_WPG, I_WPLE, I_NF };

__device__ __forceinline__ const float* ain_opaque(const float* const (&in)[30], int k) { asm volatile("" : "+s"(k)); return in[k]; }
#define WT1 ((bf16*)(ws + WS_WT1))
#define WGLU ((bf16*)(ws + WS_WGLU))
#define WA ((bf16*)(ws + WS_WA))
#define WB ((bf16*)(ws + WS_WB))
#define WOUT ((bf16*)(ws + WS_WOUT))
#define WPG ((bf16*)(ws + WS_WPG))
#define M8 (ws + (size_t)444 * MiB)
#define H8 (ws + (size_t)404 * MiB)
#define WM8 (ws + (size_t)436 * MiB)
#define WP ((bf16*)(ws + WS_WP))
#define BTC ((bf16*)(ws + WS_BTC))
#define BLT ((bf16*)(ws + WS_BLT))
#define HB ((bf16*)(ws + WS_HB))
#define YCAT ((bf16*)(ws + (size_t)476 * MiB))
#define YRET YCAT
#define YPRE ((bf16*)(ws + WS_YPRE))
#define QKVG ((bf16*)(ws + WS_Q))
#define UA ((bf16*)(ws + WS_UA))
#define EST ((float*)(ws + WS_EST))
#define KVS ((float*)(ws + WS_KVS))
#define KVS2 ((float*)(ws + WS_KVS + 16 * MiB))
#define MERGED ((bf16*)(ws + WS_MERGED))
#define YSSM (YCAT + RW)
#define PB ((bf16*)(ws + WS_PB))
#define COS ((float*)(ws + WS_COS))
#define SIN ((float*)(ws + WS_SIN))
#define LAMT ((float*)(ws + WS_LAM))
#define WGU ((bf16*)(ws + WS_WGU))
#define WDN ((bf16*)(ws + WS_WDN))
#define WRH ((bf16*)(ws + WS_WR))
#define ACT ((bf16*)(ws + WS_ACT))
#define MOE ((bf16*)(ws + WS_MOE))
#define PP ((bf16*)(ws + WS_PP))
#define LIST ((int*)(ws + WS_LIST))
#define WGT ((float*)(ws + WS_WGT))
#define RINV ((float*)(ws + WS_RINV))
__global__ void __launch_bounds__(NWAVES * 64, 2) mk_fwd(Args args) {
    extern __shared__ __attribute__((aligned(16))) unsigned char lds_raw[];
    Frame F;
    F.lds = (LAS unsigned char*)lds_raw;
    F.MISC = (volatile LAS unsigned*)(F.lds + MISC_OFF);
    F.wave = __builtin_amdgcn_readfirstlane((int)threadIdx.x >> 6); F.G = gridDim.x;
    unsigned char* ws = args.ws;
    F.ctl = (unsigned*)(ws + WS_CTL);
    for (int u = FTID; u < (LDS_BYTES - LDSCTL_OFF) / 4; u += NWAVES * 64) ((LAS unsigned*)(F.lds + LDSCTL_OFF))[u] = 0u;
    __syncthreads();
    const int lo = args.ph_lo, hi = args.ph_hi;
    const bool fused = (hi - lo) > 1;
    if (fused) (void)xcd_barrier_post(F.ctl + CW_BAR, F.MISC + 8);
#ifndef PH_MASK
#define PH_MASK 0xffffffffu
#endif
#define IN(k) (((PH_MASK >> (k)) & 1u) && lo <= (k) && (k) < hi)
#ifdef STAMP_A
#define STAMP(i) do { if (blockIdx.x == STAMP_BLOCK && FTID == 0) ((volatile LAS unsigned long long*)(F.lds + LDSCTL_OFF + 2048))[i] = wall_clock64(); } while (0)
#else
#define STAMP(i) do { } while (0)
#endif
#define SEAM(k) do { if (IN(k) && IN((k) + 1)) { XcdBarrier _b; _b.bar = (unsigned*)(args.ws + WS_CTL) + CW_BAR; _b.x = xb_xcc_id(); _b.st = (volatile LAS unsigned*)(F.lds + MISC_OFF) + 8; _b.t0 = (F.wave == 0) && (FLANE == 0);     \
        xcd_barrier(_b); if ((args.rep_mask >> 14) & 1) xcd_barrier(_b); } } while (0)
#define NREP(k) (1 + ((args.rep_mask >> (k)) & 1))
    bf16* X1B = (bf16*)args.out;
    bf16* GATES = (bf16*)args.out;

#define AIN(k) ain_opaque(args.in, (k))
    if (IN(0)) {
        constexpr int I_S5 = 64;
        constexpr int I_WIN8 = (D / 64) * (INC / 64) / 8, I_WMG8 = (D / 64) * (4096 / 64) / 8, I_GLU8 = (RW / 64) * (RW / 64) / 8, I_WA8 = (RW / 64) * (D / 64) / 8, I_WO8 = (D / 64) * (D / 64) / 8, I_WPL8 = (PLE / 64) * (D / 64) / 8;
        constexpr int I_H = T / 16, I_PB = 256, I_ROPE = 256;
        constexpr int B0 = 0, B1 = B0 + I_S5, B2 = B1 + I_WIN8, B3 = B2 + I_WMG8, B4 = B3 + I_GLU8, B5 = B4 + I_WA8, B6 = B5 + I_WA8, B7 = B6 + I_WO8, B8 = B7 + I_WO8, B9 = B8 + I_WPL8, B10 = B9 + I_H, B11 = B10 + I_PB, B12 = B11 + I_ROPE, B13 = B12 + 1, B14 = B13 + 24;
        LAS unsigned char* scr = F.lds + RING_OFF + F.wave * 9216;
        for (int itq = wg_next_item(F, F.ctl + CW_Q0); itq < B14 * NREP(0);) {
            const unsigned nxq = wq_begin(F, F.ctl + CW_Q0);
            const int it = itq >= B14 ? itq - B14 : itq;
            if (it < B1) { s5_tables(F, it, AIN(I_LRE), AIN(I_LIM), AIN(I_LDT), AIN(I_BRE), AIN(I_BIM), AIN(I_CRE), AIN(I_CIM), AIN(I_SD), BTC, BLT, LAMT); }
            else if (it < B2) transpose_item<0>(AIN(I_WIN), D, INC, WT1, D, 0, scr, (it - B1) * 8 + F.wave, FLANE);
            else if (it < B3) { const int w8 = (it - B2) * 8 + F.wave, gs = w8 >> 10, t8 = w8 & 1023;
                transpose_item<0, true>(AIN(I_WMERGE) + gs * 2048, D, 4096, WM8, D, (((t8 & 31) >> 1) + gs) * 128, scr, t8, FLANE, nullptr, 64.f, 2048); }
            else if (it < B4) transpose_item<0>(AIN(I_WGLU), RW, RW, WGLU, RW, 0, scr, (it - B3) * 8 + F.wave, FLANE);
            else if (it < B5) transpose_item<0>(AIN(I_WA), RW, D, WA, 2 * RW, 0, scr, (it - B4) * 8 + F.wave, FLANE);
            else if (it < B6) transpose_item<0>(AIN(I_WB), RW, D, WA + RW, 2 * RW, 0, scr, (it - B5) * 8 + F.wave, FLANE);
            else if (it < B7) transpose_item<0, true>(AIN(I_WOUT), D, D, WOUT, D, 0, scr, (it - B6) * 8 + F.wave, FLANE, nullptr, 64.f);
            else if (it < B8) transpose_item<0, true>(AIN(I_WPG), D, D, WPG, D, 0, scr, (it - B7) * 8 + F.wave, FLANE, AIN(I_NPLE), 64.f);
            else if (it < B9) transpose_item<0>(AIN(I_WPLE), PLE, D, WP, PLE, 0, scr, (it - B8) * 8 + F.wave, FLANE);
            else if (it < B10) { const int r0 = (it - B9) * 16 + F.wave * 2;
                for (int r = 0; r < 2; ++r) rms_row_to_bf16(FLANE, AIN(I_X) + (size_t)(r0 + r) * D, AIN(I_NMIX), HB + (size_t)(r0 + r) * D, H8 + (size_t)(r0 + r) * D); }
            else if (it < B11) { const size_t e0 = (size_t)(it - B10) * 16384 + FTID * 8;
#pragma unroll
                for (int k = 0; k < 4; ++k) { const size_t e = e0 + (size_t)k * 4096; const f32x4 a = *(const f32x4*)(AIN(I_P) + e), b = *(const f32x4*)(AIN(I_P) + e + 4); *(v4u*)(PB + e) = pack8(a, b); } }
            else if (it < B12) { const int t0 = (it - B11) * 64;
#pragma unroll
                for (int k = 0; k < 8; ++k) { const int idx = k * 512 + FTID, t = t0 + (idx >> 6), j = idx & 63; const double inv = exp2(-(double)j * (13.287712379549449 / 64.0));
                    double sn, cs; sincos((double)t * inv, &sn, &cs); COS[(size_t)t * 64 + j] = (float)cs; SIN[(size_t)t * 64 + j] = (float)sn; } }
            else if (it >= B13) router_weights_item(F, it - B13, AIN(I_NFFN), AIN(I_WRG), AIN(I_WRE), (bf16*)(ws + WS_WR));
            else { for (int i = FTID; i < 128 * 256 / 8; i += 512) *(v4u*)(BLT + (size_t)SG * 128 * 256 + (size_t)i * 8) = (v4u){0u, 0u, 0u, 0u}; }
            itq = wq_end(F, nxq);
        }
    }
    SEAM(0);
    if (IN(1)) {
#pragma unroll 1
        for (int s = 0; s < 2; ++s) {
          if ((s ^ (int)(blockIdx.x & 1)) == 0) { pg8::SchedPlain S; S.init(HB, D, WT1, D, T, INC, F.G, (int)blockIdx.x); S.rep = NREP(1);
            EpiProj E{QKVG, UA, GATES};
            pg8::gemm_phase<EpiProj, pg8::SchedPlain>(F.lds + RING_OFF, D, S, E, F.wave); }
          else { pg8::SchedPlainC<T / 256, 4096 / 256> S; S.A = (const char*)H8; S.B = (const char*)WM8; S.lda2 = D; S.ldb2 = D; S.G = F.G; S.c = (int)blockIdx.x; S.rep = NREP(1);
            EpiGates E{GATES, GATES + (size_t)T * D};
            pg8::gemm_phase<EpiGates, pg8::SchedPlainC<T / 256, 4096 / 256>, true, true>(F.lds + RING_OFF, D, S, E, F.wave); }
        }
    }
    SEAM(1);
    RetCtx RC{QKVG, QKVG + (size_t)T * RW, QKVG + (size_t)2 * T * RW, QKVG + (size_t)3 * T * RW, COS, SIN, args.in[I_GNW], KVS, KVS2, YRET};
    if (IN(2)) {
        pg8::SchedBatch S; S.A = (const char*)UA; S.B = (const char*)BLT; S.lda2 = S5K * 2; S.ldb2 = 256 * 2; S.sA = (size_t)S5NC * S5K * 2; S.sB = (size_t)128 * 256 * 2; S.nMz = S5NC / 256; S.nz = SG; S.G = F.G; S.c = (int)blockIdx.x; S.rep = NREP(2);
        EpiS5A E{EST};
        pg8::gemm_phase<EpiS5A, pg8::SchedBatch>(F.lds + RING_OFF, 256, S, E, F.wave);
        for (int job = blockIdx.x; job < RSC * NH * NREP(2); job += F.G) ret_pass_a(F, RC, job & (RSC * NH - 1));
    }
    SEAM(2);
    if (IN(3)) {
        for (int job = blockIdx.x; job < SG * 4 * NREP(3); job += F.G) s5_scan(F, job & (SG * 4 - 1), EST, LAMT, UA);
        for (int job = blockIdx.x; job < NH * DH * DH / 512 * NREP(3); job += F.G) ret_scan(F, job & (NH * DH * DH / 512 - 1), KVS, KVS2);
    }
    SEAM(3);
    if (IN(4)) {
        pg8::SchedBatch S; S.A = (const char*)UA; S.B = (const char*)BTC; S.lda2 = S5K * 2; S.ldb2 = S5K * 2; S.sA = (size_t)S5NC * S5K * 2; S.sB = (size_t)256 * S5K * 2; S.nMz = S5NC / 256; S.nz = SG; S.G = F.G; S.c = (int)blockIdx.x; S.rep = NREP(4);
        EpiS5C E{YPRE};
#ifndef P4_NOGEMM
        pg8::gemm_phase<EpiS5C, pg8::SchedBatch>(F.lds + RING_OFF, S5K, S, E, F.wave);
#endif
#ifndef P4_NORET
        for (int job = blockIdx.x; job < RSC * NH * NREP(4); job += F.G) ret_pass_c(F, RC, job & (RSC * NH - 1));
#endif
    }
    SEAM(4);
    if (IN(5)) {
        pg8::SchedPlain S; S.init(YPRE, RW, WGLU, RW, T, RW, F.G, (int)blockIdx.x); S.rep = NREP(5);
        EpiGlu E{YPRE, YSSM};
        pg8::gemm_phase<EpiGlu, pg8::SchedPlain>(F.lds + RING_OFF, RW, S, E, F.wave);
    }
    SEAM(5);
    if (IN(6)) {
        pg8::SchedPlainC<T / 256, D / 256> S; S.A = (const char*)YCAT; S.B = (const char*)WA; S.lda2 = D * 2; S.ldb2 = D * 2; S.G = F.G; S.c = (int)blockIdx.x; S.rep = NREP(6);
        EpiMerge1 E{GATES, GATES + (size_t)T * D, M8};
        pg8::gemm_phase<EpiMerge1, pg8::SchedPlainC<T / 256, D / 256>, true, false, true>(F.lds + RING_OFF, D, S, E, F.wave);
    }
    SEAM(6);
    if (IN(7)) {
        constexpr int I_EW = 32 * 3 * 32;
#pragma unroll 1
        for (int s = 0; s < 2; ++s) {
            if ((s ^ (int)(blockIdx.x & 1)) == 0) {
                LAS unsigned char* scr = F.lds + RING_OFF + F.wave * 9216;
                for (int rp = 0; rp < NREP(7); ++rp)
                    conv_stream(F.wave, FLANE, scr, (int)blockIdx.x, F.G, I_EW, args.in[I_WEG], args.in[I_WEU], args.in[I_WED], (unsigned char*)WGU, (unsigned char*)WDN);
            } else {
                pg8::SchedPlainC<T / 256, D / 256> S; S.A = (const char*)M8; S.B = (const char*)WOUT; S.lda2 = D; S.ldb2 = D; S.G = F.G; S.c = (int)blockIdx.x; S.rep = NREP(7);
                EpiOut E{args.in[I_X], X1B};
                pg8::gemm_phase<EpiOut, pg8::SchedPlainC<T / 256, D / 256>, true, true>(F.lds + RING_OFF, D, S, E, F.wave); }
            __syncthreads();
        }
    }
    SEAM(7);
    float* RINV3 = RINV + T;
    unsigned* CNT = F.ctl + CW_CNT; bf16* X2B = HB; bf16* X3B = MOE;
    if (IN(8)) {
        constexpr int I_RT = T / 64;
        for (int itq = (int)blockIdx.x; itq < I_RT * NREP(8); itq += F.G) {
            int it = itq; bool dry = false; if (it >= I_RT) { it -= I_RT; dry = true; }
            __syncthreads();
            router_item(F, it, dry, X1B, args.in[I_NFFN], WRH, args.in[I_BRG], args.in[I_BRE2], (unsigned char*)HB, RINV, CNT, LIST, WGT);
        }
    }
    SEAM(8);
    if (IN(9)) {
        moe_tables<4>(F, CNT);
        SchedGU S; S.tab = (LAS int*)(F.lds + MOE_TAB_OFF); S.G = F.G; S.c = (int)blockIdx.x; S.A = (const char*)HB; S.B = (const char*)WGU; S.list = LIST; S.lda2 = D; S.ldb2 = D; S.rep = NREP(9);
        EpiGU E{(unsigned char*)ACT, LIST, RINV, S.tab};
        pg8::gemm_phase<EpiGU, SchedGU, true, true>(F.lds + RING_OFF, D, S, E, F.wave);
        { const int nRB = (S.tab[32] >> 2) * S.rep, lastRound = (nRB + 63) / 64 - 1, rem = nRB - lastRound * 64;
          const int q = ((int)blockIdx.x & 7) * 8 + ((int)blockIdx.x >> 5); int nLight = (64 - rem) * 4, idx = (q - rem) * 4 + (((int)blockIdx.x >> 3) & 3); bool light = q >= rem;
          if (nLight < 32 || F.G != 256) { nLight = F.G; idx = (int)blockIdx.x; light = true; }
          if (light) { pg8::SchedPlain S2; S2.init(PB, PLE, WP, PLE, T, D, nLight, idx); S2.rep = NREP(12); EpiPP E2{PP}; pg8::gemm_phase<EpiPP, pg8::SchedPlain>(F.lds + RING_OFF, PLE, S2, E2, F.wave); } }
    }
    SEAM(9);
    if (IN(10)) {
        moe_tables<8>(F, CNT);
        SchedDN S; S.tab = (LAS int*)(F.lds + MOE_TAB_OFF); S.G = F.G; S.c = (int)blockIdx.x; S.A = (const char*)ACT; S.B = (const char*)WDN; S.lda2 = FE; S.ldb2 = FE; S.rep = NREP(10);
        EpiDN E{MOE, LIST, WGT, S.tab};
        pg8::gemm_phase<EpiDN, SchedDN, true, true>(F.lds + RING_OFF, FE, S, E, F.wave);
    }
    SEAM(10);
    if (IN(11)) {
        for (int r2 = blockIdx.x * NWAVES + F.wave; r2 < T * NREP(11); r2 += F.G * NWAVES) { const int row = r2 & (T - 1);
            combine_row(FLANE, X1B + (size_t)row * D, MOE + (size_t)row * D, MOE + ((size_t)T + row) * D, X2B + (size_t)row * D, (unsigned char*)ACT + (size_t)row * D, RINV3 + row); }
    }
    SEAM(11);
    if (IN(12)) {
#ifndef P12_NOGATE
        { pg8::SchedPlainC<T / 256, D / 256> S; S.A = (const char*)ACT; S.B = (const char*)WPG; S.G = F.G; S.c = (int)blockIdx.x; S.lda2 = D; S.ldb2 = D; S.rep = NREP(12); EpiPle E{PP, X2B, RINV3, X3B};
          pg8::gemm_phase<EpiPle, pg8::SchedPlainC<T / 256, D / 256>, true, true>(F.lds + RING_OFF, D, S, E, F.wave); }
#endif
    }
    SEAM(12);
    if (IN(13)) {
        for (int r2 = blockIdx.x * NWAVES + F.wave; r2 < T * NREP(13); r2 += F.G * NWAVES) { const int row = r2 & (T - 1);
            final_row(FLANE, X3B + (size_t)row * D, args.out + (size_t)row * D, args.in[I_NF]); }
    }
#undef IN
#undef SEAM
}

#ifndef RUN_HI
#define RUN_HI 14
#endif
extern "C" void kernel_launch(void* const* d_in, const int* in_sizes, int n_in, void* d_out, int out_size, void* d_ws, size_t ws_size, hipStream_t stream) {
    static int grid = 0;
    if (grid == 0) {
        if (n_in != 30 || ws_size < WS_END2) { fprintf(stderr, "kernel_launch: unexpected n_in %d / ws %zu\n", n_in, ws_size); grid = -1; return; }
        int dev = 0, cus = 0;
        if (hipGetDevice(&dev) != hipSuccess || hipDeviceGetAttribute(&cus, hipDeviceAttributeMultiprocessorCount, dev) != hipSuccess) { grid = -1; return; }
        if (hipFuncSetAttribute((const void*)mk_fwd, hipFuncAttributeMaxDynamicSharedMemorySize, LDS_BYTES) != hipSuccess) { fprintf(stderr, "kernel_launch: hipFuncSetAttribute failed\n"); grid = -1; return; }
        grid = cus;
    }
    if (grid < 0) return;
    (void)hipMemsetAsync((char*)d_ws + WS_CTL, 0, CTL_ZERO_BYTES, stream);
    Args a{};
    for (int i = 0; i < 30; ++i) a.in[i] = (const float*)d_in[i];
    a.out = (float*)d_out; a.ws = (unsigned char*)d_ws;
#ifdef REP_MASK
    a.rep_mask = REP_MASK;
#endif
    a.ph_lo = 0; a.ph_hi = RUN_HI; hipLaunchKernelGGL(mk_fwd, dim3(grid), dim3(NWAVES * 64), LDS_BYTES, stream, a);
}
```

```cpp
#define REP_MASK 0x0
#include <hip/hip_runtime.h>
#include <math.h>
#include <stdio.h>
#include <stdint.h>
namespace pg8 {
#define PG8_LAS __attribute__((address_space(3)))
typedef unsigned short bf16_t;
typedef short bf16x8 __attribute__((ext_vector_type(8)));
typedef float f32x4 __attribute__((ext_vector_type(4)));
typedef float f32x2 __attribute__((ext_vector_type(2)));
typedef unsigned u32x4 __attribute__((ext_vector_type(4)));
typedef unsigned u32x2 __attribute__((ext_vector_type(2)));
constexpr int BM = 256, BK = 64, HALF = 128, HTB = HALF * BK * 2  , STAGE_BYTES = 8 * HTB, NXCD = 8, WGM = 8;

__host__ __device__ __forceinline__ int lds_byte(int r, int c) { const int st = (r >> 4) * 2 + (c >> 5), rr = r & 15, cc = c & 31, ob = rr * 64 + cc * 2; return st * 1024 + (ob ^ (((ob >> 9) & 1) << 5)); }
__host__ __device__ __forceinline__ void stage_rc(int b, int& R, int& C) { const int st = b / 1024, sb = b % 1024, swz = sb ^ (((sb >> 9) & 1) << 5); R = (st >> 1) * 16 + swz / 64; C = (st & 1) * 32 + (swz % 64) / 2; }
__host__ __device__ __forceinline__ int perm32(int rho) { const int n = rho >> 4, i = rho & 15; return 8 * (i >> 2) + 4 * n + (i & 3); }

struct Unit { int pm, pn, z; };
__device__ __forceinline__ const char* uptr(const char* p) {
    const unsigned long long v = (unsigned long long)p; const unsigned lo = __builtin_amdgcn_readfirstlane((unsigned)v), hi = __builtin_amdgcn_readfirstlane((unsigned)(v >> 32));
    return (const char*)(((unsigned long long)hi << 32) | lo); }

__device__ __forceinline__ void tile_of(int L, int nM, int nN, int& pm, int& pn) {
    const int nwg = nM * nN; int wgid = L; { const int q = nwg / NXCD, r = nwg % NXCD, xcd = wgid % NXCD, off = wgid / NXCD; wgid = (xcd < r ? xcd * (q + 1) : r * (q + 1) + (xcd - r) * q) + off; }
    const int nig = WGM * nN, gid = wgid / nig, fm = gid * WGM, gsz = (nM - fm) < WGM ? (nM - fm) : WGM;
    pm = fm + ((wgid % nig) % gsz); pn = (wgid % nig) / gsz;
}
struct SchedPlain {
    static constexpr bool GATHER = false;
    const char* A; const char* B; unsigned lda2, ldb2; int nM, nN, G, c, rep, i0, icnt;
    __device__ __forceinline__ void init(const void* A_, int lda, const void* B_, int ldb, int M, int N, int G_, int c_) { A = (const char*)A_; B = (const char*)B_; lda2 = lda * 2; ldb2 = ldb * 2; nM = M / BM; nN = N / BM; G = G_; c = c_; i0 = 0; icnt = 1 << 30; rep = 1; }
    __device__ __forceinline__ bool next(int i, Unit& u) const { if (i >= icnt) return false; int L = (i + i0) * G + c; if (L >= nM * nN * rep) return false; u.z = 0; if (L >= nM * nN) { L -= nM * nN; u.z = 1; } tile_of(L, nM, nN, u.pm, u.pn); return true; }
    __device__ __forceinline__ const char* a_ptr(const Unit& u) const { return A + (size_t)u.pm * BM * lda2; }
    __device__ __forceinline__ const char* b_ptr(const Unit& u) const { return B + (size_t)u.pn * BM * ldb2; }
    __device__ __forceinline__ void a_off(const Unit&, const int (&R)[2], const int (&C)[2], unsigned (&v)[2][2]) const {
#pragma unroll
        for (int h = 0; h < 2; ++h)
#pragma unroll
            for (int i = 0; i < 2; ++i) v[h][i] = (unsigned)(h * HALF + R[i]) * lda2 + (unsigned)C[i] * 2u; }
};
template <int NM, int NN> struct SchedPlainC {
    static constexpr bool GATHER = false;
    const char* A; const char* B; unsigned lda2, ldb2; int G, c, rep;
    __device__ __forceinline__ bool next(int i, Unit& u) const { int L = i * G + c; if (L >= NM * NN * rep) return false; u.z = 0; if (L >= NM * NN) { L -= NM * NN; u.z = 1; } tile_of(L, NM, NN, u.pm, u.pn); return true; }
    __device__ __forceinline__ const char* a_ptr(const Unit& u) const { return A + (size_t)u.pm * BM * lda2; }
    __device__ __forceinline__ const char* b_ptr(const Unit& u) const { return B + (size_t)u.pn * BM * ldb2; }
    __device__ __forceinline__ void a_off(const Unit&, const int (&)[2], const int (&)[2], unsigned (&)[2][2]) const {}
};
struct SchedBatch {
    static constexpr bool GATHER = false;
    const char* A; const char* B; unsigned lda2, ldb2; size_t sA, sB; int nMz, nz, G, c, rep;
    __device__ __forceinline__ bool next(int i, Unit& u) const { int L = i * G + c; if (L >= nMz * nz * rep) return false; if (L >= nMz * nz) L -= nMz * nz; u.z = L >> 2; u.pm = L & 3; u.pn = 0; return true; }
    __device__ __forceinline__ const char* a_ptr(const Unit& u) const { return A + (size_t)u.z * sA + (size_t)u.pm * BM * lda2; }
    __device__ __forceinline__ const char* b_ptr(const Unit& u) const { return B + (size_t)u.z * sB; }
    __device__ __forceinline__ void a_off(const Unit&, const int (&R)[2], const int (&C)[2], unsigned (&v)[2][2]) const {
#pragma unroll
        for (int h = 0; h < 2; ++h)
#pragma unroll
            for (int i = 0; i < 2; ++i) v[h][i] = (unsigned)(h * HALF + R[i]) * lda2 + (unsigned)C[i] * 2u; }
};
struct SchedTwoPass {
    static constexpr bool GATHER = false;
    const char* A0; const char* A1; const char* B0; const char* B1; unsigned lda2, ldb2; int nM, nN, G, c, rep;
    __device__ __forceinline__ bool next(int i, Unit& u) const { int L = (i >> 1) * G + c; if (L >= nM * nN * rep) return false; if (L >= nM * nN) L -= nM * nN; tile_of(L, nM, nN, u.pm, u.pn); u.z = i & 1; return true; }
    __device__ __forceinline__ const char* a_ptr(const Unit& u) const { return (u.z ? A1 : A0) + (size_t)u.pm * BM * lda2; }
    __device__ __forceinline__ const char* b_ptr(const Unit& u) const { return (u.z ? B1 : B0) + (size_t)u.pn * BM * ldb2; }
    __device__ __forceinline__ void a_off(const Unit&, const int (&R)[2], const int (&C)[2], unsigned (&v)[2][2]) const {
#pragma unroll
        for (int h = 0; h < 2; ++h)
#pragma unroll
            for (int i = 0; i < 2; ++i) v[h][i] = (unsigned)(h * HALF + R[i]) * lda2 + (unsigned)C[i] * 2u; }
};

typedef float f32x2_t __attribute__((ext_vector_type(2))); typedef __bf16 bf16x2_t __attribute__((ext_vector_type(2)));
__device__ __forceinline__ unsigned cvt_pk_bf16(float lo, float hi) { f32x2_t v = {lo, hi}; bf16x2_t b = __builtin_convertvector(v, bf16x2_t); return __builtin_bit_cast(unsigned, b); }
__device__ __forceinline__ float bf_lo(unsigned w) { return __uint_as_float(w << 16); }
__device__ __forceinline__ float bf_hi(unsigned w) { return __uint_as_float(w & 0xffff0000u); }
__device__ __forceinline__ float fsigm(float x) { return __builtin_amdgcn_rcpf(1.f + __builtin_amdgcn_exp2f(-1.4426950408889634f * x)); }
__device__ __forceinline__ u32x4 pack8(const f32x4& a, const f32x4& b) { u32x4 w; w.x = cvt_pk_bf16(a[0], a[1]); w.y = cvt_pk_bf16(a[2], a[3]); w.z = cvt_pk_bf16(b[0], b[1]); w.w = cvt_pk_bf16(b[2], b[3]); return w; }
__device__ __forceinline__ void unpack8(const u32x4& w, f32x4& a, f32x4& b) { a = (f32x4){bf_lo(w.x), bf_hi(w.x), bf_lo(w.y), bf_hi(w.y)}; b = (f32x4){bf_lo(w.z), bf_hi(w.z), bf_lo(w.w), bf_hi(w.w)}; }

typedef float f32x8 __attribute__((ext_vector_type(8)));
struct AccView4 { const f32x4 (&a)[2][2][4][2]; __device__ __forceinline__ f32x4 operator()(int ai, int bj, int m, int n) const { return a[ai][bj][m][n]; } };
struct AccView8 { const f32x8 (&a)[2][2][4];    __device__ __forceinline__ f32x4 operator()(int ai, int bj, int m, int n) const { return n ? __builtin_shufflevector(a[ai][bj][m], a[ai][bj][m], 4, 5, 6, 7) : __builtin_shufflevector(a[ai][bj][m], a[ai][bj][m], 0, 1, 2, 3); } };
__device__ __forceinline__ void glds16s(const char* sbase, unsigned voff, unsigned lds_dst) { unsigned keep;
    asm volatile("s_mov_b32 %0, m0\n\ts_mov_b32 m0, %3\n\ts_nop 4\n\tglobal_load_lds_dwordx4 %1, %2\n\ts_mov_b32 m0, %0" : "=&s"(keep) : "v"(voff), "s"(sbase), "s"(lds_dst) : "memory"); }
typedef int v8i32 __attribute__((ext_vector_type(8)));
typedef int v4i32 __attribute__((ext_vector_type(4)));
template <class Epi, class Sched, bool ALIGN_EPI = true, bool FP8 = false, bool MID = false>
__device__ __forceinline__ void gemm_phase(PG8_LAS unsigned char* lds, const int K, const Sched& S, const Epi& E, const int wave_id) {
    int lane_ = (int)__builtin_amdgcn_mbcnt_hi(~0u, __builtin_amdgcn_mbcnt_lo(~0u, 0u)); asm volatile("" : "+v"(lane_));
    const int lane = lane_, wid = wave_id, tid = wid * 64 + lane, wr = wid >> 2, wc = wid & 3, fr = lane & 15, fq = lane >> 4;
    const int nt = FP8 ? K / 128 : K / BK;
    int Rr[2], Cc[2]; unsigned voffB[2], voffA[2];
#pragma unroll
    for (int i = 0; i < 2; ++i) { stage_rc(tid * 16 + i * 8192, Rr[i], Cc[i]); const int Rb = Epi::PERM ? ((Rr[i] & ~31) + perm32(Rr[i] & 31)) : Rr[i];
        voffB[i] = (unsigned)Rb * S.ldb2 + (unsigned)Cc[i] * 2u; voffA[i] = (unsigned)Rr[i] * S.lda2 + (unsigned)Cc[i] * 2u; }
    const size_t ah = (size_t)HALF * S.lda2;
    const size_t a64 = (size_t)64 * S.lda2, b64 = (size_t)64 * S.ldb2;
    const size_t kstep = (size_t)(BK * 2);
    const size_t bh = (size_t)HALF * S.ldb2;
    const unsigned ldsw = (unsigned)wid * 1024u;
    const int aoff = FP8 ? lds_byte(wr * 64 + fr, fq * 16) : lds_byte(wr * 64 + fr, fq * 8), boff = FP8 ? lds_byte(wc * 32 + fr, fq * 16) : lds_byte(wc * 32 + fr, fq * 8);
#define PG8_SA(b, h) (((b) * 2 + (h)) * HTB)
#define PG8_SB(b, h) ((4 + (b) * 2 + (h)) * HTB)
#define PG8_STAGE2(bufoff, gbase, voff, r64) do { if constexpr (FP8) { _Pragma("unroll") for (int _i = 0; _i < 2; ++_i) glds16s(uptr((const char*)(gbase) + (size_t)_i * (r64)), (voff)[0], (unsigned)(size_t)(lds + (bufoff) + ldsw + _i * 8192)); } else _Pragma("unroll") for (int _i = 0; _i < 2; ++_i) \
        __builtin_amdgcn_global_load_lds((const unsigned*)((const char*)(gbase) + (size_t)_i * (r64) + (voff)[0]), (PG8_LAS unsigned*)(lds + (bufoff) + ldsw + _i * 8192), 16, 0, 0); } while (0)
#define PG8_STAGE(bufoff, gbase, voff) do { if constexpr (FP8) { _Pragma("unroll") for (int _i = 0; _i < 2; ++_i) glds16s(uptr((const char*)(gbase)), (voff)[_i], (unsigned)(size_t)(lds + (bufoff) + ldsw + _i * 8192)); } else _Pragma("unroll") for (int _i = 0; _i < 2; ++_i) \
        __builtin_amdgcn_global_load_lds((const unsigned*)((const char*)(gbase) + (voff)[_i]), (PG8_LAS unsigned*)(lds + (bufoff) + ldsw + _i * 8192), 16, 0, 0); } while (0)
#define PG8_STAGE_A(bufoff, h, gbase, TB) do { if constexpr (Sched::GATHER) { unsigned _vg[2]; _vg[0] = (TB)[(h) * HALF + Rr[0]] + (unsigned)Cc[0] * 2u; _vg[1] = (TB)[(h) * HALF + Rr[0] + 64] + (unsigned)Cc[0] * 2u; PG8_STAGE(bufoff, gbase, _vg); } \
        else { PG8_STAGE2(bufoff, (gbase) + (h) * ah, voffA, a64); } } while (0)
#define PG8_STAGE_B(bufoff, gbase) PG8_STAGE2(bufoff, gbase, voffB, b64)
#define PG8_LDA(dst, b, h) do { if constexpr (FP8) { _Pragma("unroll") for (int m = 0; m < 4; ++m) dst##8[m] = PG8_LD8(lds + PG8_SA(b, h) + aoff + m * 2048); } else { _Pragma("unroll") for (int m = 0; m < 4; ++m) _Pragma("unroll") for (int k = 0; k < 2; ++k) dst[m][k] = *(const PG8_LAS bf16x8*)(lds + PG8_SA(b, h) + aoff + m * 2048 + k * 1024); } } while (0)
#define PG8_LDB(dst, b, h) do { if constexpr (FP8) { _Pragma("unroll") for (int n = 0; n < 2; ++n) dst##8[n] = PG8_LD8(lds + PG8_SB(b, h) + boff + n * 2048); } else { _Pragma("unroll") for (int n = 0; n < 2; ++n) _Pragma("unroll") for (int k = 0; k < 2; ++k) dst[n][k] = *(const PG8_LAS bf16x8*)(lds + PG8_SB(b, h) + boff + n * 2048 + k * 1024); } } while (0)
#define PG8_LD8(p) __builtin_shufflevector(*(const PG8_LAS v4i32*)(p), *(const PG8_LAS v4i32*)((p) + 16), 0, 1, 2, 3, 4, 5, 6, 7)
#define PG8_F8(x) __builtin_shufflevector(__builtin_bit_cast(v4i32, (x)[0]), __builtin_bit_cast(v4i32, (x)[1]), 0, 1, 2, 3, 4, 5, 6, 7)
#define PG8_MMA(ai, bj, At, Bt) do { __builtin_amdgcn_s_setprio(1); if constexpr (FP8) { _Pragma("unroll") for (int m = 0; m < 4; ++m) { \
        const f32x4 _r0 = __builtin_amdgcn_mfma_scale_f32_16x16x128_f8f6f4(Bt##8[0], At##8[m], __builtin_shufflevector(acc8[ai][bj][m], acc8[ai][bj][m], 0, 1, 2, 3), 0, 0, 0, 0, 0, 0); \
        const f32x4 _r1 = __builtin_amdgcn_mfma_scale_f32_16x16x128_f8f6f4(Bt##8[1], At##8[m], __builtin_shufflevector(acc8[ai][bj][m], acc8[ai][bj][m], 4, 5, 6, 7), 0, 0, 0, 0, 0, 0); \
        acc8[ai][bj][m] = __builtin_shufflevector(_r0, _r1, 0, 1, 2, 3, 4, 5, 6, 7); } } else { \
        _Pragma("unroll") for (int m = 0; m < 4; ++m) _Pragma("unroll") for (int n = 0; n < 2; ++n) _Pragma("unroll") for (int k = 0; k < 2; ++k) \
        acc[ai][bj][m][n] = __builtin_amdgcn_mfma_f32_16x16x32_bf16(Bt[n][k], At[m][k], acc[ai][bj][m][n], 0, 0, 0); } __builtin_amdgcn_s_setprio(0); } while (0)
#define PG8_WAIT_V(n) asm volatile("s_waitcnt vmcnt(" #n ")" ::: "memory")
#define PG8_WAIT_L(n) asm volatile("s_waitcnt lgkmcnt(" #n ")" ::: "memory")
#define PG8_BAR __builtin_amdgcn_s_barrier()
#define PG8_SCHED __builtin_amdgcn_sched_barrier(0)
    Unit cur, nxt; int ui = 0;
    if (!S.next(0, cur)) return;
    cur.pm = __builtin_amdgcn_readfirstlane(cur.pm); cur.pn = __builtin_amdgcn_readfirstlane(cur.pn); cur.z = __builtin_amdgcn_readfirstlane(cur.z);
    f32x8 acc8[2][2][4];
    f32x4 acc[2][2][4][2];
#pragma unroll
    for (int a = 0; a < 2; ++a)
#pragma unroll
        for (int b = 0; b < 2; ++b)
#pragma unroll
            for (int m = 0; m < 4; ++m)
#pragma unroll
                for (int n = 0; n < 2; ++n) { acc[a][b][m][n] = (f32x4){0.f, 0.f, 0.f, 0.f}; acc8[a][b][m] = (f32x8){0.f, 0.f, 0.f, 0.f, 0.f, 0.f, 0.f, 0.f}; }
    bf16x8 At[4][2], B0[2][2], B1[2][2];
    v8i32 At8[4], B08[2], B18[2];
    PG8_LAS unsigned* gtab = (PG8_LAS unsigned*)(lds + STAGE_BYTES + 4096);
    PG8_LAS unsigned* vAc = gtab; PG8_LAS unsigned* vAn = gtab;
    if constexpr (Sched::GATHER) { if (tid < 256) gtab[tid] = S.row_off(cur, tid); asm volatile("s_waitcnt lgkmcnt(0)" ::: "memory"); PG8_BAR; }
    const char* cA = uptr(S.a_ptr(cur)); const char* cB = uptr(S.b_ptr(cur));
    PG8_STAGE_B(PG8_SB(0, 0), cB); PG8_STAGE_B(PG8_SB(0, 1), cB + bh); PG8_STAGE_A(PG8_SA(0, 0), 0, cA, vAc); PG8_STAGE_A(PG8_SA(0, 1), 1, cA, vAc);
    if (wr == 1) PG8_BAR;
    PG8_WAIT_V(2); PG8_BAR;
    PG8_STAGE_B(PG8_SB(1, 0), cB + kstep); PG8_STAGE_A(PG8_SA(1, 0), 0, cA + kstep, vAc); PG8_STAGE_B(PG8_SB(1, 1), cB + bh + kstep);
    PG8_WAIT_V(6); PG8_BAR;
    for (;;) {
        const bool has_next = S.next(ui + 1, nxt);
        nxt.pm = __builtin_amdgcn_readfirstlane(nxt.pm); nxt.pn = __builtin_amdgcn_readfirstlane(nxt.pn); nxt.z = __builtin_amdgcn_readfirstlane(nxt.z);
        const char* nA = cA; const char* nB = cB;
        if constexpr (Sched::GATHER) vAn = vAc;
        if (has_next) { nA = uptr(S.a_ptr(nxt)); nB = uptr(S.b_ptr(nxt)); if constexpr (Sched::GATHER) { vAn = gtab + ((ui + 1) & 1) * 256; if (tid < 256) vAn[tid] = S.row_off(nxt, tid); } }
#pragma unroll 1
        for (int t = 0; t < nt; t += 2) {
            if constexpr (MID) { if (t == (nt >> 1)) E.mid(acc, cur, wr, wc, fr, fq); }
            const bool last = (t == nt - 2);
            const char* a1 = cA + (size_t)(t + 1) * kstep;
            const char* a2 = last ? nA : cA + (size_t)(t + 2) * kstep; const char* b2 = last ? nB : cB + (size_t)(t + 2) * kstep;
            const char* a3 = a2 + kstep; const char* b3 = b2 + kstep;
            PG8_LAS unsigned* v2 = last ? vAn : vAc;
            PG8_LDB(B0, 0, 0); PG8_LDB(B1, 0, 1); PG8_SCHED; PG8_LDA(At, 0, 0); PG8_STAGE_A(PG8_SA(1, 1), 1, a1, vAc);
            PG8_WAIT_V(8); PG8_WAIT_L(0); PG8_BAR; PG8_MMA(0, 0, At, B0); PG8_MMA(0, 1, At, B1); PG8_BAR; PG8_SCHED;
            PG8_LDA(At, 0, 1); PG8_STAGE_B(PG8_SB(0, 0), b2); PG8_STAGE_B(PG8_SB(0, 1), b2 + bh); PG8_STAGE_A(PG8_SA(0, 0), 0, a2, v2);
            PG8_WAIT_V(8); PG8_WAIT_L(0); PG8_BAR; PG8_MMA(1, 0, At, B0); PG8_MMA(1, 1, At, B1); PG8_BAR; PG8_SCHED;
            PG8_LDB(B0, 1, 0); PG8_LDB(B1, 1, 1); PG8_SCHED; PG8_LDA(At, 1, 0); PG8_STAGE_A(PG8_SA(0, 1), 1, a2, v2);
            PG8_WAIT_V(8); PG8_WAIT_L(0); PG8_BAR; PG8_MMA(0, 0, At, B0); PG8_MMA(0, 1, At, B1); PG8_BAR; PG8_SCHED;
            PG8_LDA(At, 1, 1); PG8_STAGE_B(PG8_SB(1, 0), b3); PG8_STAGE_B(PG8_SB(1, 1), b3 + bh); PG8_STAGE_A(PG8_SA(1, 0), 0, a3, v2);
            PG8_WAIT_V(8); PG8_WAIT_L(0); PG8_BAR; PG8_MMA(1, 0, At, B0); PG8_MMA(1, 1, At, B1); PG8_BAR; PG8_SCHED;
        }
        if constexpr (ALIGN_EPI) { if (wr == 0) PG8_BAR; }
        { int fr_o = fr, fq_o = fq; asm volatile("" : "+v"(fr_o), "+v"(fq_o));
          if constexpr (FP8) E(AccView8{acc8}, cur, wr, wc, fr_o, fq_o); else E(AccView4{acc}, cur, wr, wc, fr_o, fq_o); }
        if (!has_next) break;
#pragma unroll
        for (int a = 0; a < 2; ++a)
#pragma unroll
            for (int b = 0; b < 2; ++b)
#pragma unroll
                for (int m = 0; m < 4; ++m)
#pragma unroll
                    for (int n = 0; n < 2; ++n) { acc[a][b][m][n] = (f32x4){0.f, 0.f, 0.f, 0.f}; acc8[a][b][m] = (f32x8){0.f, 0.f, 0.f, 0.f, 0.f, 0.f, 0.f, 0.f}; }
        cur = nxt; cA = nA; cB = nB; ++ui;
        if constexpr (Sched::GATHER) vAc = vAn;
        if constexpr (ALIGN_EPI) { if (wr == 1) PG8_BAR; }
    }
    PG8_WAIT_V(0);
    if constexpr (!ALIGN_EPI) { if (wr == 0) PG8_BAR; }
    PG8_BAR;
#undef PG8_SA
#undef PG8_SB
#undef PG8_STAGE
#undef PG8_STAGE2
#undef PG8_STAGE_B
#undef PG8_STAGE_A
#undef PG8_LDA
#undef PG8_LDB
#undef PG8_MMA
#undef PG8_F8
#undef PG8_LD8
#undef PG8_WAIT_V
#undef PG8_WAIT_L
#undef PG8_BAR
#undef PG8_SCHED
}
}

#define XB_TMO      128
#define XB_XCNT(j)  (256  + 64 * (j))
#define XB_XSUB(j)  (1280 + 64 * (j))
#define XB_XGEN(j)  (2304 + 64 * (j))
#define XB_TOP      3328
#define XB_TOPGEN   3392
#define XCD_BAR_WORDS 3456
#define XB_SPIN_CAP (1u << 18)
#define LAS __attribute__((address_space(3)))

__device__ __forceinline__ unsigned xb_ld(unsigned* p)              { return __hip_atomic_load(p, __ATOMIC_RELAXED, __HIP_MEMORY_SCOPE_AGENT); }
__device__ __forceinline__ unsigned xb_add(unsigned* p, unsigned v) { return __hip_atomic_fetch_add(p, v, __ATOMIC_RELAXED, __HIP_MEMORY_SCOPE_AGENT); }
__device__ __forceinline__ unsigned xb_xcc_id() { return (unsigned)__builtin_amdgcn_s_getreg((3 << 11) | 20) & 0xFu; }
#define XB_SPIN(cond, bar) do { unsigned _sp = 0; while (cond) { __builtin_amdgcn_s_sleep(1); \
    if ((++_sp & 255u) == 0u) { if (xb_ld(&(bar)[XB_TMO])) break; if (_sp > XB_SPIN_CAP) { atomicAdd(&(bar)[XB_TMO], 1u); break; } } } } while (0)

struct XcdBarrier {
    unsigned* bar; unsigned x;
    volatile LAS unsigned* st;
    bool t0;
};

__device__ __forceinline__ XcdBarrier xcd_barrier_post(unsigned* bar, volatile LAS unsigned* st) {
    XcdBarrier b; b.bar = bar; b.x = xb_xcc_id(); b.st = st;
    if (threadIdx.x == 0) (void)xb_add(&bar[XB_XCNT(b.x)], 1u);
    return b;
}
__device__ __forceinline__ void xcd_barrier_complete(unsigned* bar, unsigned x, unsigned& nloc, unsigned& nx) {
    const unsigned G = gridDim.x * gridDim.y * gridDim.z;
    unsigned sum, cnt, mine, sp = 0u;
    for (;;) {
        sum = 0u; cnt = 0u; mine = 0u;
#pragma unroll
        for (unsigned j = 0; j < 16; ++j) { const unsigned c = xb_ld(&bar[XB_XCNT(j)]); sum += c; cnt += (c > 0u) ? 1u : 0u; mine = (j == x) ? c : mine; }
        if (sum == G) break;
        __builtin_amdgcn_s_sleep(1);
        if ((++sp & 255u) == 0u) { if (xb_ld(&bar[XB_TMO])) break; if (sp > XB_SPIN_CAP) { atomicAdd(&bar[XB_TMO], 1u); break; } }
    }
    nloc = mine > 0u ? mine : 1u; nx = cnt > 0u ? cnt : 1u;
}

__device__ __forceinline__ void xcd_barrier(const XcdBarrier& b) {
    asm volatile("s_waitcnt vmcnt(0)" ::: "memory");
    __syncthreads();
    if (b.t0) {
        unsigned* bar = b.bar;
        __builtin_amdgcn_s_waitcnt(0);
        unsigned nloc = b.st[0], nx = b.st[1];
        if (nloc == 0u) { xcd_barrier_complete(bar, b.x, nloc, nx); b.st[0] = nloc; b.st[1] = nx; }
        const unsigned old = xb_add(&bar[XB_XSUB(b.x)], 1u);
        const unsigned gen = old / nloc;
        if (old + 1u == (gen + 1u) * nloc) {
            __builtin_amdgcn_fence(__ATOMIC_RELEASE, "agent");
            asm volatile("s_waitcnt vmcnt(0)" ::: "memory");
            const unsigned og = xb_add(&bar[XB_TOP], 1u);
            const unsigned tg = og / nx;
            if (og + 1u == (tg + 1u) * nx) xb_add(&bar[XB_TOPGEN], 1u);
            else XB_SPIN(xb_ld(&bar[XB_TOPGEN]) == tg, bar);
            __builtin_amdgcn_fence(__ATOMIC_ACQUIRE, "agent");
            xb_add(&bar[XB_XGEN(b.x)], 1u);
            asm volatile("s_waitcnt vmcnt(0)" ::: "memory");
        } else {
            XB_SPIN(xb_ld(&bar[XB_XGEN(b.x)]) == gen, bar);
            __builtin_amdgcn_fence(__ATOMIC_ACQUIRE, "agent");
            asm volatile("s_waitcnt vmcnt(0)" ::: "memory");
        }
    }
    __syncthreads();
}


constexpr int NWAVES = 8;
constexpr int T = 16384, D = 2048, RW = 1024, NH = 8, DH = 128, SG = 64, SP = 64, SC = 16, NE = 32, FE = 512, PLE = 256, INC = 5120;
constexpr int N1 = 9216;
constexpr int S5L = 16, S5NC = T / S5L, S5K = 384;
constexpr int RSC = 32, RCH = 8;
constexpr float EPS = 1e-6f;

constexpr size_t MiB = 1u << 20;
constexpr size_t WS_CTL = 0, CTL_ZERO_BYTES = 1 * MiB;
constexpr size_t WS_LIST = 1 * MiB, WS_WGT = 3 * MiB, WS_RINV = 3 * MiB + 256 * 1024, WS_LAM = 3 * MiB + 512 * 1024;
constexpr size_t WS_COS = 4 * MiB, WS_SIN = 8 * MiB, WS_PB = 12 * MiB;
constexpr size_t WS_WT1 = 20 * MiB, WS_WGLU = 56 * MiB, WS_WA = 58 * MiB, WS_WB = 62 * MiB, WS_WOUT = 66 * MiB, WS_WPG = 74 * MiB, WS_WP = 82 * MiB, WS_BTC = 83 * MiB, WS_BLT = 95 * MiB;
constexpr size_t WS_HB = 100 * MiB, WS_YRET = 100 * MiB, WS_YPRE = 132 * MiB;
constexpr size_t WS_Q = 164 * MiB, WS_K = 196 * MiB, WS_V = 228 * MiB, WS_G = 260 * MiB, WS_UA = 292 * MiB, WS_EST = 340 * MiB, WS_KVS = 372 * MiB;
constexpr size_t WS_MERGED = 164 * MiB, WS_YSSM = 228 * MiB;
constexpr size_t WS_END = 600 * MiB;
constexpr int CW_TMO = 0, CW_CODE = 1, CW_BAR = 4096, CW_Q0 = 8192  , CW_CNT = 8256  ;

constexpr int RING_OFF = 0, RING_BYTES = 131072;
constexpr int LDSCTL_OFF = RING_BYTES, MISC_OFF = LDSCTL_OFF + 320;
constexpr int LDS_BYTES = 147456;

#define GAS __attribute__((address_space(1)))
typedef unsigned short bf16;
typedef unsigned v4u __attribute__((ext_vector_type(4)));
typedef unsigned v2u __attribute__((ext_vector_type(2)));
typedef float f32x4 __attribute__((ext_vector_type(4)));
typedef short bf16x8 __attribute__((ext_vector_type(8)));
typedef short s16x4 __attribute__((ext_vector_type(4)));
typedef short v4i16_t __attribute__((ext_vector_type(4)));
typedef GAS unsigned gu32;
#define RLX_AGENT __ATOMIC_RELAXED, __HIP_MEMORY_SCOPE_AGENT
#define LDS_WAIT() asm volatile("s_waitcnt lgkmcnt(0)" ::: "memory")
#define VM_WAIT() asm volatile("s_waitcnt vmcnt(0)" ::: "memory")
using pg8::cvt_pk_bf16; using pg8::bf_lo; using pg8::bf_hi; using pg8::fsigm;

__device__ __forceinline__ int flane_opaque() { int l = (int)__builtin_amdgcn_mbcnt_hi(~0u, __builtin_amdgcn_mbcnt_lo(~0u, 0u)); asm volatile("" : "+v"(l)); return l; }
#define FLANE (flane_opaque())
#define FTID (F.wave * 64 + FLANE)
struct Frame {
    LAS unsigned char* lds;
    volatile LAS unsigned* MISC;
    unsigned* ctl;
    int wave, G;
};
__device__ __forceinline__ float wave_sum(float v) {
#pragma unroll
    for (int o = 1; o < 64; o <<= 1) v += __shfl_xor(v, o);
    return v;
}
__device__ __forceinline__ int wg_next_item(Frame& F, unsigned* ctr) {
    __syncthreads();
    if (FTID == 0) F.MISC[16] = __hip_atomic_fetch_add(ctr, 1u, RLX_AGENT);
    __syncthreads();
    return (int)F.MISC[16];
}
__device__ __forceinline__ unsigned wq_begin(Frame& F, unsigned* ctr) { unsigned nx = 0u; if (FTID == 0) nx = __hip_atomic_fetch_add(ctr, 1u, RLX_AGENT); return nx; }
__device__ __forceinline__ int wq_end(Frame& F, unsigned nx) {
    __syncthreads();
    if (FTID == 0) F.MISC[16] = nx;
    __syncthreads();
    return (int)F.MISC[16];
}

__device__ __forceinline__ unsigned pk4_fp8(float a, float b, float c2, float d) { int w = 0; w = __builtin_amdgcn_cvt_pk_fp8_f32(a, b, w, false); w = __builtin_amdgcn_cvt_pk_fp8_f32(c2, d, w, true); return (unsigned)w; }
template <int MODE, bool F8 = false>
__device__ __forceinline__ void transpose_item(const float* W, int K, int N, void* WTv, int ldt, int row_off, LAS unsigned char* scr, int item, int lane, const float* kscale = nullptr, float f8scale = 1.f, int ncols = 0) {
    const int nblk = (ncols ? ncols : N) / 64, kb = item / nblk, nb = item % nblk, k0 = 64 * kb, n0 = 64 * nb;
    const float* src = W + (size_t)(k0 + (lane >> 4)) * N + n0 + (lane & 15) * 4;
    f32x4 v[16];
#pragma unroll
    for (int i = 0; i < 16; ++i) v[i] = *(const f32x4*)(src + (size_t)(4 * i) * N);
    __builtin_amdgcn_sched_barrier(0);
#pragma unroll
    for (int i = 0; i < 16; ++i) { const int k = 4 * i + (lane >> 4); f32x4 a = v[i]; if (kscale) a = a * kscale[k0 + k];
        v2u o; o.x = cvt_pk_bf16(a[0], a[1]); o.y = cvt_pk_bf16(a[2], a[3]); *(LAS v2u*)(scr + k * 144 + (lane & 15) * 8) = o; }
    LDS_WAIT(); asm volatile("" ::: "memory");
    const int i16 = lane & 15, g = lane >> 4, q = (lane & 15) >> 2, p = lane & 3;
#pragma unroll
    for (int nt = 0; nt < 4; ++nt) {
        s16x4 r[4];
#pragma unroll
        for (int t = 0; t < 4; ++t) r[t] = __builtin_bit_cast(s16x4, __builtin_amdgcn_ds_read_tr16_b64_v4i16((LAS v4i16_t*)(scr + (16 * g + 4 * t + q) * 144 + (16 * nt + 4 * p) * 2)));
        const int nn = n0 + 16 * nt + i16; const int row = MODE == 0 ? row_off + nn : (MODE == 1 ? 8 * (nn >> 2) + (nn & 3) : 8 * (nn >> 2) + 4 + (nn & 3));
        if constexpr (F8) { unsigned w[4];
#pragma unroll
            for (int t = 0; t < 4; ++t) w[t] = pk4_fp8(__uint_as_float((unsigned)(unsigned short)r[t][0] << 16) * f8scale, __uint_as_float((unsigned)(unsigned short)r[t][1] << 16) * f8scale, __uint_as_float((unsigned)(unsigned short)r[t][2] << 16) * f8scale, __uint_as_float((unsigned)(unsigned short)r[t][3] << 16) * f8scale);
            *(GAS v4u*)((unsigned char*)WTv + (size_t)row * ldt + k0 + 16 * g) = (v4u){w[0], w[1], w[2], w[3]};
        } else { bf16* WT = (bf16*)WTv;
            *(GAS bf16x8*)(WT + (size_t)row * ldt + k0 + 16 * g) = (bf16x8){r[0][0], r[0][1], r[0][2], r[0][3], r[1][0], r[1][1], r[1][2], r[1][3]};
            *(GAS bf16x8*)(WT + (size_t)row * ldt + k0 + 16 * g + 8) = (bf16x8){r[2][0], r[2][1], r[2][2], r[2][3], r[3][0], r[3][1], r[3][2], r[3][3]}; } }
    LDS_WAIT(); asm volatile("" ::: "memory");
}
#define CONV_JOB(q_, src_, dst_, N_, ldt_, mode_, k0_, n0_, sc_) { const int e_ = __builtin_amdgcn_readfirstlane((q_) / 96), r_ = __builtin_amdgcn_readfirstlane((q_) % 96), mtx_ = r_ >> 5, sub_ = (r_ & 31) * 8 + wave; \
        if (mtx_ < 2) { src_ = (mtx_ == 0 ? WEG : WEU) + (size_t)e_ * D * FE; N_ = FE; dst_ = WGU8 + (size_t)e_ * 1024 * D; ldt_ = D; mode_ = 1 + mtx_; sc_ = 64.f; } \
        else { src_ = WED + (size_t)e_ * FE * D; N_ = D; dst_ = WDN8 + (size_t)e_ * D * FE; ldt_ = FE; mode_ = 0; sc_ = 32.f; } \
        const int nblk_ = N_ >> 6, kb_ = sub_ / nblk_, nb_ = sub_ % nblk_; k0_ = 64 * kb_; n0_ = 64 * nb_; }
__device__ __forceinline__ void conv_stream(int wave, int lane, LAS unsigned char* scr, int first, int stride, int total, const float* WEG, const float* WEU, const float* WED, unsigned char* WGU8, unsigned char* WDN8) {
    if (first >= total) return;
    const float* src; unsigned char* dst; int N, ldt, mode, k0, n0; float sc;
    CONV_JOB(first, src, dst, N, ldt, mode, k0, n0, sc)
    f32x4 v[16];
    { const float* sp = src + (size_t)(k0 + (lane >> 4)) * N + n0 + (lane & 15) * 4;
#pragma unroll
      for (int i = 0; i < 16; ++i) v[i] = *(const f32x4*)(sp + (size_t)(4 * i) * N); }
#pragma unroll 1
    for (int q = first; q < total; q += stride) {
#pragma unroll
        for (int i = 0; i < 16; ++i) { const int k = 4 * i + (lane >> 4); const f32x4 a = v[i];
            v2u o; o.x = cvt_pk_bf16(a[0], a[1]); o.y = cvt_pk_bf16(a[2], a[3]); *(LAS v2u*)(scr + k * 144 + (lane & 15) * 8) = o; }
        const int qn = q + stride < total ? q + stride : q;
        const float* srcn; unsigned char* dstn; int Nn, ldtn, moden, k0n, n0n; float scn;
        CONV_JOB(qn, srcn, dstn, Nn, ldtn, moden, k0n, n0n, scn)
        { const float* sp = srcn + (size_t)(k0n + (lane >> 4)) * Nn + n0n + (lane & 15) * 4;
#pragma unroll
          for (int i = 0; i < 16; ++i) v[i] = *(const f32x4*)(sp + (size_t)(4 * i) * Nn); }
        LDS_WAIT(); asm volatile("" ::: "memory");
        const int i16 = lane & 15, g = lane >> 4, qd = (lane & 15) >> 2, p = lane & 3;
#pragma unroll
        for (int nt = 0; nt < 4; ++nt) {
            s16x4 r[4];
#pragma unroll
            for (int t = 0; t < 4; ++t) r[t] = __builtin_bit_cast(s16x4, __builtin_amdgcn_ds_read_tr16_b64_v4i16((LAS v4i16_t*)(scr + (16 * g + 4 * t + qd) * 144 + (16 * nt + 4 * p) * 2)));
            const int nn = n0 + 16 * nt + i16; const int row = mode == 0 ? nn : 8 * (nn >> 2) + (nn & 3) + (mode == 2 ? 4 : 0);
            unsigned w[4];
#pragma unroll
            for (int t = 0; t < 4; ++t) w[t] = pk4_fp8(__uint_as_float((unsigned)(unsigned short)r[t][0] << 16) * sc, __uint_as_float((unsigned)(unsigned short)r[t][1] << 16) * sc, __uint_as_float((unsigned)(unsigned short)r[t][2] << 16) * sc, __uint_as_float((unsigned)(unsigned short)r[t][3] << 16) * sc);
            *(GAS v4u*)(dst + (size_t)row * ldt + k0 + 16 * g) = (v4u){w[0], w[1], w[2], w[3]}; }
        LDS_WAIT(); asm volatile("" ::: "memory");
        src = srcn; dst = dstn; N = Nn; ldt = ldtn; mode = moden; k0 = k0n; n0 = n0n; sc = scn;
    }
}
__device__ __forceinline__ void rms_row_to_bf16(int lane, const float* xrow, const float* w, bf16* orow, unsigned char* o8row) {
    const GAS f32x4* xr = (const GAS f32x4*)xrow + lane; const GAS f32x4* wr = (const GAS f32x4*)w + lane;
    f32x4 v[8]; float s = 0.f;
#pragma unroll
    for (int j = 0; j < 8; ++j) { v[j] = xr[64 * j]; s += (v[j].x * v[j].x + v[j].y * v[j].y) + (v[j].z * v[j].z + v[j].w * v[j].w); }
    const float r = rsqrtf(wave_sum(s) * (1.f / D) + EPS);
    GAS v2u* o8 = (GAS v2u*)orow + lane;
#pragma unroll
    for (int j = 0; j < 8; ++j) { const f32x4 ww = wr[64 * j]; const f32x4 h = (f32x4){v[j].x * r * ww.x, v[j].y * r * ww.y, v[j].z * r * ww.z, v[j].w * r * ww.w};
        v2u o; o.x = cvt_pk_bf16(h[0], h[1]); o.y = cvt_pk_bf16(h[2], h[3]); o8[64 * j] = o;
        ((GAS unsigned*)o8row)[lane + 64 * j] = pk4_fp8(h[0] * 4.f, h[1] * 4.f, h[2] * 4.f, h[3] * 4.f); }
}
__device__ __forceinline__ void s5_tables(Frame& F, int g, const float* lam_re, const float* lam_im, const float* log_dt, const float* b_re, const float* b_im, const float* c_re, const float* c_im, const float* dvec,
                                          bf16* BTC, bf16* BLT, float* LAMT) {
    LAS double* PW = (LAS double*)(F.lds);
    LAS double* BB = (LAS double*)(F.lds + 17408);
    LAS double* CC = (LAS double*)(F.lds + 33792);
    LAS float* KM = (LAS float*)(F.lds + 50176);
    const int tid = FTID;
    if (tid < 64) {
        const int p = tid; const double lr = fmin((double)lam_re[g * SP + p], -1e-4), li = (double)lam_im[g * SP + p], dt = exp((double)log_dt[g]);
        for (int j = 0; j <= 16; ++j) { const double mag = exp((double)j * lr * dt); double sn, cs; sincos((double)j * li * dt, &sn, &cs); PW[(j * 64 + p) * 2] = mag * cs; PW[(j * 64 + p) * 2 + 1] = mag * sn; }
        { const double mag = exp(512.0 * lr * dt); double sn, cs; sincos(512.0 * li * dt, &sn, &cs);
          LAMT[(g * 64 + p) * 4 + 2] = (float)(mag * cs); LAMT[(g * 64 + p) * 4 + 3] = (float)(mag * sn); }
        const double lbr = PW[(1 * 64 + p) * 2], lbi = PW[(1 * 64 + p) * 2 + 1];
        LAMT[(g * 64 + p) * 4 + 0] = (float)PW[(16 * 64 + p) * 2]; LAMT[(g * 64 + p) * 4 + 1] = (float)PW[(16 * 64 + p) * 2 + 1];
        const double nr = lbr - 1.0, ni = lbi, den = lr * lr + li * li; const double fr = (nr * lr + ni * li) / den, fi = (ni * lr - nr * li) / den;
        for (int c = 0; c < 16; ++c) { const double br = b_re[(g * SP + p) * SC + c], bi = b_im[(g * SP + p) * SC + c]; BB[(p * 16 + c) * 2] = fr * br - fi * bi; BB[(p * 16 + c) * 2 + 1] = fr * bi + fi * br; }
    }
    for (int idx = tid; idx < 1024; idx += 512) { const int c = idx >> 6, p = idx & 63; CC[idx * 2] = (double)c_re[(g * SC + c) * SP + p]; CC[idx * 2 + 1] = (double)c_im[(g * SC + c) * SP + p]; }
    __syncthreads();
    for (int idx = tid; idx < 4096; idx += 512) { const int j = idx >> 8, c = (idx >> 4) & 15, c2 = idx & 15; double s = 0.0;
        for (int p = 0; p < 64; ++p) { const double cr = CC[(c * 64 + p) * 2], ci = CC[(c * 64 + p) * 2 + 1], pr = PW[(j * 64 + p) * 2], pi = PW[(j * 64 + p) * 2 + 1];
            const double ar = cr * pr - ci * pi, ai = cr * pi + ci * pr; s += ar * BB[(p * 16 + c2) * 2] - ai * BB[(p * 16 + c2) * 2 + 1]; }
        if (j == 0 && c == c2) s += (double)dvec[g * SC + c];
        KM[idx] = (float)s; }
    __syncthreads();
    for (int idx = tid; idx < 256 * 48; idx += 512) { const int n = idx / 48, kc = idx % 48, s = n >> 4, c = n & 15; float v[8];
        if (kc < 32) { const int t = kc >> 1, c0 = (kc & 1) * 8;
#pragma unroll
            for (int j = 0; j < 8; ++j) v[j] = (t <= s) ? KM[((s - t) * 16 + c) * 16 + c0 + j] : 0.f;
        } else { const int q = kc - 32, part = q >> 3, p0 = (q & 7) * 8;
#pragma unroll
            for (int j = 0; j < 8; ++j) { const int p = p0 + j; const double cr = CC[(c * 64 + p) * 2], ci = CC[(c * 64 + p) * 2 + 1], pr = PW[((s + 1) * 64 + p) * 2], pi = PW[((s + 1) * 64 + p) * 2 + 1];
                v[j] = part ? (float)(-(cr * pi + ci * pr)) : (float)(cr * pr - ci * pi); } }
        v4u o; o.x = cvt_pk_bf16(v[0], v[1]); o.y = cvt_pk_bf16(v[2], v[3]); o.z = cvt_pk_bf16(v[4], v[5]); o.w = cvt_pk_bf16(v[6], v[7]);
        *(GAS v4u*)(BTC + ((size_t)(g * 256 + n) * S5K + kc * 8)) = o; }
    for (int idx = tid; idx < 128 * 32; idx += 512) { const int n = idx >> 5, kc = idx & 31, p = n & 63, part = n >> 6, t = kc >> 1, c0 = (kc & 1) * 8; float v[8];
        const double pr = PW[((15 - t) * 64 + p) * 2], pi = PW[((15 - t) * 64 + p) * 2 + 1];
#pragma unroll
        for (int j = 0; j < 8; ++j) { const double br = BB[(p * 16 + c0 + j) * 2], bi = BB[(p * 16 + c0 + j) * 2 + 1]; v[j] = part ? (float)(pr * bi + pi * br) : (float)(pr * br - pi * bi); }
        v4u o; o.x = cvt_pk_bf16(v[0], v[1]); o.y = cvt_pk_bf16(v[2], v[3]); o.z = cvt_pk_bf16(v[4], v[5]); o.w = cvt_pk_bf16(v[6], v[7]);
        *(GAS v4u*)(BLT + ((size_t)(g * 128 + n) * 256 + kc * 8)) = o; }
    __syncthreads();
}

using pg8::Unit; using pg8::pack8; using pg8::unpack8;
struct EpiProj {
    static constexpr bool PERM = true;
    bf16* QKVG; bf16* UA; bf16* GATES;
    template <class AV> __device__ __forceinline__ void operator()(const AV& acc, const Unit& u, int wr, int wc, int fr, int fq) const {
        const int row0 = u.pm * 256 + wr * 64 + fr, ct = wc * 32 + 8 * fq;
        if (u.pn < 16) { bf16* dst = QKVG + (size_t)(u.pn >> 2) * T * RW + (u.pn & 3) * 256 + ct;
#pragma unroll
            for (int ai = 0; ai < 2; ++ai)
#pragma unroll
                for (int m = 0; m < 4; ++m) { const size_t row = row0 + ai * 128 + m * 16;
#pragma unroll
                    for (int bj = 0; bj < 2; ++bj) *(v4u*)(dst + row * RW + bj * 128) = pack8(acc(ai, bj, m, 0), acc(ai, bj, m, 1)); }
        } else if (u.pn < 20) {
#pragma unroll
            for (int ai = 0; ai < 2; ++ai)
#pragma unroll
                for (int m = 0; m < 4; ++m) { const int row = row0 + ai * 128 + m * 16, ci = row >> 4, s = row & 15;
#pragma unroll
                    for (int bj = 0; bj < 2; ++bj) { const int cu = (u.pn - 16) * 256 + bj * 128 + ct, g = cu >> 4, c0 = cu & 15;
                        *(v4u*)(UA + ((size_t)(g * S5NC + ci) * S5K + 16 * s + c0)) = pack8(acc(ai, bj, m, 0), acc(ai, bj, m, 1)); } }
        } else { bf16* dst = GATES + (u.pn - 20) * 256 + ct;
#pragma unroll
            for (int ai = 0; ai < 2; ++ai)
#pragma unroll
                for (int m = 0; m < 4; ++m) { const size_t row = row0 + ai * 128 + m * 16;
#pragma unroll
                    for (int bj = 0; bj < 2; ++bj) { f32x4 a = acc(ai, bj, m, 0), b = acc(ai, bj, m, 1);
#pragma unroll
                        for (int j = 0; j < 4; ++j) { a[j] = fsigm(a[j]); b[j] = fsigm(b[j]); }
                        *(v4u*)(dst + row * 4096 + bj * 128) = pack8(a, b); } }
        }
    }
};
struct EpiGates {
    static constexpr bool PERM = true;
    bf16* RHO; bf16* G1;
    template <class AV> __device__ __forceinline__ void operator()(const AV& acc, const Unit& u, int wr, int wc, int fr, int fq) const {
        const int row0 = u.pm * 256 + wr * 64 + fr, j0 = u.pn * 128 + wc * 32 + 8 * fq;
#pragma unroll
        for (int ai = 0; ai < 2; ++ai)
#pragma unroll
            for (int m = 0; m < 4; ++m) { const size_t row = row0 + ai * 128 + m * 16;
                f32x4 a0 = acc(ai, 0, m, 0) * (1.f / 256.f), a1 = acc(ai, 0, m, 1) * (1.f / 256.f), b0 = acc(ai, 1, m, 0) * (1.f / 256.f), b1 = acc(ai, 1, m, 1) * (1.f / 256.f);
#pragma unroll
                for (int j = 0; j < 4; ++j) { const float s0 = fsigm(a0[j]), s1 = fsigm(b0[j]); b0[j] = s1; a0[j] = s0 * __builtin_amdgcn_rcpf(s1);
                    const float t0 = fsigm(a1[j]), t1 = fsigm(b1[j]); b1[j] = t1; a1[j] = t0 * __builtin_amdgcn_rcpf(t1); }
                *(v4u*)(RHO + row * D + j0) = pack8(a0, a1); *(v4u*)(G1 + row * D + j0) = pack8(b0, b1); }
    }
};
struct EpiS5A {
    static constexpr bool PERM = false;
    float* EST;
    template <class AV> __device__ __forceinline__ void operator()(const AV& acc, const Unit& u, int wr, int wc, int fr, int fq) const {
        const int row0 = u.pm * 256 + wr * 64 + fr, col0 = wc * 32 + 4 * fq;
#pragma unroll
        for (int ai = 0; ai < 2; ++ai)
#pragma unroll
            for (int m = 0; m < 4; ++m) { float* rowp = EST + ((size_t)u.z * S5NC + row0 + ai * 128 + m * 16) * 128 + col0;
#pragma unroll
                for (int n = 0; n < 2; ++n) *(f32x4*)(rowp + n * 16) = acc(ai, 0, m, n); }
    }
};
struct EpiS5C {
    static constexpr bool PERM = true;
    bf16* YPRE;
    template <class AV> __device__ __forceinline__ void operator()(const AV& acc, const Unit& u, int wr, int wc, int fr, int fq) const {
        const int row0 = u.pm * 256 + wr * 64 + fr, ct = wc * 32 + 8 * fq;
        bf16* yb = YPRE + ((size_t)row0 * 16 * RW + u.z * 16);
#pragma unroll
        for (int ai = 0; ai < 2; ++ai)
#pragma unroll
            for (int m = 0; m < 4; ++m) {
#pragma unroll
                for (int bj = 0; bj < 2; ++bj) { const int col = bj * 128 + ct, s = col >> 4, c0 = col & 15;
                    f32x4 a = acc(ai, bj, m, 0), b = acc(ai, bj, m, 1);
#pragma unroll
                    for (int j = 0; j < 4; ++j) { const float xa = a[j], xb = b[j];
                        a[j] = xa * fsigm(1.5957691216057308f * (xa + 0.044715f * xa * xa * xa)); b[j] = xb * fsigm(1.5957691216057308f * (xb + 0.044715f * xb * xb * xb)); }
                    *(v4u*)(yb + (size_t)(ai * 128 + m * 16) * 16 * RW + (size_t)s * RW + c0) = pack8(a, b); } }
    }
};
struct EpiGlu {
    static constexpr bool PERM = true;
    const bf16* YPRE; bf16* YSSM;
    template <class AV> __device__ __forceinline__ void operator()(const AV& acc, const Unit& u, int wr, int wc, int fr, int fq) const {
        const int row0 = u.pm * 256 + wr * 64 + fr, col0 = u.pn * 256 + wc * 32 + 8 * fq;
#pragma unroll
        for (int ai = 0; ai < 2; ++ai) { v4u yw[4][2];
#pragma unroll
            for (int m = 0; m < 4; ++m)
#pragma unroll
                for (int bj = 0; bj < 2; ++bj) yw[m][bj] = *(const v4u*)(YPRE + (size_t)(row0 + ai * 128 + m * 16) * RW + col0 + bj * 128);
            __builtin_amdgcn_sched_barrier(0);
#pragma unroll
            for (int m = 0; m < 4; ++m)
#pragma unroll
                for (int bj = 0; bj < 2; ++bj) { f32x4 y0, y1; unpack8(yw[m][bj], y0, y1); f32x4 a = acc(ai, bj, m, 0), b = acc(ai, bj, m, 1);
#pragma unroll
                    for (int j = 0; j < 4; ++j) { a[j] = y0[j] * fsigm(a[j]); b[j] = y1[j] * fsigm(b[j]); }
                    *(v4u*)(YSSM + (size_t)(row0 + ai * 128 + m * 16) * (2 * RW) + col0 + bj * 128) = pack8(a, b); }
            __builtin_amdgcn_sched_barrier(0); }
    }
};
struct EpiMerge1 {
    static constexpr bool PERM = true;
    const bf16* RHO; const bf16* G1; unsigned char* M8;
    __device__ __forceinline__ void mid(f32x4 (&acc)[2][2][4][2], const Unit& u, int wr, int wc, int fr, int fq) const {
        const int row0 = u.pm * 256 + wr * 64 + fr, col0 = u.pn * 256 + wc * 32 + 8 * fq;
#pragma unroll
        for (int ai = 0; ai < 2; ++ai) { v4u rw[4][2];
#pragma unroll
            for (int m = 0; m < 4; ++m)
#pragma unroll
                for (int bj = 0; bj < 2; ++bj) rw[m][bj] = *(const v4u*)(RHO + (size_t)(row0 + ai * 128 + m * 16) * D + col0 + bj * 128);
            __builtin_amdgcn_sched_barrier(0);
#pragma unroll
            for (int m = 0; m < 4; ++m)
#pragma unroll
                for (int bj = 0; bj < 2; ++bj) { f32x4 r0, r1; unpack8(rw[m][bj], r0, r1); acc[ai][bj][m][0] *= r0; acc[ai][bj][m][1] *= r1; }
            __builtin_amdgcn_sched_barrier(0); }
    }
    template <class AV> __device__ __forceinline__ void operator()(const AV& acc, const Unit& u, int wr, int wc, int fr, int fq) const {
        const int row0 = u.pm * 256 + wr * 64 + fr, col0 = u.pn * 256 + wc * 32 + 8 * fq;
#pragma unroll
        for (int ai = 0; ai < 2; ++ai) { v4u gw[4][2];
#pragma unroll
            for (int m = 0; m < 4; ++m)
#pragma unroll
                for (int bj = 0; bj < 2; ++bj) gw[m][bj] = *(const v4u*)(G1 + (size_t)(row0 + ai * 128 + m * 16) * D + col0 + bj * 128);
            __builtin_amdgcn_sched_barrier(0);
#pragma unroll
            for (int m = 0; m < 4; ++m)
#pragma unroll
                for (int bj = 0; bj < 2; ++bj) { f32x4 g0, g1; unpack8(gw[m][bj], g0, g1); const f32x4 a = acc(ai, bj, m, 0) * g0 * 8.f, b = acc(ai, bj, m, 1) * g1 * 8.f;
                    *(v2u*)(M8 + (size_t)(row0 + ai * 128 + m * 16) * D + col0 + bj * 128) = (v2u){pk4_fp8(a[0], a[1], a[2], a[3]), pk4_fp8(b[0], b[1], b[2], b[3])}; }
            __builtin_amdgcn_sched_barrier(0); }
    }
};
struct EpiOut {
    static constexpr bool PERM = true;
    const float* X; bf16* O;
    template <class AV> __device__ __forceinline__ void operator()(const AV& acc, const Unit& u, int wr, int wc, int fr, int fq) const {
        const int row0 = u.pm * 256 + wr * 64 + fr, col0 = u.pn * 256 + wc * 32 + 8 * fq;
#pragma unroll
        for (int ai = 0; ai < 2; ++ai) { f32x4 xv[4][2][2];
#pragma unroll
            for (int m = 0; m < 4; ++m)
#pragma unroll
                for (int bj = 0; bj < 2; ++bj)
#pragma unroll
                    for (int n = 0; n < 2; ++n) xv[m][bj][n] = *(const f32x4*)(X + (size_t)(row0 + ai * 128 + m * 16) * D + col0 + bj * 128 + n * 4);
            __builtin_amdgcn_sched_barrier(0);
#pragma unroll
            for (int m = 0; m < 4; ++m)
#pragma unroll
                for (int bj = 0; bj < 2; ++bj) *(v4u*)(O + (size_t)(row0 + ai * 128 + m * 16) * D + col0 + bj * 128) = pack8(xv[m][bj][0] + acc(ai, bj, m, 0) * (1.f / 512.f), xv[m][bj][1] + acc(ai, bj, m, 1) * (1.f / 512.f));
            __builtin_amdgcn_sched_barrier(0); }
    }
};

__device__ __forceinline__ unsigned off_b(unsigned row, unsigned ch) { return 256u * row + 16u * (ch ^ (((row & 3) << 2) | ((row >> 2) & 3))); }
__device__ __forceinline__ unsigned rrow16(unsigned lane, unsigned rb, unsigned s) { return off_b((lane & 15) + 16 * rb, 4 * s + (lane >> 4)); }
__device__ __forceinline__ unsigned rtr16(unsigned lane, unsigned c, unsigned ks, unsigned t) { const unsigned g = lane >> 4, q = (lane & 15) >> 2, p = lane & 3; return off_b(32 * ks + 8 * g + 4 * t + q, 2 * c + (p >> 1)) + 8 * (p & 1); }
__device__ __forceinline__ s16x4 vtr(LAS unsigned char* p) { return __builtin_bit_cast(s16x4, __builtin_amdgcn_ds_read_tr16_b64_v4i16((LAS v4i16_t*)p)); }
__device__ __forceinline__ bf16x8 trfrag(LAS unsigned char* img, unsigned lane, unsigned c, unsigned ks) {
    const s16x4 a = vtr(img + rtr16(lane, c, ks, 0)), b = vtr(img + rtr16(lane, c, ks, 1));
    return (bf16x8){a[0], a[1], a[2], a[3], b[0], b[1], b[2], b[3]};
}
__device__ __forceinline__ bf16x8 rowfrag(LAS unsigned char* img, unsigned lane, unsigned rb, unsigned s) { return *(const LAS bf16x8*)(img + rrow16(lane, rb, s)); }
constexpr int RL_Q = 0, RL_K = 16384, RL_KD = 32768, RL_V = 49152, RL_ST = 65536, RL_P = 98304, RL_STAT = 98304 + 9216;
constexpr int PS_STRIDE = 144;

struct RetCtx { const bf16* Q; const bf16* K; const bf16* V; const bf16* Gt; const float* COS; const float* SIN; const float* gnw; float* KVS; const float* KVS2; bf16* YRET; };

struct RetRegs { v4u q1, q2, k1, k2, v1, v2; f32x4 c0, c1, s0, s1; };
template <bool WITH_Q>
__device__ __forceinline__ void ret_load(Frame& F, const RetCtx& R, int tok0, int h, RetRegs& L) {
    const int tid = FTID, row = tid >> 3, ch = tid & 7; const size_t tok = (size_t)tok0 + row;
    const size_t gofs = tok * RW + h * DH + ch * 8;
    L.k1 = *(const v4u*)(R.K + gofs); L.k2 = *(const v4u*)(R.K + gofs + 64);
    L.v1 = *(const v4u*)(R.V + gofs); L.v2 = *(const v4u*)(R.V + gofs + 64);
    if (WITH_Q) { L.q1 = *(const v4u*)(R.Q + gofs); L.q2 = *(const v4u*)(R.Q + gofs + 64); }
    L.c0 = *(const f32x4*)(R.COS + tok * 64 + ch * 8); L.c1 = *(const f32x4*)(R.COS + tok * 64 + ch * 8 + 4);
    L.s0 = *(const f32x4*)(R.SIN + tok * 64 + ch * 8); L.s1 = *(const f32x4*)(R.SIN + tok * 64 + ch * 8 + 4);
}
template <bool WITH_Q>
__device__ __forceinline__ void ret_store(Frame& F, const RetCtx& R, int tok0, const RetRegs& L, float l2g, float wexp0) {
    const int tid = FTID, row = tid >> 3, ch = tid & 7; const size_t tok = (size_t)tok0 + row;
    const f32x4 c0 = L.c0, c1 = L.c1, s0 = L.s0, s1 = L.s1;
    f32x4 a0, a1, b0, b1;
    if (WITH_Q) { unpack8(L.q1, a0, a1); unpack8(L.q2, b0, b1);
        *(LAS v4u*)(F.lds + RL_Q + off_b(row, ch)) = pack8(a0 * c0 - b0 * s0, a1 * c1 - b1 * s1);
        *(LAS v4u*)(F.lds + RL_Q + off_b(row, ch + 8)) = pack8(a0 * s0 + b0 * c0, a1 * s1 + b1 * c1); }
    unpack8(L.k1, a0, a1); unpack8(L.k2, b0, b1);
    const float sc = 0.08838834764831845f;
    f32x4 o0 = (a0 * c0 - b0 * s0) * sc, o1 = (a1 * c1 - b1 * s1) * sc, p0 = (a0 * s0 + b0 * c0) * sc, p1 = (a1 * s1 + b1 * c1) * sc;
    if (WITH_Q) { *(LAS v4u*)(F.lds + RL_K + off_b(row, ch)) = pack8(o0, o1); *(LAS v4u*)(F.lds + RL_K + off_b(row, ch + 8)) = pack8(p0, p1); }
    const float kw = __builtin_amdgcn_exp2f(l2g * (wexp0 - (float)row));
    *(LAS v4u*)(F.lds + RL_KD + off_b(row, ch)) = pack8(o0 * kw, o1 * kw); *(LAS v4u*)(F.lds + RL_KD + off_b(row, ch + 8)) = pack8(p0 * kw, p1 * kw);
    *(LAS v4u*)(F.lds + RL_V + off_b(row, ch)) = L.v1; *(LAS v4u*)(F.lds + RL_V + off_b(row, ch + 8)) = L.v2;
}
__device__ __forceinline__ void ret_kv_update(Frame& F, f32x4 (&st)[8]) {
    const unsigned lane = FLANE, w = F.wave;
#pragma unroll
    for (int ks = 0; ks < 2; ++ks) { const bf16x8 a = trfrag(F.lds + RL_KD, lane, w, ks);
#pragma unroll
        for (int et = 0; et < 8; ++et) { const bf16x8 b = trfrag(F.lds + RL_V, lane, et, ks); st[et] = __builtin_amdgcn_mfma_f32_16x16x32_bf16(a, b, st[et], 0, 0, 0); } }
}
__device__ __forceinline__ void ret_pass_a(Frame& F, const RetCtx& R, int job) {
    const int s = job >> 3, h = job & 7; const float l2g = log2f(1.f - exp2f(-5.f - (float)h));
    f32x4 st[8];
#pragma unroll
    for (int et = 0; et < 8; ++et) st[et] = (f32x4){0.f, 0.f, 0.f, 0.f};
    RetRegs L; ret_load<false>(F, R, s * RCH * 64, h, L);
    __syncthreads();
#pragma unroll 1
    for (int c = 0; c < RCH; ++c) {
        Frame F2 = F; F2.lds = F.lds - (c & 1) * 32768;
        ret_store<false>(F2, R, (s * RCH + c) * 64, L, l2g, (float)(511 - 64 * c));
        __syncthreads();
        if (c + 1 < RCH) ret_load<false>(F, R, (s * RCH + c + 1) * 64, h, L);
        __builtin_amdgcn_sched_barrier(0);
        ret_kv_update(F2, st);
    }
    const int fr = FLANE & 15, g = FLANE >> 4; float* o = R.KVS + ((size_t)(s * NH + h) * DH) * DH;
#pragma unroll
    for (int et = 0; et < 8; ++et)
#pragma unroll
        for (int r = 0; r < 4; ++r) o[(size_t)(16 * F.wave + 4 * g + r) * DH + 16 * et + fr] = st[et][r];
}
__device__ __forceinline__ void ret_pass_c(Frame& F, const RetCtx& R, int job) {
    const int s = job >> 3, h = job & 7; const float gam = 1.f - exp2f(-5.f - (float)h), l2g = log2f(gam), cd = __builtin_amdgcn_exp2f(l2g * 64.f);
    const unsigned lane = FLANE, w = F.wave; const int fr = lane & 15, g = lane >> 4;
    f32x4 st[8];
    { const float* o = R.KVS2 + ((size_t)(s * NH + h) * DH) * DH;
#pragma unroll
      for (int et = 0; et < 8; ++et)
#pragma unroll
          for (int r = 0; r < 4; ++r) st[et][r] = o[(size_t)(16 * w + 4 * g + r) * DH + 16 * et + fr]; }
    const int qt = w >> 1, eh = w & 1;
    const int kt = w >> 1, qt2 = 2 * (w & 1);
    RetRegs L; ret_load<true>(F, R, s * RCH * 64, h, L);
    float gnv[4];
#pragma unroll
    for (int j = 0; j < 4; ++j) gnv[j] = R.gnw[h * DH + 16 * (4 * eh + j) + fr];
#pragma unroll 1
    for (int c = 0; c < RCH; ++c) {
        const int tok0 = (s * RCH + c) * 64;
        unsigned lane = FLANE; asm volatile("" : "+v"(lane));
        if (c == 0) __syncthreads();
#pragma unroll
        for (int et = 0; et < 8; ++et) { v2u pk; pk.x = cvt_pk_bf16(st[et][0], st[et][1]); pk.y = cvt_pk_bf16(st[et][2], st[et][3]);
            *(LAS v2u*)(F.lds + RL_ST + off_b(16 * et + fr, 2 * w + (g >> 1)) + 8 * (g & 1)) = pk; }
        ret_store<true>(F, R, tok0, L, l2g, 63.f);
        __syncthreads();
        if (c + 1 < RCH) ret_load<true>(F, R, tok0 + 64, h, L);
        __builtin_amdgcn_sched_barrier(0);
#pragma unroll
        for (int j = 0; j < 2; ++j) { f32x4 sc = (f32x4){0.f, 0.f, 0.f, 0.f};
#pragma unroll
            for (int ks = 0; ks < 4; ++ks) sc = __builtin_amdgcn_mfma_f32_16x16x32_bf16(rowfrag(F.lds + RL_K, lane, kt, ks), rowfrag(F.lds + RL_Q, lane, qt2 + j, ks), sc, 0, 0, 0);
            const int q = 16 * (qt2 + j) + fr;
#pragma unroll
            for (int r = 0; r < 4; ++r) { const int key = 16 * kt + 4 * g + r; sc[r] *= __builtin_amdgcn_exp2f(l2g * fabsf((float)(q - key))); }
            v2u pk; pk.x = cvt_pk_bf16(sc[0], sc[1]); pk.y = cvt_pk_bf16(sc[2], sc[3]);
            *(LAS v2u*)(F.lds + RL_P + q * PS_STRIDE + (16 * kt + 4 * g) * 2) = pk; }
        f32x4 y[4];
#pragma unroll
        for (int j = 0; j < 4; ++j) y[j] = (f32x4){0.f, 0.f, 0.f, 0.f};
#pragma unroll
        for (int ks = 0; ks < 4; ++ks) { const bf16x8 a = rowfrag(F.lds + RL_Q, lane, qt, ks);
#pragma unroll
            for (int j = 0; j < 4; ++j) y[j] = __builtin_amdgcn_mfma_f32_16x16x32_bf16(a, rowfrag(F.lds + RL_ST, lane, 4 * eh + j, ks), y[j], 0, 0, 0); }
#pragma unroll
        for (int r = 0; r < 4; ++r) { const float qd = __builtin_amdgcn_exp2f(l2g * (float)(16 * qt + 4 * g + r + 1));
#pragma unroll
            for (int j = 0; j < 4; ++j) y[j][r] *= qd; }
        __syncthreads();
        unsigned short gq[4][4];
#pragma unroll
        for (int r = 0; r < 4; ++r)
#pragma unroll
            for (int j = 0; j < 4; ++j) gq[r][j] = R.Gt[((size_t)tok0 + 16 * qt + 4 * g + r) * RW + h * DH + 16 * (4 * eh + j) + fr];
        __builtin_amdgcn_sched_barrier(0);
#pragma unroll
        for (int ks = 0; ks < 2; ++ks) { const bf16x8 a = *(const LAS bf16x8*)(F.lds + RL_P + (16 * qt + fr) * PS_STRIDE + (32 * ks + 8 * g) * 2);
#pragma unroll
            for (int j = 0; j < 4; ++j) y[j] = __builtin_amdgcn_mfma_f32_16x16x32_bf16(a, trfrag(F.lds + RL_V, lane, 4 * eh + j, ks), y[j], 0, 0, 0); }
        LAS float* STAT = (LAS float*)(F.lds + RL_STAT);
#pragma unroll
        for (int r = 0; r < 4; ++r) { float s1 = 0.f, s2 = 0.f;
#pragma unroll
            for (int j = 0; j < 4; ++j) { s1 += y[j][r]; s2 += y[j][r] * y[j][r]; }
#pragma unroll
            for (int o = 1; o < 16; o <<= 1) { s1 += __shfl_xor(s1, o); s2 += __shfl_xor(s2, o); }
            if (fr == 0) { STAT[((16 * qt + 4 * g + r) * 2 + eh) * 2] = s1; STAT[((16 * qt + 4 * g + r) * 2 + eh) * 2 + 1] = s2; } }
#pragma unroll
        for (int et = 0; et < 8; ++et) st[et] *= cd;
        ret_kv_update(F, st);
        __syncthreads();
#pragma unroll
        for (int r = 0; r < 4; ++r) { const int q = 16 * qt + 4 * g + r; const float s1 = STAT[(q * 2) * 2] + STAT[(q * 2 + 1) * 2], s2 = STAT[(q * 2) * 2 + 1] + STAT[(q * 2 + 1) * 2 + 1];
            const float mu = s1 * (1.f / 128.f), var = s2 * (1.f / 128.f) - mu * mu, rs = rsqrtf(var + EPS); const size_t tok = (size_t)tok0 + q;
#pragma unroll
            for (int j = 0; j < 4; ++j) { const int e = h * DH + 16 * (4 * eh + j) + fr; const float gv = __uint_as_float((unsigned)gq[r][j] << 16);
                const float o = (y[j][r] - mu) * rs * gnv[j] * gv * fsigm(gv);
                R.YRET[tok * (2 * RW) + e] = (bf16)(cvt_pk_bf16(o, o) & 0xffffu); } }
    }
}

constexpr size_t WS_WR = WS_LAM + 64 * 1024;
constexpr size_t WS_WGU = 164 * MiB, WS_WDN = 292 * MiB, WS_ACT = 356 * MiB, WS_MOE = 396 * MiB, WS_PP = 524 * MiB + 1280;
constexpr size_t WS_END2 = 589 * MiB;
constexpr int CW_Q1 = 8320, CW_SS = 131072;
constexpr int MOE_TAB_OFF = LDSCTL_OFF + 1024;

__device__ __forceinline__ void router_weights_item(Frame& F, int item, const float* nf, const float* wrg, const float* wre, bf16* WRF) {
    const int tt = item * 512 + FTID, pair = tt >> 6, lane = tt & 63, ks = pair / 3, nt = pair % 3, j = 16 * nt + (lane & 15), k0 = 32 * ks + 8 * (lane >> 4); float v[8];
#pragma unroll
    for (int i = 0; i < 8; ++i) { const int k = k0 + i; float w = 0.f; if (j < 4) w = wrg[k * 4 + j]; else if (j < 36) w = wre[k * NE + (j - 4)]; v[i] = w * nf[k]; }
    unsigned hi[4], lo[4];
#pragma unroll
    for (int i = 0; i < 4; ++i) { hi[i] = cvt_pk_bf16(v[2 * i], v[2 * i + 1]); lo[i] = cvt_pk_bf16(v[2 * i] - bf_lo(hi[i]), v[2 * i + 1] - bf_hi(hi[i])); }
    *(v4u*)(WRF + ((size_t)(pair * 2 + 0) * 64 + lane) * 8) = (v4u){hi[0], hi[1], hi[2], hi[3]}; *(v4u*)(WRF + ((size_t)(pair * 2 + 1) * 64 + lane) * 8) = (v4u){lo[0], lo[1], lo[2], lo[3]};
}
__device__ __forceinline__ void router_item(Frame& F, int item, bool dry, const bf16* X1, const float* nf, const bf16* WRF, const float* brg, const float* bre,
                                            unsigned char* HX, float* RINV, unsigned* cnt, int* list, float* wgt) {
    const int lane = FLANE, fr = lane & 15, g = lane >> 4, w = F.wave, tok0 = item * 64, kb = w * 256;
    const bf16* xp = X1 + (size_t)(tok0 + fr) * D + kb + 8 * g; unsigned char* hp = HX + (size_t)(tok0 + fr) * D + kb + 8 * g; const float* np = nf + kb + 8 * g;
    const bf16* bp = WRF + ((size_t)(w * 8) * 6 * 64 + lane) * 8;
    f32x4 acc[4][3]; float ss[4];
#pragma unroll
    for (int mt = 0; mt < 4; ++mt) { ss[mt] = 0.f;
#pragma unroll
        for (int nt = 0; nt < 3; ++nt) acc[mt][nt] = (f32x4){0.f, 0.f, 0.f, 0.f}; }
#pragma unroll 1
    for (int k2 = 0; k2 < 2; ++k2) {
        v4u xw[4][4]; f32x4 n0[4], n1[4]; bf16x8 bh[3], bl[3];
#pragma unroll
        for (int s = 0; s < 4; ++s) { const int ko = 128 * k2 + 32 * s; n0[s] = *(const f32x4*)(np + ko); n1[s] = *(const f32x4*)(np + ko + 4);
#pragma unroll
            for (int mt = 0; mt < 4; ++mt) xw[s][mt] = *(const v4u*)(xp + (size_t)16 * mt * D + ko); }
#pragma unroll
        for (int nt = 0; nt < 3; ++nt) { bh[nt] = *(const bf16x8*)(bp + (size_t)(((4 * k2) * 3 + nt) * 2 + 0) * 512); bl[nt] = *(const bf16x8*)(bp + (size_t)(((4 * k2) * 3 + nt) * 2 + 1) * 512); }
        __builtin_amdgcn_sched_barrier(0);
#pragma unroll
        for (int s = 0; s < 4; ++s) {
#pragma unroll
            for (int mt = 0; mt < 4; ++mt) { const int ko = 128 * k2 + 32 * s; f32x4 a, b; unpack8(xw[s][mt], a, b);
                ss[mt] += (a[0] * a[0] + a[1] * a[1]) + (a[2] * a[2] + a[3] * a[3]) + (b[0] * b[0] + b[1] * b[1]) + (b[2] * b[2] + b[3] * b[3]);
                { const f32x4 ha = a * n0[s] * 4.f, hb = b * n1[s] * 4.f; *(v2u*)(hp + (size_t)16 * mt * D + ko) = (v2u){pk4_fp8(ha[0], ha[1], ha[2], ha[3]), pk4_fp8(hb[0], hb[1], hb[2], hb[3])}; }
                const bf16x8 ah = __builtin_bit_cast(bf16x8, xw[s][mt]);
#pragma unroll
                for (int nt = 0; nt < 3; ++nt) {
                    acc[mt][nt] = __builtin_amdgcn_mfma_f32_16x16x32_bf16(ah, bh[nt], acc[mt][nt], 0, 0, 0);
                    acc[mt][nt] = __builtin_amdgcn_mfma_f32_16x16x32_bf16(ah, bl[nt], acc[mt][nt], 0, 0, 0); } }
            if (s < 3) {
#pragma unroll
                for (int nt = 0; nt < 3; ++nt) { bh[nt] = *(const bf16x8*)(bp + (size_t)(((4 * k2 + s + 1) * 3 + nt) * 2 + 0) * 512); bl[nt] = *(const bf16x8*)(bp + (size_t)(((4 * k2 + s + 1) * 3 + nt) * 2 + 1) * 512); } } }
    }
    LAS float* LG = (LAS float*)(F.lds + w * 12544);
    LAS float* SSP = (LAS float*)(F.lds + 8 * 12544 + w * 256);
#pragma unroll
    for (int mt = 0; mt < 4; ++mt) { float s = ss[mt]; s += __shfl_xor(s, 16); s += __shfl_xor(s, 32); if (g == 0) SSP[16 * mt + fr] = s;
#pragma unroll
        for (int r = 0; r < 4; ++r)
#pragma unroll
            for (int nt = 0; nt < 3; ++nt) LG[(16 * mt + 4 * g + r) * 49 + 16 * nt + fr] = acc[mt][nt][r]; }
    __syncthreads();
    if (FTID < 64 && !dry) {
        const int tl = FTID, t = tok0 + tl; float s = 0.f;
#pragma unroll
        for (int q = 0; q < 8; ++q) s += ((const LAS float*)(F.lds + 8 * 12544 + q * 256))[tl];
        const float rinv = rsqrtf(s * (1.f / D) + EPS);
        const LAS float* lg = (const LAS float*)F.lds + tl * 49;
        float mx = -1e30f; int gi = 0; float gl[4];
#pragma unroll
        for (int j = 0; j < 4; ++j) { float a = 0.f;
#pragma unroll
            for (int q = 0; q < 8; ++q) a += lg[q * 3136 + j];
            gl[j] = a * rinv + brg[j]; if (gl[j] > mx) { mx = gl[j]; gi = j; } }
        float se = 0.f;
#pragma unroll
        for (int j = 0; j < 4; ++j) se += __expf(gl[j] - mx);
        const float gw = 1.f / se;
        float b1 = -1e30f, b2 = -1e30f; int j1 = 0, j2 = 0;
        for (int j = 0; j < 8; ++j) { float a = 0.f;
#pragma unroll
            for (int q = 0; q < 8; ++q) a += lg[q * 3136 + 4 + gi * 8 + j];
            const float v = a * rinv + bre[gi * 8 + j]; if (v > b1) { b2 = b1; j2 = j1; b1 = v; j1 = j; } else if (v > b2) { b2 = v; j2 = j; } }
        const float e2 = __expf(b2 - b1); const float w1 = gw / (1.f + e2), w2 = gw * e2 / (1.f + e2);
        const int ea = gi * 8 + j1, eb = gi * 8 + j2;
        LAS unsigned* LC = (LAS unsigned*)(F.lds + 8 * 12544 + 2048);
        if (tl < 32) LC[tl] = 0u;
        asm volatile("s_waitcnt lgkmcnt(0)" ::: "memory");
        const unsigned la = __hip_atomic_fetch_add(LC + ea, 1u, __ATOMIC_RELAXED, __HIP_MEMORY_SCOPE_WORKGROUP);
        const unsigned lb = __hip_atomic_fetch_add(LC + eb, 1u, __ATOMIC_RELAXED, __HIP_MEMORY_SCOPE_WORKGROUP);
        asm volatile("s_waitcnt lgkmcnt(0)" ::: "memory");
        if (tl < 32) { const unsigned n = LC[tl]; unsigned base = 0u; if (n) base = __hip_atomic_fetch_add(cnt + tl, n, RLX_AGENT); LC[32 + tl] = base; }
        asm volatile("s_waitcnt vmcnt(0) lgkmcnt(0)" ::: "memory");
        const int pa = (int)(LC[32 + ea] + la), pb = (int)(LC[32 + eb] + lb);
        list[(size_t)ea * T + pa] = t * 2; wgt[t * 2] = w1;
        list[(size_t)eb * T + pb] = t * 2 + 1; wgt[t * 2 + 1] = w2;
        RINV[t] = rinv;
    }
}

template <int NT> __device__ __forceinline__ void moe_tables(Frame& F, const unsigned* cnt) {
    LAS int* tab = (LAS int*)(F.lds + MOE_TAB_OFF);
    __syncthreads();
    if (FTID == 0) { int cu = 0, ps = 0; for (int e = 0; e < NE; ++e) { const int c = (int)__hip_atomic_load(cnt + e, RLX_AGENT), nrb = (c + 255) >> 8; tab[e] = cu; tab[33 + e] = ps; tab[66 + e] = c; cu += nrb * NT; ps += nrb * 256; } tab[32] = cu; tab[65] = ps; }
    __syncthreads();
}
template <int NT, int NTSH> struct SchedMoe {
    LAS int* tab; int G, c, rep;
    __device__ __forceinline__ bool next(int i, pg8::Unit& u) const {
        const int nRB = tab[32] >> NTSH; int RB, pn;
        if (G == 256) { const int x = c & 7, slot = c >> 3; RB = (i * 8 + x) * (32 >> NTSH) + (slot >> NTSH); pn = slot & (NT - 1); }
        else { const int L = i * G + c; RB = L >> NTSH; pn = L & (NT - 1); }
        if (RB >= nRB * rep) return false; if (RB >= nRB) RB -= nRB;
        const int L = RB << NTSH; int e = 0;
        while (e < NE - 1 && tab[e + 1] <= L) ++e;
        u.z = e; u.pm = (L - tab[e]) >> NTSH; u.pn = pn; return true; }
};
struct SchedGU : SchedMoe<4, 2> {
    static constexpr bool GATHER = true;
    const char* A; const char* B; const int* list; unsigned lda2, ldb2;
    __device__ __forceinline__ const char* a_ptr(const pg8::Unit&) const { return A; }
    __device__ __forceinline__ const char* b_ptr(const pg8::Unit& u) const { return B + ((size_t)u.z * 1024 + (size_t)u.pn * 256) * ldb2; }
    __device__ __forceinline__ unsigned row_off(const pg8::Unit& u, int rr) const { const int r = u.pm * 256 + rr; const int tok = r < tab[66 + u.z] ? (list[(size_t)u.z * T + r] >> 1) : 0; return (unsigned)tok * lda2; }
};
struct SchedDN : SchedMoe<8, 3> {
    static constexpr bool GATHER = false;
    const char* A; const char* B; unsigned lda2, ldb2;
    __device__ __forceinline__ const char* a_ptr(const pg8::Unit& u) const { return A + (size_t)(tab[33 + u.z] + u.pm * 256) * lda2; }
    __device__ __forceinline__ const char* b_ptr(const pg8::Unit& u) const { return B + ((size_t)u.z * 2048 + (size_t)u.pn * 256) * ldb2; }
    __device__ __forceinline__ void a_off(const pg8::Unit&, const int (&)[2], const int (&)[2], unsigned (&)[2][2]) const {}
};
struct EpiGU {
    static constexpr bool PERM = true;
    unsigned char* ACT; const int* list; const float* RINV; LAS int* tab;
    template <class AV> __device__ __forceinline__ void operator()(const AV& acc, const Unit& u, int wr, int wc, int fr, int fq) const {
        const int ce = tab[66 + u.z], ps = tab[33 + u.z], r0 = u.pm * 256 + wr * 64 + fr, c0 = u.pn * 128 + wc * 16 + 4 * fq;
        int code[2][4]; float rvv[2][4];
#pragma unroll
        for (int ai = 0; ai < 2; ++ai)
#pragma unroll
            for (int m = 0; m < 4; ++m) { const int r = r0 + ai * 128 + m * 16; code[ai][m] = r < ce ? list[(size_t)u.z * T + r] : 0; }
#pragma unroll
        for (int ai = 0; ai < 2; ++ai)
#pragma unroll
            for (int m = 0; m < 4; ++m) rvv[ai][m] = RINV[code[ai][m] >> 1] * (1.f / 256.f);
#pragma unroll
        for (int ai = 0; ai < 2; ++ai)
#pragma unroll
            for (int m = 0; m < 4; ++m) { const int r = r0 + ai * 128 + m * 16;
                if (r < ce) { const float rv = rvv[ai][m];
#pragma unroll
                    for (int bj = 0; bj < 2; ++bj) { f32x4 gt = acc(ai, bj, m, 0) * rv, up = acc(ai, bj, m, 1) * rv;
#pragma unroll
                        for (int j = 0; j < 4; ++j) gt[j] = __builtin_fminf(__builtin_fmaxf(gt[j] * fsigm(gt[j]) * up[j] * 16.f, -440.f), 440.f);
                        *(unsigned*)(ACT + (size_t)(ps + r) * FE + c0 + bj * 64) = pk4_fp8(gt[0], gt[1], gt[2], gt[3]); } } }
    }
};
struct EpiDN {
    static constexpr bool PERM = true;
    bf16* MOE; const int* list; const float* wgt; LAS int* tab;
    template <class AV> __device__ __forceinline__ void operator()(const AV& acc, const Unit& u, int wr, int wc, int fr, int fq) const {
        const int ce = tab[66 + u.z], r0 = u.pm * 256 + wr * 64 + fr, c0 = u.pn * 256 + wc * 32 + 8 * fq;
        int code[2][4]; float wv[2][4];
#pragma unroll
        for (int ai = 0; ai < 2; ++ai)
#pragma unroll
            for (int m = 0; m < 4; ++m) { const int r = r0 + ai * 128 + m * 16; code[ai][m] = r < ce ? list[(size_t)u.z * T + r] : 0; }
#pragma unroll
        for (int ai = 0; ai < 2; ++ai)
#pragma unroll
            for (int m = 0; m < 4; ++m) wv[ai][m] = wgt[code[ai][m]] * (1.f / 512.f);
#pragma unroll
        for (int ai = 0; ai < 2; ++ai)
#pragma unroll
            for (int m = 0; m < 4; ++m) { const int r = r0 + ai * 128 + m * 16;
                if (r < ce) { const int cd = code[ai][m]; const float w = wv[ai][m]; bf16* dst = MOE + ((size_t)(cd & 1) * T + (cd >> 1)) * D + c0;
#pragma unroll
                    for (int bj = 0; bj < 2; ++bj) *(v4u*)(dst + bj * 128) = pack8(acc(ai, bj, m, 0) * w, acc(ai, bj, m, 1) * w); } }
    }
};
struct EpiPP {
    static constexpr bool PERM = false;
    bf16* PP;
    template <class AV> __device__ __forceinline__ void operator()(const AV& acc, const Unit& u, int wr, int wc, int fr, int fq) const {
        const int row0 = u.pm * 256 + wr * 64 + fr, col0 = u.pn * 256 + wc * 32 + 4 * fq;
#pragma unroll
        for (int ai = 0; ai < 2; ++ai)
#pragma unroll
            for (int m = 0; m < 4; ++m) { const size_t off = (size_t)(row0 + ai * 128 + m * 16) * D + col0;
#pragma unroll
                for (int bj = 0; bj < 2; ++bj)
#pragma unroll
                    for (int n = 0; n < 2; ++n) { const f32x4 a = acc(ai, bj, m, n); v2u o; o.x = cvt_pk_bf16(a[0], a[1]); o.y = cvt_pk_bf16(a[2], a[3]); *(v2u*)(PP + off + bj * 128 + n * 16) = o; } }
    }
};
struct EpiPle {
    static constexpr bool PERM = true;
    const bf16* PP; const bf16* X2B; const float* RINV; bf16* X3B;
    template <class AV> __device__ __forceinline__ void operator()(const AV& acc, const Unit& u, int wr, int wc, int fr, int fq) const {
        const int row0 = u.pm * 256 + wr * 64 + fr, col0 = u.pn * 256 + wc * 32 + 8 * fq;
#pragma unroll
        for (int ai = 0; ai < 2; ++ai) { v4u pw[4][2], xw[4][2]; float rvv[4];
#pragma unroll
            for (int m = 0; m < 4; ++m) { const int row = row0 + ai * 128 + m * 16; rvv[m] = RINV[row];
#pragma unroll
                for (int bj = 0; bj < 2; ++bj) { const size_t o = (size_t)row * D + col0 + bj * 128; pw[m][bj] = *(const v4u*)(PP + o); xw[m][bj] = *(const v4u*)(X2B + o); } }
            __builtin_amdgcn_sched_barrier(0);
#pragma unroll
            for (int m = 0; m < 4; ++m) { const int row = row0 + ai * 128 + m * 16; const float rv = rvv[m] * (1.f / 256.f)  ;
#pragma unroll
                for (int bj = 0; bj < 2; ++bj) { f32x4 p0, p1, x0, x1; unpack8(pw[m][bj], p0, p1); unpack8(xw[m][bj], x0, x1);
                    const f32x4 a0 = acc(ai, bj, m, 0) * rv, a1 = acc(ai, bj, m, 1) * rv;
#pragma unroll
                    for (int j = 0; j < 4; ++j) { x0[j] += fsigm(a0[j]) * p0[j]; x1[j] += fsigm(a1[j]) * p1[j]; }
                    *(v4u*)(X3B + (size_t)row * D + col0 + bj * 128) = pack8(x0, x1); } }
            __builtin_amdgcn_sched_barrier(0); }
    }
};
__device__ __forceinline__ void combine_row(int lane, const bf16* xrow, const bf16* m0, const bf16* m1, bf16* hrow, unsigned char* h8row, float* rinv) {
    v4u xw[4], u0[4], u1[4];
#pragma unroll
    for (int j = 0; j < 4; ++j) { const int c = (lane + 64 * j) * 8; xw[j] = *(const v4u*)(xrow + c); u0[j] = *(const v4u*)(m0 + c); u1[j] = *(const v4u*)(m1 + c); }
    __builtin_amdgcn_sched_barrier(0);
    float s = 0.f;
#pragma unroll
    for (int j = 0; j < 4; ++j) { const int c = (lane + 64 * j) * 8; f32x4 a, b, p0, p1, q0, q1; unpack8(xw[j], a, b); unpack8(u0[j], p0, p1); unpack8(u1[j], q0, q1);
        a += p0 + q0; b += p1 + q1;
        s += (a[0] * a[0] + a[1] * a[1]) + (a[2] * a[2] + a[3] * a[3]) + (b[0] * b[0] + b[1] * b[1]) + (b[2] * b[2] + b[3] * b[3]);
        *(v4u*)(hrow + c) = pack8(a, b); *(v2u*)(h8row + c) = (v2u){pk4_fp8(a[0] * 4.f, a[1] * 4.f, a[2] * 4.f, a[3] * 4.f), pk4_fp8(b[0] * 4.f, b[1] * 4.f, b[2] * 4.f, b[3] * 4.f)}; }
    s = wave_sum(s); if (lane == 0) *rinv = rsqrtf(s * (1.f / D) + EPS);
}
__device__ __forceinline__ void final_row(int lane, const bf16* xrow, float* orow, const float* w) {
    v4u xw[4]; f32x4 w0[4], w1[4];
#pragma unroll
    for (int j = 0; j < 4; ++j) { const int c = (lane + 64 * j) * 8; xw[j] = *(const v4u*)(xrow + c); w0[j] = *(const f32x4*)(w + c); w1[j] = *(const f32x4*)(w + c + 4); }
    __builtin_amdgcn_sched_barrier(0);
    f32x4 a[4], b[4]; float s = 0.f;
#pragma unroll
    for (int j = 0; j < 4; ++j) { unpack8(xw[j], a[j], b[j]); s += (a[j][0] * a[j][0] + a[j][1] * a[j][1]) + (a[j][2] * a[j][2] + a[j][3] * a[j][3]) + (b[j][0] * b[j][0] + b[j][1] * b[j][1]) + (b[j][2] * b[j][2] + b[j][3] * b[j][3]); }
    const float r = rsqrtf(wave_sum(s) * (1.f / D) + EPS);
#pragma unroll
    for (int j = 0; j < 4; ++j) { const int c = (lane + 64 * j) * 8; *(f32x4*)(orow + c) = a[j] * r * w0[j]; *(f32x4*)(orow + c + 4) = b[j] * r * w1[j]; }
}

__device__ __forceinline__ void s5_scan(Frame& F, int job, const float* EST, const float* LAMT, bf16* UA) {
    const int g = job >> 2, pq = job & 3, pl = FTID & 15, seg = FTID >> 4, p = pq * 16 + pl;
    const float l16r = LAMT[(g * 64 + p) * 4 + 0], l16i = LAMT[(g * 64 + p) * 4 + 1], lsr = LAMT[(g * 64 + p) * 4 + 2], lsi = LAMT[(g * 64 + p) * 4 + 3];
    float er[32], ei[32];
    const float* e0 = EST + ((size_t)g * S5NC + seg * 32) * 128 + p;
#pragma unroll
    for (int i = 0; i < 32; ++i) { er[i] = e0[(size_t)i * 128]; ei[i] = e0[(size_t)i * 128 + 64]; }
    float sr = 0.f, si = 0.f;
#pragma unroll
    for (int i = 0; i < 32; ++i) { const float nr = l16r * sr - l16i * si + er[i], ni = l16r * si + l16i * sr + ei[i]; sr = nr; si = ni; }
    LAS float* SE = (LAS float*)F.lds;
    __syncthreads();
    SE[(seg * 16 + pl) * 2] = sr; SE[(seg * 16 + pl) * 2 + 1] = si;
    __syncthreads();
    sr = 0.f; si = 0.f;
    for (int s2 = 0; s2 < seg; ++s2) { const float ar = SE[(s2 * 16 + pl) * 2], ai = SE[(s2 * 16 + pl) * 2 + 1]; const float nr = lsr * sr - lsi * si + ar, ni = lsr * si + lsi * sr + ai; sr = nr; si = ni; }
    bf16* o = UA + ((size_t)g * S5NC + seg * 32) * S5K + 256 + p;
#pragma unroll
    for (int i = 0; i < 32; ++i) { o[(size_t)i * S5K] = (bf16)(cvt_pk_bf16(sr, sr) & 0xffffu); o[(size_t)i * S5K + 64] = (bf16)(cvt_pk_bf16(si, si) & 0xffffu);
        const float nr = l16r * sr - l16i * si + er[i], ni = l16r * si + l16i * sr + ei[i]; sr = nr; si = ni; }
    __syncthreads();
}
__device__ __forceinline__ void ret_scan(Frame& F, int job, const float* KVS, float* KVS2) {
    const int idx = job * 512 + FTID;
    const int h = idx >> 14; const float cd8 = __builtin_amdgcn_exp2f(log2f(1.f - exp2f(-5.f - (float)h)) * 512.f);
    float v[RSC];
#pragma unroll
    for (int s = 0; s < RSC; ++s) v[s] = KVS[(size_t)s * NH * DH * DH + idx];
    float st = 0.f;
#pragma unroll
    for (int s = 0; s < RSC; ++s) { const float t = v[s]; KVS2[(size_t)s * NH * DH * DH + idx] = st; st = st * cd8 + t; }
}

struct Args { const float* in[30]; float* out; unsigned char* ws; int ph_lo, ph_hi, rep_mask, pad; };
enum { I_X = 0, I_P, I_NMIX, I_WIN, I_GNW, I_LRE, I_LIM, I_LDT, I_BRE, I_BIM, I_CRE, I_CIM, I_SD, I_WGLU, I_WA, I_WB, I_WMERGE, I_WOUT, I_NFFN, I_WRG, I_BRG, I_WRE, I_BRE2, I_WEG, I_WEU, I_WED, I_NPLE, I_WPG, I_WPLE, I_NF };

__device__ __forceinline__ const float* ain_opaque(const float* const (&in)[30], int k) { asm volatile("" : "+s"(k)); return in[k]; }
#define WT1 ((bf16*)(ws + WS_WT1))
#define WGLU ((bf16*)(ws + WS_WGLU))
#define WA ((bf16*)(ws + WS_WA))
#define WB ((bf16*)(ws + WS_WB))
#define WOUT ((bf16*)(ws + WS_WOUT))
#define WPG ((bf16*)(ws + WS_WPG))
#define M8 (ws + (size_t)444 * MiB)
#define H8 (ws + (size_t)404 * MiB)
#define WM8 (ws + (size_t)436 * MiB)
#define WP ((bf16*)(ws + WS_WP))
#define BTC ((bf16*)(ws + WS_BTC))
#define BLT ((bf16*)(ws + WS_BLT))
#define HB ((bf16*)(ws + WS_HB))
#define YCAT ((bf16*)(ws + (size_t)476 * MiB))
#define YRET YCAT
#define YPRE ((bf16*)(ws + WS_YPRE))
#define QKVG ((bf16*)(ws + WS_Q))
#define UA ((bf16*)(ws + WS_UA))
#define EST ((float*)(ws + WS_EST))
#define KVS ((float*)(ws + WS_KVS))
#define KVS2 ((float*)(ws + WS_KVS + 16 * MiB))
#define MERGED ((bf16*)(ws + WS_MERGED))
#define YSSM (YCAT + RW)
#define PB ((bf16*)(ws + WS_PB))
#define COS ((float*)(ws + WS_COS))
#define SIN ((float*)(ws + WS_SIN))
#define LAMT ((float*)(ws + WS_LAM))
#define WGU ((bf16*)(ws + WS_WGU))
#define WDN ((bf16*)(ws + WS_WDN))
#define WRH ((bf16*)(ws + WS_WR))
#define ACT ((bf16*)(ws + WS_ACT))
#define MOE ((bf16*)(ws + WS_MOE))
#define PP ((bf16*)(ws + WS_PP))
#define LIST ((int*)(ws + WS_LIST))
#define WGT ((float*)(ws + WS_WGT))
#define RINV ((float*)(ws + WS_RINV))
__global__ void __launch_bounds__(NWAVES * 64, 2) mk_fwd(Args args) {
    extern __shared__ __attribute__((aligned(16))) unsigned char lds_raw[];
    Frame F;
    F.lds = (LAS unsigned char*)lds_raw;
    F.MISC = (volatile LAS unsigned*)(F.lds + MISC_OFF);
    F.wave = __builtin_amdgcn_readfirstlane((int)threadIdx.x >> 6); F.G = gridDim.x;
    unsigned char* ws = args.ws;
    F.ctl = (unsigned*)(ws + WS_CTL);
    for (int u = FTID; u < (LDS_BYTES - LDSCTL_OFF) / 4; u += NWAVES * 64) ((LAS unsigned*)(F.lds + LDSCTL_OFF))[u] = 0u;
    __syncthreads();
    const int lo = args.ph_lo, hi = args.ph_hi;
    const bool fused = (hi - lo) > 1;
    if (fused) (void)xcd_barrier_post(F.ctl + CW_BAR, F.MISC + 8);
#ifndef PH_MASK
#define PH_MASK 0xffffffffu
#endif
#define IN(k) (((PH_MASK >> (k)) & 1u) && lo <= (k) && (k) < hi)
#ifdef STAMP_A
#define STAMP(i) do { if (blockIdx.x == STAMP_BLOCK && FTID == 0) ((volatile LAS unsigned long long*)(F.lds + LDSCTL_OFF + 2048))[i] = wall_clock64(); } while (0)
#else
#define STAMP(i) do { } while (0)
#endif
#define SEAM(k) do { if (IN(k) && IN((k) + 1)) { XcdBarrier _b; _b.bar = (unsigned*)(args.ws + WS_CTL) + CW_BAR; _b.x = xb_xcc_id(); _b.st = (volatile LAS unsigned*)(F.lds + MISC_OFF) + 8; _b.t0 = (F.wave == 0) && (FLANE == 0);     \
        xcd_barrier(_b); if ((args.rep_mask >> 14) & 1) xcd_barrier(_b); } } while (0)
#define NREP(k) (1 + ((args.rep_mask >> (k)) & 1))
    bf16* X1B = (bf16*)args.out;
    bf16* GATES = (bf16*)args.out;

#define AIN(k) ain_opaque(args.in, (k))
    if (IN(0)) {
        constexpr int I_S5 = 64;
        constexpr int I_WIN8 = (D / 64) * (INC / 64) / 8, I_WMG8 = (D / 64) * (4096 / 64) / 8, I_GLU8 = (RW / 64) * (RW / 64) / 8, I_WA8 = (RW / 64) * (D / 64) / 8, I_WO8 = (D / 64) * (D / 64) / 8, I_WPL8 = (PLE / 64) * (D / 64) / 8;
        constexpr int I_H = T / 16, I_PB = 256, I_ROPE = 256;
        constexpr int B0 = 0, B1 = B0 + I_S5, B2 = B1 + I_WIN8, B3 = B2 + I_WMG8, B4 = B3 + I_GLU8, B5 = B4 + I_WA8, B6 = B5 + I_WA8, B7 = B6 + I_WO8, B8 = B7 + I_WO8, B9 = B8 + I_WPL8, B10 = B9 + I_H, B11 = B10 + I_PB, B12 = B11 + I_ROPE, B13 = B12 + 1, B14 = B13 + 24;
        LAS unsigned char* scr = F.lds + RING_OFF + F.wave * 9216;
        for (int itq = wg_next_item(F, F.ctl + CW_Q0); itq < B14 * NREP(0);) {
            const unsigned nxq = wq_begin(F, F.ctl + CW_Q0);
            const int it = itq >= B14 ? itq - B14 : itq;
            if (it < B1) { s5_tables(F, it, AIN(I_LRE), AIN(I_LIM), AIN(I_LDT), AIN(I_BRE), AIN(I_BIM), AIN(I_CRE), AIN(I_CIM), AIN(I_SD), BTC, BLT, LAMT); }
            else if (it < B2) transpose_item<0>(AIN(I_WIN), D, INC, WT1, D, 0, scr, (it - B1) * 8 + F.wave, FLANE);
            else if (it < B3) { const int w8 = (it - B2) * 8 + F.wave, gs = w8 >> 10, t8 = w8 & 1023;
                transpose_item<0, true>(AIN(I_WMERGE) + gs * 2048, D, 4096, WM8, D, (((t8 & 31) >> 1) + gs) * 128, scr, t8, FLANE, nullptr, 64.f, 2048); }
            else if (it < B4) transpose_item<0>(AIN(I_WGLU), RW, RW, WGLU, RW, 0, scr, (it - B3) * 8 + F.wave, FLANE);
            else if (it < B5) transpose_item<0>(AIN(I_WA), RW, D, WA, 2 * RW, 0, scr, (it - B4) * 8 + F.wave, FLANE);
            else if (it < B6) transpose_item<0>(AIN(I_WB), RW, D, WA + RW, 2 * RW, 0, scr, (it - B5) * 8 + F.wave, FLANE);
            else if (it < B7) transpose_item<0, true>(AIN(I_WOUT), D, D, WOUT, D, 0, scr, (it - B6) * 8 + F.wave, FLANE, nullptr, 64.f);
            else if (it < B8) transpose_item<0, true>(AIN(I_WPG), D, D, WPG, D, 0, scr, (it - B7) * 8 + F.wave, FLANE, AIN(I_NPLE), 64.f);
            else if (it < B9) transpose_item<0>(AIN(I_WPLE), PLE, D, WP, PLE, 0, scr, (it - B8) * 8 + F.wave, FLANE);
            else if (it < B10) { const int r0 = (it - B9) * 16 + F.wave * 2;
                for (int r = 0; r < 2; ++r) rms_row_to_bf16(FLANE, AIN(I_X) + (size_t)(r0 + r) * D, AIN(I_NMIX), HB + (size_t)(r0 + r) * D, H8 + (size_t)(r0 + r) * D); }
            else if (it < B11) { const size_t e0 = (size_t)(it - B10) * 16384 + FTID * 8;
#pragma unroll
                for (int k = 0; k < 4; ++k) { const size_t e = e0 + (size_t)k * 4096; const f32x4 a = *(const f32x4*)(AIN(I_P) + e), b = *(const f32x4*)(AIN(I_P) + e + 4); *(v4u*)(PB + e) = pack8(a, b); } }
            else if (it < B12) { const int t0 = (it - B11) * 64;
#pragma unroll
                for (int k = 0; k < 8; ++k) { const int idx = k * 512 + FTID, t = t0 + (idx >> 6), j = idx & 63; const double inv = exp2(-(double)j * (13.287712379549449 / 64.0));
                    double sn, cs; sincos((double)t * inv, &sn, &cs); COS[(size_t)t * 64 + j] = (float)cs; SIN[(size_t)t * 64 + j] = (float)sn; } }
            else if (it >= B13) router_weights_item(F, it - B13, AIN(I_NFFN), AIN(I_WRG), AIN(I_WRE), (bf16*)(ws + WS_WR));
            else { for (int i = FTID; i < 128 * 256 / 8; i += 512) *(v4u*)(BLT + (size_t)SG * 128 * 256 + (size_t)i * 8) = (v4u){0u, 0u, 0u, 0u}; }
            itq = wq_end(F, nxq);
        }
    }
    SEAM(0);
    if (IN(1)) {
#pragma unroll 1
        for (int s = 0; s < 2; ++s) {
          if ((s ^ (int)(blockIdx.x & 1)) == 0) { pg8::SchedPlain S; S.init(HB, D, WT1, D, T, INC, F.G, (int)blockIdx.x); S.rep = NREP(1);
            EpiProj E{QKVG, UA, GATES};
            pg8::gemm_phase<EpiProj, pg8::SchedPlain>(F.lds + RING_OFF, D, S, E, F.wave); }
          else { pg8::SchedPlainC<T / 256, 4096 / 256> S; S.A = (const char*)H8; S.B = (const char*)WM8; S.lda2 = D; S.ldb2 = D; S.G = F.G; S.c = (int)blockIdx.x; S.rep = NREP(1);
            EpiGates E{GATES, GATES + (size_t)T * D};
            pg8::gemm_phase<EpiGates, pg8::SchedPlainC<T / 256, 4096 / 256>, true, true>(F.lds + RING_OFF, D, S, E, F.wave); }
        }
    }
    SEAM(1);
    RetCtx RC{QKVG, QKVG + (size_t)T * RW, QKVG + (size_t)2 * T * RW, QKVG + (size_t)3 * T * RW, COS, SIN, args.in[I_GNW], KVS, KVS2, YRET};
    if (IN(2)) {
        pg8::SchedBatch S; S.A = (const char*)UA; S.B = (const char*)BLT; S.lda2 = S5K * 2; S.ldb2 = 256 * 2; S.sA = (size_t)S5NC * S5K * 2; S.sB = (size_t)128 * 256 * 2; S.nMz = S5NC / 256; S.nz = SG; S.G = F.G; S.c = (int)blockIdx.x; S.rep = NREP(2);
        EpiS5A E{EST};
        pg8::gemm_phase<EpiS5A, pg8::SchedBatch>(F.lds + RING_OFF, 256, S, E, F.wave);
        for (int job = blockIdx.x; job < RSC * NH * NREP(2); job += F.G) ret_pass_a(F, RC, job & (RSC * NH - 1));
    }
    SEAM(2);
    if (IN(3)) {
        for (int job = blockIdx.x; job < SG * 4 * NREP(3); job += F.G) s5_scan(F, job & (SG * 4 - 1), EST, LAMT, UA);
        for (int job = blockIdx.x; job < NH * DH * DH / 512 * NREP(3); job += F.G) ret_scan(F, job & (NH * DH * DH / 512 - 1), KVS, KVS2);
    }
    SEAM(3);
    if (IN(4)) {
        pg8::SchedBatch S; S.A = (const char*)UA; S.B = (const char*)BTC; S.lda2 = S5K * 2; S.ldb2 = S5K * 2; S.sA = (size_t)S5NC * S5K * 2; S.sB = (size_t)256 * S5K * 2; S.nMz = S5NC / 256; S.nz = SG; S.G = F.G; S.c = (int)blockIdx.x; S.rep = NREP(4);
        EpiS5C E{YPRE};
#ifndef P4_NOGEMM
        pg8::gemm_phase<EpiS5C, pg8::SchedBatch>(F.lds + RING_OFF, S5K, S, E, F.wave);
#endif
#ifndef P4_NORET
        for (int job = blockIdx.x; job < RSC * NH * NREP(4); job += F.G) ret_pass_c(F, RC, job & (RSC * NH - 1));
#endif
    }
    SEAM(4);
    if (IN(5)) {
        pg8::SchedPlain S; S.init(YPRE, RW, WGLU, RW, T, RW, F.G, (int)blockIdx.x); S.rep = NREP(5);
        EpiGlu E{YPRE, YSSM};
        pg8::gemm_phase<EpiGlu, pg8::SchedPlain>(F.lds + RING_OFF, RW, S, E, F.wave);
    }
    SEAM(5);
    if (IN(6)) {
        pg8::SchedPlainC<T / 256, D / 256> S; S.A = (const char*)YCAT; S.B = (const char*)WA; S.lda2 = D * 2; S.ldb2 = D * 2; S.G = F.G; S.c = (int)blockIdx.x; S.rep = NREP(6);
        EpiMerge1 E{GATES, GATES + (size_t)T * D, M8};
        pg8::gemm_phase<EpiMerge1, pg8::SchedPlainC<T / 256, D / 256>, true, false, true>(F.lds + RING_OFF, D, S, E, F.wave);
    }
    SEAM(6);
    if (IN(7)) {
        constexpr int I_EW = 32 * 3 * 32;
#pragma unroll 1
        for (int s = 0; s < 2; ++s) {
            if ((s ^ (int)(blockIdx.x & 1)) == 0) {
                LAS unsigned char* scr = F.lds + RING_OFF + F.wave * 9216;
                for (int rp = 0; rp < NREP(7); ++rp)
                    conv_stream(F.wave, FLANE, scr, (int)blockIdx.x, F.G, I_EW, args.in[I_WEG], args.in[I_WEU], args.in[I_WED], (unsigned char*)WGU, (unsigned char*)WDN);
            } else {
                pg8::SchedPlainC<T / 256, D / 256> S; S.A = (const char*)M8; S.B = (const char*)WOUT; S.lda2 = D; S.ldb2 = D; S.G = F.G; S.c = (int)blockIdx.x; S.rep = NREP(7);
                EpiOut E{args.in[I_X], X1B};
                pg8::gemm_phase<EpiOut, pg8::SchedPlainC<T / 256, D / 256>, true, true>(F.lds + RING_OFF, D, S, E, F.wave); }
            __syncthreads();
        }
    }
    SEAM(7);
    float* RINV3 = RINV + T;
    unsigned* CNT = F.ctl + CW_CNT; bf16* X2B = HB; bf16* X3B = MOE + 1152;
    if (IN(8)) {
        constexpr int I_RT = T / 64;
        for (int itq = (int)blockIdx.x; itq < I_RT * NREP(8); itq += F.G) {
            int it = itq; bool dry = false; if (it >= I_RT) { it -= I_RT; dry = true; }
            __syncthreads();
            router_item(F, it, dry, X1B, args.in[I_NFFN], WRH, args.in[I_BRG], args.in[I_BRE2], (unsigned char*)HB, RINV, CNT, LIST, WGT);
        }
    }
    SEAM(8);
    if (IN(9)) {
        moe_tables<4>(F, CNT);
        SchedGU S; S.tab = (LAS int*)(F.lds + MOE_TAB_OFF); S.G = F.G; S.c = (int)blockIdx.x; S.A = (const char*)HB; S.B = (const char*)WGU; S.list = LIST; S.lda2 = D; S.ldb2 = D; S.rep = NREP(9);
        EpiGU E{(unsigned char*)ACT, LIST, RINV, S.tab};
        pg8::gemm_phase<EpiGU, SchedGU, true, true>(F.lds + RING_OFF, D, S, E, F.wave);
        { const int nRB = (S.tab[32] >> 2) * S.rep, lastRound = (nRB + 63) / 64 - 1, rem = nRB - lastRound * 64;
          const int q = ((int)blockIdx.x & 7) * 8 + ((int)blockIdx.x >> 5); int nLight = (64 - rem) * 4, idx = (q - rem) * 4 + (((int)blockIdx.x >> 3) & 3); bool light = q >= rem;
          if (nLight < 32 || F.G != 256) { nLight = F.G; idx = (int)blockIdx.x; light = true; }
          if (light) { pg8::SchedPlain S2; S2.init(PB, PLE, WP, PLE, T, D, nLight, idx); S2.rep = NREP(12); EpiPP E2{PP}; pg8::gemm_phase<EpiPP, pg8::SchedPlain>(F.lds + RING_OFF, PLE, S2, E2, F.wave); } }
    }
    SEAM(9);
    if (IN(10)) {
        moe_tables<8>(F, CNT);
        SchedDN S; S.tab = (LAS int*)(F.lds + MOE_TAB_OFF); S.G = F.G; S.c = (int)blockIdx.x; S.A = (const char*)ACT; S.B = (const char*)WDN; S.lda2 = FE; S.ldb2 = FE; S.rep = NREP(10);
        EpiDN E{MOE, LIST, WGT, S.tab};
        pg8::gemm_phase<EpiDN, SchedDN, true, true>(F.lds + RING_OFF, FE, S, E, F.wave);
    }
    SEAM(10);
    if (IN(11)) {
        for (int r2 = blockIdx.x * NWAVES + F.wave; r2 < T * NREP(11); r2 += F.G * NWAVES) { const int row = r2 & (T - 1);
            combine_row(FLANE, X1B + (size_t)row * D, MOE + (size_t)row * D, MOE + ((size_t)T + row) * D, X2B + (size_t)row * D, (unsigned char*)ACT + (size_t)row * D, RINV3 + row); }
    }
    SEAM(11);
    if (IN(12)) {
#ifndef P12_NOGATE
        { pg8::SchedPlainC<T / 256, D / 256> S; S.A = (const char*)ACT; S.B = (const char*)WPG; S.G = F.G; S.c = (int)blockIdx.x; S.lda2 = D; S.ldb2 = D; S.rep = NREP(12); EpiPle E{PP, X2B, RINV3, X3B};
          pg8::gemm_phase<EpiPle, pg8::SchedPlainC<T / 256, D / 256>, true, true>(F.lds + RING_OFF, D, S, E, F.wave); }
#endif
    }
    SEAM(12);
    if (IN(13)) {
        for (int r2 = blockIdx.x * NWAVES + F.wave; r2 < T * NREP(13); r2 += F.G * NWAVES) { const int row = r2 & (T - 1);
            final_row(FLANE, X3B + (size_t)row * D, args.out + (size_t)row * D, args.in[I_NF]); }
    }
#undef IN
#undef SEAM
}

#ifndef RUN_HI
#define RUN_HI 14
#endif
extern "C" void kernel_launch(void* const* d_in, const int* in_sizes, int n_in, void* d_out, int out_size, void* d_ws, size_t ws_size, hipStream_t stream) {
    static int grid = 0;
    if (grid == 0) {
        if (n_in != 30 || ws_size < WS_END2) { fprintf(stderr, "kernel_launch: unexpected n_in %d / ws %zu\n", n_in, ws_size); grid = -1; return; }
        int dev = 0, cus = 0;
        if (hipGetDevice(&dev) != hipSuccess || hipDeviceGetAttribute(&cus, hipDeviceAttributeMultiprocessorCount, dev) != hipSuccess) { grid = -1; return; }
        if (hipFuncSetAttribute((const void*)mk_fwd, hipFuncAttributeMaxDynamicSharedMemorySize, LDS_BYTES) != hipSuccess) { fprintf(stderr, "kernel_launch: hipFuncSetAttribute failed\n"); grid = -1; return; }
        grid = cus;
    }
    if (grid < 0) return;
    (void)hipMemsetAsync((char*)d_ws + WS_CTL, 0, CTL_ZERO_BYTES, stream);
    Args a{};
    for (int i = 0; i < 30; ++i) a.in[i] = (const float*)d_in[i];
    a.out = (float*)d_out; a.ws = (unsigned char*)d_ws;
#ifdef REP_MASK
    a.rep_mask = REP_MASK;
#endif
    a.ph_lo = 0; a.ph_hi = RUN_HI; hipLaunchKernelGGL(mk_fwd, dim3(grid), dim3(NWAVES * 64), LDS_BYTES, stream, a);
}
```
